# Optimizing an MI355X kernel written in HIP

```python
import math
import jax, jax.numpy as jnp
from jax import lax
import numpy as np

D_MODEL = 1024
BATCH = 16
SEQ = 4096
DEPTH = 1

D_MIX = D_MODEL
D_SSM = D_MIX // 2
SSM_GROUP = 16
N_SSM_GROUPS = D_SSM // SSM_GROUP
SSM_STATE = 64
D_ATTN = D_MIX - D_SSM
N_HEADS = 8
QK_NOPE = 64
QK_ROPE = 32
V_HEAD = D_ATTN // N_HEADS
Q_LORA = 384
KV_LORA = 256
IN_COLS = D_SSM + Q_LORA + KV_LORA + QK_ROPE
D_FF = 4 * D_MODEL
ROPE_BASE = 10000.0
Q_BLOCK = 128
EPS = 1e-6
DT_MIN = 1e-3
DT_MAX = 1e-1
N_MOD = 6

kernel_name = "hymba_s5_mla_adaln_block"


def rmsnorm(x, g):
    xf = x.astype(jnp.float32)
    y = xf * lax.rsqrt(jnp.mean(xf * xf, axis=-1, keepdims=True) + EPS)
    return (y * g.astype(jnp.float32)).astype(x.dtype)


def rope_tables(positions):
    inv_freq = ROPE_BASE ** (-jnp.arange(0, QK_ROPE, 2, dtype=jnp.float32) / QK_ROPE)
    ang = positions.astype(jnp.float32)[..., None] * inv_freq
    return jnp.cos(ang), jnp.sin(ang)


def apply_rope(x, cos, sin):
    xf = x.astype(jnp.float32)
    x1, x2 = jnp.split(xf, 2, axis=-1)
    out = jnp.concatenate([x1 * cos - x2 * sin, x1 * sin + x2 * cos], axis=-1)
    return out.astype(x.dtype)


def s5_mixer(u, lam_re, lam_im, b_re, b_im, c_re, c_im, d, log_dt, w_glu):
    f32 = jnp.float32
    bsz, seq, _ = u.shape
    uf = u.astype(f32).reshape(bsz, seq, N_SSM_GROUPS, SSM_GROUP)
    lam = lax.complex(lam_re.astype(f32), lam_im.astype(f32))
    dt = jnp.exp(log_dt.astype(f32))[:, None]
    lam_bar = jnp.exp(lam * dt)
    b = lax.complex(b_re.astype(f32), b_im.astype(f32))
    b_bar = ((lam_bar - 1.0) / lam)[..., None] * b
    bu = jnp.einsum("bsgh,gph->bsgp", uf, b_bar)
    a = jnp.broadcast_to(lam_bar, (1, seq) + lam_bar.shape)

    def combine(left, right):
        a_l, b_l = left
        a_r, b_r = right
        return a_r * a_l, a_r * b_l + b_r

    _, states = lax.associative_scan(combine, (a, bu), axis=1)
    y = (jnp.einsum("bsgp,ghp->bsgh", jnp.real(states), c_re.astype(f32))
         - jnp.einsum("bsgp,ghp->bsgh", jnp.imag(states), c_im.astype(f32))
         + d.astype(f32) * uf)
    y = jax.nn.gelu(y).reshape(bsz, seq, D_SSM).astype(u.dtype)
    z = y @ w_glu
    return z[..., :D_SSM] * jax.nn.sigmoid(z[..., D_SSM:])


def causal_block_attention(q_nope, q_rope, k_nope, k_rope, v):
    bsz, seq = q_nope.shape[:2]
    n_blocks = seq // Q_BLOCK
    scale = (QK_NOPE + QK_ROPE) ** -0.5
    key_pos = jnp.arange(seq)

    def one_block(i):
        start = i * Q_BLOCK
        qn = lax.dynamic_slice_in_dim(q_nope, start, Q_BLOCK, axis=1)
        qr = lax.dynamic_slice_in_dim(q_rope, start, Q_BLOCK, axis=1)
        s = (jnp.einsum("bqhd,bkhd->bhqk", qn, k_nope)
             + jnp.einsum("bqhr,bkr->bhqk", qr, k_rope)).astype(jnp.float32) * scale
        q_pos = start + jnp.arange(Q_BLOCK)
        mask = key_pos[None, :] <= q_pos[:, None]
        s = jnp.where(mask, s, -jnp.inf)
        p = jax.nn.softmax(s, axis=-1).astype(v.dtype)
        return jnp.einsum("bhqk,bkhd->bqhd", p, v)

    out = lax.map(one_block, jnp.arange(n_blocks))
    return out.transpose(1, 0, 2, 3, 4).reshape(bsz, seq, N_HEADS, V_HEAD)


def mla_mixer(q_lat, kv_lat, k_rope, cos, sin, q_norm_g, w_uq, kv_norm_g, w_ukv):
    bsz, seq, _ = q_lat.shape
    q = (rmsnorm(q_lat, q_norm_g) @ w_uq).reshape(bsz, seq, N_HEADS, QK_NOPE + QK_ROPE)
    kv = (rmsnorm(kv_lat, kv_norm_g) @ w_ukv).reshape(bsz, seq, N_HEADS, QK_NOPE + V_HEAD)
    q_nope, q_rope = q[..., :QK_NOPE], q[..., QK_NOPE:]
    k_nope, v = kv[..., :QK_NOPE], kv[..., QK_NOPE:]
    q_rope = apply_rope(q_rope, cos[:, :, None, :], sin[:, :, None, :])
    k_rope = apply_rope(k_rope, cos, sin)
    out = causal_block_attention(q_nope, q_rope, k_nope, k_rope, v)
    return out.reshape(bsz, seq, D_ATTN)


def setup_inputs(seed: int = 0) -> dict:
    key = jax.random.key(seed)
    ks = jax.random.split(key, 32)
    f32 = jnp.float32
    L = DEPTH

    def nrm(k, shape, scale):
        return jax.random.normal(k, shape, f32) * scale

    def gain(k, shape):
        return 1.0 + 0.02 * jax.random.normal(k, shape, f32)

    x = jax.random.normal(ks[0], (BATCH, SEQ, D_MODEL), f32)
    c = jax.random.normal(ks[1], (BATCH, D_MODEL), f32)
    offset = jax.random.randint(ks[2], (BATCH, 1), 0, 2048, dtype=jnp.int32)
    positions = offset + jnp.arange(SEQ, dtype=jnp.int32)[None, :]

    n_idx = jnp.arange(SSM_STATE, dtype=f32)
    lam_re = -0.5 * jnp.exp(0.01 * jax.random.normal(ks[3], (L, N_SSM_GROUPS, SSM_STATE), f32))
    lam_im = math.pi * n_idx + 0.01 * jax.random.normal(ks[4], (L, N_SSM_GROUPS, SSM_STATE), f32)
    log_dt = jax.random.uniform(ks[5], (L, N_SSM_GROUPS), f32, math.log(DT_MIN), math.log(DT_MAX))

    return {
        "x": x,
        "c": c,
        "positions": positions,
        "ada_w": nrm(ks[6], (L, D_MODEL, N_MOD * D_MODEL), 0.5 * D_MODEL ** -0.5),
        "ada_b": nrm(ks[7], (L, N_MOD * D_MODEL), 0.02),
        "norm1_g": gain(ks[8], (L, D_MODEL)),
        "w_in": nrm(ks[9], (L, D_MODEL, IN_COLS), D_MODEL ** -0.5),
        "ssm_lambda_re": lam_re,
        "ssm_lambda_im": lam_im,
        "ssm_b_re": nrm(ks[10], (L, N_SSM_GROUPS, SSM_STATE, SSM_GROUP), (2 * SSM_GROUP) ** -0.5),
        "ssm_b_im": nrm(ks[11], (L, N_SSM_GROUPS, SSM_STATE, SSM_GROUP), (2 * SSM_GROUP) ** -0.5),
        "ssm_c_re": nrm(ks[12], (L, N_SSM_GROUPS, SSM_GROUP, SSM_STATE), (2 * SSM_STATE) ** -0.5),
        "ssm_c_im": nrm(ks[13], (L, N_SSM_GROUPS, SSM_GROUP, SSM_STATE), (2 * SSM_STATE) ** -0.5),
        "ssm_d": nrm(ks[14], (L, N_SSM_GROUPS, SSM_GROUP), 1.0),
        "ssm_log_dt": log_dt,
        "w_glu": nrm(ks[15], (L, D_SSM, 2 * D_SSM), D_SSM ** -0.5),
        "q_norm_g": gain(ks[16], (L, Q_LORA)),
        "w_uq": nrm(ks[17], (L, Q_LORA, N_HEADS * (QK_NOPE + QK_ROPE)), Q_LORA ** -0.5),
        "kv_norm_g": gain(ks[18], (L, KV_LORA)),
        "w_ukv": nrm(ks[19], (L, KV_LORA, N_HEADS * (QK_NOPE + V_HEAD)), KV_LORA ** -0.5),
        "ssm_out_g": gain(ks[20], (L, D_SSM)),
        "attn_out_g": gain(ks[21], (L, D_ATTN)),
        "w_out": nrm(ks[22], (L, D_MIX, D_MODEL), D_MIX ** -0.5),
        "norm2_g": gain(ks[23], (L, D_MODEL)),
        "w_ff1": nrm(ks[24], (L, D_MODEL, D_FF), D_MODEL ** -0.5),
        "w_ff2": nrm(ks[25], (L, D_FF, D_MODEL), D_FF ** -0.5),
        "final_ada_w": nrm(ks[26], (D_MODEL, 2 * D_MODEL), 0.5 * D_MODEL ** -0.5),
        "final_ada_b": nrm(ks[27], (2 * D_MODEL,), 0.02),
        "final_norm_g": gain(ks[28], (D_MODEL,)),
    }


def reference(x, c, positions, ada_w, ada_b, norm1_g, w_in, ssm_lambda_re, ssm_lambda_im,
              ssm_b_re, ssm_b_im, ssm_c_re, ssm_c_im, ssm_d, ssm_log_dt, w_glu,
              q_norm_g, w_uq, kv_norm_g, w_ukv, ssm_out_g, attn_out_g, w_out,
              norm2_g, w_ff1, w_ff2, final_ada_w, final_ada_b, final_norm_g):
    cond = jax.nn.silu(c)
    cos, sin = rope_tables(positions)
    s1 = D_SSM
    s2 = s1 + Q_LORA
    s3 = s2 + KV_LORA
    for l in range(DEPTH):
        mod = (cond @ ada_w[l] + ada_b[l])[:, None, :]
        shift1, scale1, gate1, shift2, scale2, gate2 = jnp.split(mod, N_MOD, axis=-1)

        h = rmsnorm(x, norm1_g[l]) * (1.0 + scale1) + shift1
        proj = h @ w_in[l]
        u = proj[..., :s1]
        q_lat = proj[..., s1:s2]
        kv_lat = proj[..., s2:s3]
        k_rope = proj[..., s3:]
        y_ssm = s5_mixer(u, ssm_lambda_re[l], ssm_lambda_im[l], ssm_b_re[l], ssm_b_im[l],
                         ssm_c_re[l], ssm_c_im[l], ssm_d[l], ssm_log_dt[l], w_glu[l])
        y_attn = mla_mixer(q_lat, kv_lat, k_rope, cos, sin, q_norm_g[l], w_uq[l],
                           kv_norm_g[l], w_ukv[l])
        y = jnp.concatenate([rmsnorm(y_ssm, ssm_out_g[l]), rmsnorm(y_attn, attn_out_g[l])], axis=-1)
        x = x + gate1 * (y @ w_out[l])

        h = rmsnorm(x, norm2_g[l]) * (1.0 + scale2) + shift2
        ff = jnp.square(jax.nn.relu(h @ w_ff1[l])) @ w_ff2[l]
        x = x + gate2 * ff

    fmod = (cond @ final_ada_w + final_ada_b)[:, None, :]
    fshift, fscale = jnp.split(fmod, 2, axis=-1)
    return rmsnorm(x, final_norm_g) * (1.0 + fscale) + fshift
```

```cpp
#include <hip/hip_runtime.h>
#include <hip/hip_cooperative_groups.h>
#include <stdint.h>
#include <cstdio>
namespace cg = cooperative_groups;

#ifndef ONE_LAUNCH
#define ONE_LAUNCH 0
#endif

typedef unsigned short bf16;
typedef __attribute__((ext_vector_type(8))) short bf16x8;
typedef __attribute__((ext_vector_type(4))) float f32x4;
typedef __attribute__((ext_vector_type(16))) float f32x16;

#define NT 256
#define SMEM_BYTES (73728 + 1024)
#define EPSN 1e-6f
#define QSCALE (0.10206207261596577f * 1.4426950408889634f)

struct P {
  const float *x, *c; const int* pos;
  const float *ada_w, *ada_b, *norm1_g, *w_in, *lam_re, *lam_im, *b_re, *b_im, *c_re, *c_im, *ssm_d, *log_dt,
      *w_glu, *q_norm_g, *w_uq, *kv_norm_g, *w_ukv, *ssm_out_g, *attn_out_g, *w_out, *norm2_g, *w_ff1, *w_ff2,
      *fada_w, *fada_b, *fnorm_g;
  float* out;
  bf16 *Wt_in, *Wt_glu, *Wt_uq, *Wt_ukv, *Wt_out, *Wt_ff1, *Wt_ff2;
  float* mod; float2* pw; float2* bbar; float* ktab; float2* cs;
  bf16* hbuf; bf16 *Ag, *Bty, *Fm; float* S;
  bf16 *qlat, *kvlat, *Q, *Kc, *Vt, *ygelu, *ycat, *hid;
};

__device__ __forceinline__ float bf2f(unsigned h) { return __uint_as_float(h << 16); }
__device__ __forceinline__ unsigned pack2(float a, float b) {
  typedef __attribute__((ext_vector_type(2))) __bf16 bf2;
  bf2 v; v[0] = (__bf16)a; v[1] = (__bf16)b;
  return __builtin_bit_cast(unsigned, v);
}
__device__ __forceinline__ bf16 f2bf(float a) { return (bf16)(pack2(a, 0.f) & 0xffffu); }
__device__ __forceinline__ float sq2(unsigned w) {
  float a = __uint_as_float(w << 16), b = __uint_as_float(w & 0xffff0000u);
  return a * a + b * b;
}
__device__ __forceinline__ float gelu_tanh(float x) {
  float z = 0.7978845608028654f * (x + 0.044715f * x * x * x);
  float e = __expf(2.f * z);
  float th = 1.f - 2.f / (e + 1.f);
  return 0.5f * x * (1.f + th);
}
__device__ __forceinline__ float sigmoidf(float x) { return 1.f / (1.f + __expf(-x)); }

enum { EPI_INPROJ = 0, EPI_Q, EPI_KV, EPI_S, EPI_Y, EPI_GLU, EPI_OUT, EPI_FF1, EPI_FF2 };

template <int EPI, int PRE>
__device__ __forceinline__ void gemm_tile(const P& p, const bf16* __restrict__ A, int lda, const bf16* __restrict__ Bt,
                                          int ldb, int nt_total, int nk1, int kjump, int m0, int n0, int g,
                                          char* smem) {
  bf16* As = (bf16*)smem;
  bf16* Bs = As + 2 * 128 * 72;
  float* rs = (float*)(Bs + 2 * 128 * 72);
  const int t = threadIdx.x, w = __builtin_amdgcn_readfirstlane(t >> 6), l = t & 63, wm = w >> 1, wn = w & 1, lr = l & 15, lq = l >> 4;

  if (PRE == 1) {
    const int K = nt_total * 64;
    int row = t >> 1, hf = t & 1;
    const bf16* ap = A + (size_t)(m0 + row) * lda + hf * (K / 2);
    float ss = 0.f;
    for (int c = 0; c < K / 16; ++c) {
      uint4 v = *(const uint4*)(ap + c * 8);
      ss += sq2(v.x) + sq2(v.y) + sq2(v.z) + sq2(v.w);
    }
    ss += __shfl_xor(ss, 1);
    if (!hf) rs[row] = rsqrtf(ss / (float)K + EPSN);
  }
  if (PRE == 2) {
    int row = t >> 1, hf = t & 1;
    const bf16* ap = A + (size_t)(m0 + row) * lda + hf * 512;
    float ss = 0.f;
    for (int c = 0; c < 64; ++c) {
      uint4 v = *(const uint4*)(ap + c * 8);
      ss += sq2(v.x) + sq2(v.y) + sq2(v.z) + sq2(v.w);
    }
    rs[hf * 128 + row] = rsqrtf(ss / 512.f + EPSN);
  }

  f32x4 acc[4][4];
#pragma unroll
  for (int i = 0; i < 4; ++i)
#pragma unroll
    for (int j = 0; j < 4; ++j) acc[i][j] = (f32x4){0.f, 0.f, 0.f, 0.f};

  const int ldrow = t >> 3, ldkc = (t & 7) * 8;
  const bf16* Ap = A + (size_t)(m0 + ldrow) * lda + ldkc;
  const bf16* Bp = Bt + (size_t)(n0 + ldrow) * ldb + ldkc;
  uint4 ra[4], rb[4];
  {
    int kt = (0 < nk1) ? 0 : kjump;
#pragma unroll
    for (int i = 0; i < 4; ++i) {
      ra[i] = *(const uint4*)(Ap + (size_t)i * 32 * lda + kt * 64);
      rb[i] = *(const uint4*)(Bp + (size_t)i * 32 * ldb + kt * 64);
    }
#pragma unroll
    for (int i = 0; i < 4; ++i) {
      *(uint4*)(As + (ldrow + 32 * i) * 72 + ldkc) = ra[i];
      *(uint4*)(Bs + (ldrow + 32 * i) * 72 + ldkc) = rb[i];
    }
  }
  __syncthreads();

  for (int it = 0; it < nt_total; ++it) {
    const int buf = it & 1;
    const bool more = (it + 1 < nt_total);
    if (more) {
      int kt = (it + 1 < nk1) ? (it + 1) : (it + 1 - nk1 + kjump);
#pragma unroll
      for (int i = 0; i < 4; ++i) {
        ra[i] = *(const uint4*)(Ap + (size_t)i * 32 * lda + kt * 64);
        rb[i] = *(const uint4*)(Bp + (size_t)i * 32 * ldb + kt * 64);
      }
    }
    if (PRE == 2) {
      if (it == 8) {
#pragma unroll
        for (int mt = 0; mt < 4; ++mt)
#pragma unroll
          for (int r = 0; r < 4; ++r) {
            int rl = wm * 64 + mt * 16 + lq * 4 + r;
            float f = rs[rl] / rs[128 + rl];
#pragma unroll
            for (int nt = 0; nt < 4; ++nt) acc[mt][nt][r] *= f;
          }
      }
    }
    const bf16* Ab = As + buf * (128 * 72) + (wm * 64 + lr) * 72 + lq * 8;
    const bf16* Bb = Bs + buf * (128 * 72) + (wn * 64 + lr) * 72 + lq * 8;
#pragma unroll
    for (int ks = 0; ks < 2; ++ks) {
      bf16x8 a[4], b[4];
#pragma unroll
      for (int i = 0; i < 4; ++i) {
        a[i] = *(const bf16x8*)(Ab + i * 16 * 72 + ks * 32);
        b[i] = *(const bf16x8*)(Bb + i * 16 * 72 + ks * 32);
      }
#pragma unroll
      for (int mt = 0; mt < 4; ++mt)
#pragma unroll
        for (int nt = 0; nt < 4; ++nt)
          acc[mt][nt] = __builtin_amdgcn_mfma_f32_16x16x32_bf16(a[mt], b[nt], acc[mt][nt], 0, 0, 0);
    }
    if (more) {
#pragma unroll
      for (int i = 0; i < 4; ++i) {
        *(uint4*)(As + (buf ^ 1) * (128 * 72) + (ldrow + 32 * i) * 72 + ldkc) = ra[i];
        *(uint4*)(Bs + (buf ^ 1) * (128 * 72) + (ldrow + 32 * i) * 72 + ldkc) = rb[i];
      }
    }
    __syncthreads();
  }

#pragma unroll
  for (int mt = 0; mt < 4; ++mt) {
    const int rl0 = wm * 64 + mt * 16 + lq * 4;
    const int row0 = m0 + rl0;
#pragma unroll
    for (int nt = 0; nt < 4; ++nt) {
      const int cb = n0 + wn * 64 + nt * 16;
      const int col = cb + lr;
      if (EPI == EPI_INPROJ) {
        if (cb < 512) {
          const int gg = cb >> 4;
#pragma unroll
          for (int r = 0; r < 4; ++r) {
            int row = row0 + r, b = row >> 12, s = row & 4095, c = s >> 6, j = s & 63;
            p.Ag[((size_t)(gg * 1024 + b * 64 + c)) * 1152 + j * 16 + lr] = f2bf(acc[mt][nt][r]);
          }
        } else if (cb < 896) {
#pragma unroll
          for (int r = 0; r < 4; ++r) p.qlat[(size_t)(row0 + r) * 384 + (col - 512)] = f2bf(acc[mt][nt][r]);
        } else if (cb < 1152) {
#pragma unroll
          for (int r = 0; r < 4; ++r) p.kvlat[(size_t)(row0 + r) * 256 + (col - 896)] = f2bf(acc[mt][nt][r]);
        } else if (cb == 1152) {
          if (nt < 3) {
#pragma unroll
            for (int r = 0; r < 4; ++r) {
              int row = row0 + r, b = row >> 12, s = row & 4095;
              float2 cs = p.cs[(size_t)row * 16 + lr];
              float x1 = acc[mt][nt][r], x2 = acc[mt][nt < 3 ? nt + 1 : nt][r];
              bf16 o1 = f2bf(x1 * cs.x - x2 * cs.y), o2 = f2bf(x1 * cs.y + x2 * cs.x);
#pragma unroll
              for (int h = 0; h < 8; ++h) {
                bf16* kp = p.Kc + ((size_t)((b * 8 + h) * 4096 + s)) * 96;
                kp[64 + lr] = o1;
                kp[80 + lr] = o2;
              }
            }
          }
        }
      } else if (EPI == EPI_Q) {
        const int hq = cb / 96, d0 = cb - hq * 96;
        if (d0 < 64) {
#pragma unroll
          for (int r = 0; r < 4; ++r) {
            int row = row0 + r, b = row >> 12, s = row & 4095;
            float v = acc[mt][nt][r] * rs[rl0 + r] * QSCALE;
            p.Q[((size_t)((b * 8 + hq) * 4096 + s)) * 96 + d0 + lr] = f2bf(v);
          }
        } else if (d0 == 64) {
          if (nt < 3) {
#pragma unroll
            for (int r = 0; r < 4; ++r) {
              int row = row0 + r, b = row >> 12, s = row & 4095;
              float sc = rs[rl0 + r] * QSCALE;
              float x1 = acc[mt][nt][r] * sc, x2 = acc[mt][nt < 3 ? nt + 1 : nt][r] * sc;
              float2 cs = p.cs[(size_t)row * 16 + lr];
              bf16* qp = p.Q + ((size_t)((b * 8 + hq) * 4096 + s)) * 96;
              qp[64 + lr] = f2bf(x1 * cs.x - x2 * cs.y);
              qp[80 + lr] = f2bf(x1 * cs.y + x2 * cs.x);
            }
          }
        }
      } else if (EPI == EPI_KV) {
        const int hk = cb >> 7, d0 = cb & 127;
        const int b = row0 >> 12, s0 = row0 & 4095;
        if (d0 < 64) {
#pragma unroll
          for (int r = 0; r < 4; ++r)
            p.Kc[((size_t)((b * 8 + hk) * 4096 + s0 + r)) * 96 + d0 + lr] = f2bf(acc[mt][nt][r] * rs[rl0 + r]);
        } else {
          uint2 v;
          v.x = pack2(acc[mt][nt][0] * rs[rl0 + 0], acc[mt][nt][1] * rs[rl0 + 1]);
          v.y = pack2(acc[mt][nt][2] * rs[rl0 + 2], acc[mt][nt][3] * rs[rl0 + 3]);
          *(uint2*)(p.Vt + ((size_t)((b * 8 + hk) * 64 + (d0 - 64) + lr)) * 4096 + s0) = v;
        }
      } else if (EPI == EPI_S) {
#pragma unroll
        for (int r = 0; r < 4; ++r) p.S[((size_t)(g * 1024 + row0 + r)) * 128 + col] = acc[mt][nt][r];
      } else if (EPI == EPI_Y) {
        const float dd = p.ssm_d[g * 16 + lr];
        const int j = cb >> 4;
#pragma unroll
        for (int r = 0; r < 4; ++r) {
          int row = row0 + r, b = row >> 6, c = row & 63;
          float u = bf2f(p.Ag[((size_t)(g * 1024 + row)) * 1152 + col]);
          float y = gelu_tanh(acc[mt][nt][r] + dd * u);
          p.ygelu[((size_t)(b * 4096 + c * 64 + j)) * 512 + g * 16 + lr] = f2bf(y);
        }
      } else if (EPI == EPI_GLU) {
        if ((nt & 1) == 0) {
          const int oc = (cb >> 5) * 16 + lr;
#pragma unroll
          for (int r = 0; r < 4; ++r) {
            float v = acc[mt][nt][r] * sigmoidf(acc[mt][(nt & 1) == 0 ? nt + 1 : nt][r]);
            p.ycat[(size_t)(row0 + r) * 1024 + oc] = f2bf(v);
          }
        }
      } else if (EPI == EPI_OUT) {
#pragma unroll
        for (int r = 0; r < 4; ++r) {
          int row = row0 + r, b = row >> 12;
          size_t o = (size_t)row * 1024 + col;
          p.out[o] = p.x[o] + p.mod[b * 8192 + 2048 + col] * acc[mt][nt][r] * rs[128 + rl0 + r];
        }
      } else if (EPI == EPI_FF1) {
#pragma unroll
        for (int r = 0; r < 4; ++r) {
          float v = fmaxf(acc[mt][nt][r], 0.f);
          p.hid[(size_t)(row0 + r) * 4096 + col] = f2bf(v * v);
        }
      } else if (EPI == EPI_FF2) {
#pragma unroll
        for (int r = 0; r < 4; ++r) {
          int row = row0 + r, b = row >> 12;
          size_t o = (size_t)row * 1024 + col;
          p.out[o] = p.out[o] + p.mod[b * 8192 + 5120 + col] * acc[mt][nt][r];
        }
      }
    }
  }
  if (PRE != 0) __syncthreads();
}

#define KSTR 104
#define VSTR 68
__device__ __forceinline__ void attn_item(const P& p, int bh, int qt, char* smem) {
  bf16* Ks = (bf16*)smem;
  bf16* Vs = Ks + 2 * 64 * KSTR;
  const int t = threadIdx.x, w = __builtin_amdgcn_readfirstlane(t >> 6), l = t & 63, qi = l & 31, half = l >> 5;
  const int q0 = qt * 128, wq0 = q0 + w * 32;
  const bf16* Qp = p.Q + ((size_t)bh * 4096 + wq0 + qi) * 96;
  bf16x8 qf[6];
#pragma unroll
  for (int ks = 0; ks < 6; ++ks) qf[ks] = *(const bf16x8*)(Qp + ks * 16 + half * 8);
  const bf16* Kg = p.Kc + (size_t)bh * 4096 * 96;
  const bf16* Vg = p.Vt + (size_t)bh * 64 * 4096;
  const int nkt = 2 * qt + 2;

  const int kr0r = t / 12, kr0c = t - kr0r * 12;
  const int kr1r = (t + 256) / 12, kr1c = (t + 256) - kr1r * 12;
  const int kr2r = (t + 512) / 12, kr2c = (t + 512) - kr2r * 12;
  const int vrow = t >> 3, vkc = t & 7;
  const bf16* kg0 = Kg + (size_t)kr0r * 96 + kr0c * 8;
  const bf16* kg1 = Kg + (size_t)kr1r * 96 + kr1c * 8;
  const bf16* kg2 = Kg + (size_t)kr2r * 96 + kr2c * 8;
  const bf16* vg0 = Vg + (size_t)vrow * 4096 + vkc * 8;
  const bf16* vg1 = Vg + (size_t)(vrow + 32) * 4096 + vkc * 8;
  const int ks0 = kr0r * KSTR + kr0c * 8, ks1 = kr1r * KSTR + kr1c * 8, ks2 = kr2r * KSTR + kr2c * 8;
  const int vs0 = vrow * VSTR + vkc * 8, vs1 = (vrow + 32) * VSTR + vkc * 8;
  uint4 kra, krb, krc, vra, vrb;
#define ATT_GLOAD(kt_) do { kra = *(const uint4*)(kg0 + (size_t)(kt_) * 64 * 96); krb = *(const uint4*)(kg1 + (size_t)(kt_) * 64 * 96); \
    krc = *(const uint4*)(kg2 + (size_t)(kt_) * 64 * 96); vra = *(const uint4*)(vg0 + (kt_) * 64); vrb = *(const uint4*)(vg1 + (kt_) * 64); } while (0)
#define ATT_LSTORE(buf_) do { bf16* kb_ = Ks + (buf_) * (64 * KSTR); bf16* vb_ = Vs + (buf_) * (64 * VSTR); \
    *(uint4*)(kb_ + ks0) = kra; *(uint4*)(kb_ + ks1) = krb; *(uint4*)(kb_ + ks2) = krc; \
    ((uint2*)(vb_ + vs0))[0] = make_uint2(vra.x, vra.y); ((uint2*)(vb_ + vs0))[1] = make_uint2(vra.z, vra.w); \
    ((uint2*)(vb_ + vs1))[0] = make_uint2(vrb.x, vrb.y); ((uint2*)(vb_ + vs1))[1] = make_uint2(vrb.z, vrb.w); } while (0)
  ATT_GLOAD(0);
  ATT_LSTORE(0);
  __syncthreads();

  f32x16 o0, o1;
#pragma unroll
  for (int r = 0; r < 16; ++r) { o0[r] = 0.f; o1[r] = 0.f; }
  float mrun = -INFINITY, lsum = 0.f;

  for (int kt = 0; kt < nkt; ++kt) {
    const int buf = kt & 1;
    const bool more = (kt + 1 < nkt);
    if (more) ATT_GLOAD(kt + 1);
    if (kt * 64 <= wq0 + 31) {
      const bf16* Kb = Ks + buf * (64 * KSTR);
      const bf16* Vb = Vs + buf * (64 * VSTR);
      f32x16 s0, s1;
#pragma unroll
      for (int r = 0; r < 16; ++r) { s0[r] = 0.f; s1[r] = 0.f; }
#pragma unroll
      for (int ks = 0; ks < 6; ++ks) {
        bf16x8 a0 = *(const bf16x8*)(Kb + qi * KSTR + ks * 16 + half * 8);
        bf16x8 a1 = *(const bf16x8*)(Kb + (32 + qi) * KSTR + ks * 16 + half * 8);
        s0 = __builtin_amdgcn_mfma_f32_32x32x16_bf16(a0, qf[ks], s0, 0, 0, 0);
        s1 = __builtin_amdgcn_mfma_f32_32x32x16_bf16(a1, qf[ks], s1, 0, 0, 0);
      }
      if (kt * 64 + 63 > wq0) {
        const int qpos = wq0 + qi;
#pragma unroll
        for (int r = 0; r < 16; ++r) {
          int key = kt * 64 + (r >> 2) * 8 + half * 4 + (r & 3);
          if (key > qpos) s0[r] = -INFINITY;
          if (key + 32 > qpos) s1[r] = -INFINITY;
        }
      }
      float mt_ = s0[0];
#pragma unroll
      for (int r = 1; r < 16; ++r) mt_ = fmaxf(mt_, s0[r]);
#pragma unroll
      for (int r = 0; r < 16; ++r) mt_ = fmaxf(mt_, s1[r]);
      mt_ = fmaxf(mt_, __shfl_xor(mt_, 32));
      const float mnew = fmaxf(mrun, mt_);
      const float alpha = exp2f(mrun - mnew);
      mrun = mnew;
      float ps = 0.f;
#pragma unroll
      for (int r = 0; r < 16; ++r) { s0[r] = exp2f(s0[r] - mnew); ps += s0[r]; }
#pragma unroll
      for (int r = 0; r < 16; ++r) { s1[r] = exp2f(s1[r] - mnew); ps += s1[r]; }
      lsum = lsum * alpha + ps;
#pragma unroll
      for (int r = 0; r < 16; ++r) { o0[r] *= alpha; o1[r] *= alpha; }
#pragma unroll
      for (int kk = 0; kk < 4; ++kk) {
        unsigned pk[4];
#pragma unroll
        for (int j = 0; j < 4; ++j) {
          float a = (kk < 2) ? s0[(kk & 1) * 8 + 2 * j] : s1[(kk & 1) * 8 + 2 * j];
          float b = (kk < 2) ? s0[(kk & 1) * 8 + 2 * j + 1] : s1[(kk & 1) * 8 + 2 * j + 1];
          pk[j] = pack2(a, b);
        }
        bf16x8 pb = __builtin_bit_cast(bf16x8, make_uint4(pk[0], pk[1], pk[2], pk[3]));
        const bf16* v0p = Vb + qi * VSTR + kk * 16 + half * 4;
        const bf16* v1p = Vb + (32 + qi) * VSTR + kk * 16 + half * 4;
        uint2 a0l = *(const uint2*)(v0p), a0h = *(const uint2*)(v0p + 8);
        uint2 a1l = *(const uint2*)(v1p), a1h = *(const uint2*)(v1p + 8);
        bf16x8 av0 = __builtin_bit_cast(bf16x8, make_uint4(a0l.x, a0l.y, a0h.x, a0h.y));
        bf16x8 av1 = __builtin_bit_cast(bf16x8, make_uint4(a1l.x, a1l.y, a1h.x, a1h.y));
        o0 = __builtin_amdgcn_mfma_f32_32x32x16_bf16(av0, pb, o0, 0, 0, 0);
        o1 = __builtin_amdgcn_mfma_f32_32x32x16_bf16(av1, pb, o1, 0, 0, 0);
      }
    }
    if (more) ATT_LSTORE(buf ^ 1);
    __syncthreads();
  }
  const float ltot = lsum + __shfl_xor(lsum, 32);
  const float inv = 1.f / ltot;
  const int b = bh >> 3, h = bh & 7;
  bf16* op = p.ycat + ((size_t)(b * 4096 + wq0 + qi)) * 1024 + 512 + h * 64 + half * 4;
#pragma unroll
  for (int rg = 0; rg < 4; ++rg) {
    uint2 v0, v1;
    v0.x = pack2(o0[rg * 4 + 0] * inv, o0[rg * 4 + 1] * inv);
    v0.y = pack2(o0[rg * 4 + 2] * inv, o0[rg * 4 + 3] * inv);
    v1.x = pack2(o1[rg * 4 + 0] * inv, o1[rg * 4 + 1] * inv);
    v1.y = pack2(o1[rg * 4 + 2] * inv, o1[rg * 4 + 3] * inv);
    *(uint2*)(op + rg * 8) = v0;
    *(uint2*)(op + 32 + rg * 8) = v1;
  }
}

template <bool TOBF>
__device__ __forceinline__ void norm_rows(const P& p, const float* __restrict__ src, const float* __restrict__ g,
                                          int shift_off, int scale_off, bf16* dstb, float* dstf, int item) {
  const int t = threadIdx.x, w = t >> 6, l = t & 63;
  const int row = item * 4 + w;
  const float4* sp = (const float4*)(src + (size_t)row * 1024);
  float4 v[4];
  float ss = 0.f;
#pragma unroll
  for (int i = 0; i < 4; ++i) {
    v[i] = sp[i * 64 + l];
    ss += v[i].x * v[i].x + v[i].y * v[i].y + v[i].z * v[i].z + v[i].w * v[i].w;
  }
#pragma unroll
  for (int o = 32; o >= 1; o >>= 1) ss += __shfl_xor(ss, o);
  const float rstd = rsqrtf(ss * (1.f / 1024.f) + EPSN);
  const float* md = p.mod + (row >> 12) * 8192;
#pragma unroll
  for (int i = 0; i < 4; ++i) {
    const int col = i * 256 + l * 4;
    float4 gg = *(const float4*)(g + col);
    float4 sc = *(const float4*)(md + scale_off + col);
    float4 sh = *(const float4*)(md + shift_off + col);
    float y0 = v[i].x * rstd * gg.x * (1.f + sc.x) + sh.x;
    float y1 = v[i].y * rstd * gg.y * (1.f + sc.y) + sh.y;
    float y2 = v[i].z * rstd * gg.z * (1.f + sc.z) + sh.z;
    float y3 = v[i].w * rstd * gg.w * (1.f + sc.w) + sh.w;
    if (TOBF) {
      uint2 o; o.x = pack2(y0, y1); o.y = pack2(y2, y3);
      *(uint2*)(dstb + (size_t)row * 1024 + col) = o;
    } else {
      *(float4*)(dstf + (size_t)row * 1024 + col) = make_float4(y0, y1, y2, y3);
    }
  }
}

__device__ __forceinline__ void mod_item(const P& p, int item, char* smem) {
  float* cond = (float*)smem;
  const int t = threadIdx.x;
  for (int i = t; i < 16384; i += NT) { float c = p.c[i]; cond[i] = c * sigmoidf(c); }
  __syncthreads();
  const int ks = t >> 5, cc = t & 31;
  const int n = item * 32 + cc;
  const float* W; int ldw; int nn; const float* bias;
  if (n < 6144) { W = p.ada_w; ldw = 6144; nn = n; bias = p.ada_b; }
  else { W = p.fada_w; ldw = 2048; nn = n - 6144; bias = p.fada_b; }
  float acc[16];
#pragma unroll
  for (int b = 0; b < 16; ++b) acc[b] = 0.f;
  for (int k = ks * 128; k < ks * 128 + 128; ++k) {
    float wv = W[(size_t)k * ldw + nn];
#pragma unroll
    for (int b = 0; b < 16; ++b) acc[b] += cond[b * 1024 + k] * wv;
  }
  __syncthreads();
  float* red = (float*)smem;
#pragma unroll
  for (int b = 0; b < 16; ++b) red[(ks * 16 + b) * 32 + cc] = acc[b];
  __syncthreads();
  for (int o = t; o < 512; o += NT) {
    int b = o >> 5, c2 = o & 31;
    float s = 0.f;
#pragma unroll
    for (int k2 = 0; k2 < 8; ++k2) s += red[(k2 * 16 + b) * 32 + c2];
    int n2 = item * 32 + c2;
    float bv = (n2 < 6144) ? p.ada_b[n2] : p.fada_b[n2 - 6144];
    p.mod[b * 8192 + n2] = s + bv;
  }
  __syncthreads();
  (void)bias;
}

__device__ __forceinline__ void tr_tile(const float* __restrict__ W, int K, int N, bf16* __restrict__ Wt,
                                        const float* __restrict__ rsA, const float* __restrict__ rsB, int splitK,
                                        int glu, int kt, int ntile, char* smem) {
  float* tile = (float*)smem;
  const int t = threadIdx.x;
  const int k0 = kt * 64, n0 = ntile * 64;
#pragma unroll
  for (int i = 0; i < 4; ++i) {
    int r = (t >> 4) + 16 * i, c4 = (t & 15) * 4;
    float4 v = make_float4(0.f, 0.f, 0.f, 0.f);
    if (n0 + c4 < N) v = *(const float4*)(W + (size_t)(k0 + r) * N + n0 + c4);
    float sc = 1.f;
    if (rsA) { int k = k0 + r; sc = (k < splitK) ? rsA[k] : rsB[k - splitK]; }
    tile[(c4 + 0) * 65 + r] = v.x * sc;
    tile[(c4 + 1) * 65 + r] = v.y * sc;
    tile[(c4 + 2) * 65 + r] = v.z * sc;
    tile[(c4 + 3) * 65 + r] = v.w * sc;
  }
  __syncthreads();
  {
    int n = t >> 2, ks = (t & 3) * 16;
    int no = n0 + n;
    if (glu) { int vv = (no < 512) ? no : no - 512; no = (vv >> 4) * 32 + (vv & 15) + ((no < 512) ? 0 : 16); }
    unsigned o[8];
#pragma unroll
    for (int j = 0; j < 8; ++j) o[j] = pack2(tile[n * 65 + ks + 2 * j], tile[n * 65 + ks + 2 * j + 1]);
    uint4* dp = (uint4*)(Wt + (size_t)no * K + k0 + ks);
    dp[0] = make_uint4(o[0], o[1], o[2], o[3]);
    dp[1] = make_uint4(o[4], o[5], o[6], o[7]);
  }
  __syncthreads();
}

__device__ __forceinline__ float2 cmul(float2 a, float2 b) {
  return make_float2(a.x * b.x - a.y * b.y, a.x * b.y + a.y * b.x);
}
__device__ __forceinline__ float2 lam_pow(float lre, float lim, float dt, int m) {
  float mag = __expf((float)m * lre * dt);
  float s, c;
  sincosf((float)m * lim * dt, &s, &c);
  return make_float2(mag * c, mag * s);
}
__device__ __forceinline__ float2 zoh_fac(float lre, float lim, float dt) {
  float2 lb = lam_pow(lre, lim, dt, 1);
  float nr = lb.x - 1.f, ni = lb.y;
  float den = lre * lre + lim * lim;
  return make_float2((nr * lre + ni * lim) / den, (ni * lre - nr * lim) / den);
}

__device__ __forceinline__ void ktab_item(const P& p, int item, char* smem) {
  float2* lamm = (float2*)smem;
  float2* fac = lamm + 64;
  const int t = threadIdx.x;
  const int g = item >> 6, m = item & 63;
  if (t < 64) {
    float lre = p.lam_re[g * 64 + t], lim = p.lam_im[g * 64 + t], dt = __expf(p.log_dt[g]);
    lamm[t] = lam_pow(lre, lim, dt, m);
    fac[t] = zoh_fac(lre, lim, dt);
  }
  __syncthreads();
  const int h = t >> 4, hp = t & 15;
  float s = 0.f;
  for (int pp = 0; pp < 64; ++pp) {
    float2 C = make_float2(p.c_re[(g * 16 + h) * 64 + pp], p.c_im[(g * 16 + h) * 64 + pp]);
    float2 B = make_float2(p.b_re[(g * 64 + pp) * 16 + hp], p.b_im[(g * 64 + pp) * 16 + hp]);
    float2 Bb = cmul(fac[pp], B);
    float2 CL = cmul(C, lamm[pp]);
    s += CL.x * Bb.x - CL.y * Bb.y;
  }
  p.ktab[((size_t)(g * 64 + m) * 16 + h) * 16 + hp] = s;
  __syncthreads();
}

#define TR_IN 320
#define TR_GLU 128
#define TR_UQ 72
#define TR_UKV 64
#define TR_OUT 256
#define TR_FF1 1024
#define TR_FF2 1024

template <int PH>
__device__ __forceinline__ void run_phase(const P& p, int bid, int nb, char* smem) {
  const int t = threadIdx.x;
  if (PH == 0) {
    const int n_mod = 256;
    const int n_tr = TR_IN + TR_GLU + TR_UQ + TR_UKV + TR_OUT + TR_FF1 + TR_FF2;
    const int n_kt = 2048;
    const int n_pw = (32 * 65 * 64) / 256;
    const int n_bb = (32 * 64 * 16) / 256;
    const int n_cs = (65536 * 16) / 256;
    const int total = n_mod + n_tr + n_kt + n_pw + n_bb + n_cs;
    for (int it = bid; it < total; it += nb) {
      int i = it;
      if (i < n_mod) { mod_item(p, i, smem); continue; }
      i -= n_mod;
      if (i < n_tr) {
        if (i < TR_IN) { tr_tile(p.w_in, 1024, 1184, p.Wt_in, nullptr, nullptr, 0, 0, i % 16, i / 16, smem); continue; }
        i -= TR_IN;
        if (i < TR_GLU) { tr_tile(p.w_glu, 512, 1024, p.Wt_glu, nullptr, nullptr, 0, 1, i % 8, i / 8, smem); continue; }
        i -= TR_GLU;
        if (i < TR_UQ) { tr_tile(p.w_uq, 384, 768, p.Wt_uq, p.q_norm_g, p.q_norm_g, 384, 0, i % 6, i / 6, smem); continue; }
        i -= TR_UQ;
        if (i < TR_UKV) { tr_tile(p.w_ukv, 256, 1024, p.Wt_ukv, p.kv_norm_g, p.kv_norm_g, 256, 0, i % 4, i / 4, smem); continue; }
        i -= TR_UKV;
        if (i < TR_OUT) { tr_tile(p.w_out, 1024, 1024, p.Wt_out, p.ssm_out_g, p.attn_out_g, 512, 0, i % 16, i / 16, smem); continue; }
        i -= TR_OUT;
        if (i < TR_FF1) { tr_tile(p.w_ff1, 1024, 4096, p.Wt_ff1, nullptr, nullptr, 0, 0, i % 16, i / 16, smem); continue; }
        i -= TR_FF1;
        tr_tile(p.w_ff2, 4096, 1024, p.Wt_ff2, nullptr, nullptr, 0, 0, i % 64, i / 64, smem);
        continue;
      }
      i -= n_tr;
      if (i < n_kt) { ktab_item(p, i, smem); continue; }
      i -= n_kt;
      if (i < n_pw) {
        int idx = i * 256 + t;
        int pp = idx & 63, m = (idx >> 6) % 65, g = idx / (64 * 65);
        float dt = __expf(p.log_dt[g]);
        p.pw[idx] = lam_pow(p.lam_re[g * 64 + pp], p.lam_im[g * 64 + pp], dt, m);
        continue;
      }
      i -= n_pw;
      if (i < n_bb) {
        int idx = i * 256 + t;
        int gp = idx >> 4;
        int g = gp >> 6;
        float dt = __expf(p.log_dt[g]);
        float2 f = zoh_fac(p.lam_re[gp], p.lam_im[gp], dt);
        p.bbar[idx] = cmul(f, make_float2(p.b_re[idx], p.b_im[idx]));
        continue;
      }
      i -= n_bb;
      {
        int idx = i * 256 + t;
        int tok = idx >> 4, ii = idx & 15;
        float invf = exp2f(-(float)ii * (13.287712379549449f / 16.f));
        float ang = (float)p.pos[tok] * invf;
        float s, c;
        sincosf(ang, &s, &c);
        p.cs[idx] = make_float2(c, s);
      }
    }
  } else if (PH == 1) {
    const int n_norm = 16384;
    const int n_te = (32 * 1024 * 144) / 256;
    const int n_f = (32 * 128 * 128) / 256;
    const int total = n_norm + n_te + n_f;
    for (int it = bid; it < total; it += nb) {
      int i = it;
      if (i < n_norm) { norm_rows<true>(p, p.x, p.norm1_g, 0, 1024, p.hbuf, nullptr, i); continue; }
      i -= n_norm;
      if (i < n_te) {
        int idx = i * 256 + t;
        int k8 = idx % 144, n = (idx / 144) & 1023, g = idx / (144 * 1024);
        int k = k8 * 8, j = n >> 4, h = n & 15;
        float v[8];
        if (k < 1024) {
          int ii = k >> 4, hp0 = k & 15;
          if (ii <= j) {
            const float* kp = p.ktab + ((size_t)(g * 64 + (j - ii)) * 16 + h) * 16 + hp0;
            float4 a = *(const float4*)kp, b = *(const float4*)(kp + 4);
            v[0] = a.x; v[1] = a.y; v[2] = a.z; v[3] = a.w; v[4] = b.x; v[5] = b.y; v[6] = b.z; v[7] = b.w;
          } else {
#pragma unroll
            for (int q = 0; q < 8; ++q) v[q] = 0.f;
          }
        } else {
          int q = k - 1024, p0 = q & 63, isim = q >> 6;
#pragma unroll
          for (int jj = 0; jj < 8; ++jj) {
            int pp = p0 + jj;
            float2 C = make_float2(p.c_re[(g * 16 + h) * 64 + pp], p.c_im[(g * 16 + h) * 64 + pp]);
            float2 L = p.pw[(size_t)(g * 65 + j + 1) * 64 + pp];
            float2 pr = cmul(C, L);
            v[jj] = isim ? -pr.y : pr.x;
          }
        }
        uint4 o = make_uint4(pack2(v[0], v[1]), pack2(v[2], v[3]), pack2(v[4], v[5]), pack2(v[6], v[7]));
        *(uint4*)(p.Bty + ((size_t)(g * 1024 + n)) * 1152 + k) = o;
        continue;
      }
      i -= n_te;
      {
        int idx = i * 256 + t;
        int k8 = idx & 127, n = (idx >> 7) & 127, g = idx >> 14;
        int k = k8 * 8, ii = k >> 4, hp0 = k & 15;
        int pp = n & 63, isim = n >> 6;
        float2 L = p.pw[(size_t)(g * 65 + 63 - ii) * 64 + pp];
        float v[8];
#pragma unroll
        for (int jj = 0; jj < 8; ++jj) {
          float2 pr = cmul(L, p.bbar[(size_t)(g * 64 + pp) * 16 + hp0 + jj]);
          v[jj] = isim ? pr.y : pr.x;
        }
        uint4 o = make_uint4(pack2(v[0], v[1]), pack2(v[2], v[3]), pack2(v[4], v[5]), pack2(v[6], v[7]));
        *(uint4*)(p.Fm + ((size_t)(g * 128 + n)) * 1024 + k) = o;
      }
    }
  } else if (PH == 2) {
    const int total = 512 * 10;
    for (int it = bid; it < total; it += nb) {
      int mt = it / 10, nt = it % 10;
      gemm_tile<EPI_INPROJ, 0>(p, p.hbuf, 1024, p.Wt_in, 1024, 16, 16, 0, mt * 128, nt * 128, 0, smem);
    }
  } else if (PH == 3) {
    const int nq = 512 * 6, nkv = 512 * 8, ns = 256;
    const int total = nq + nkv + ns;
    for (int it = bid; it < total; it += nb) {
      int i = it;
      if (i < nkv) { gemm_tile<EPI_KV, 1>(p, p.kvlat, 256, p.Wt_ukv, 256, 4, 4, 0, (i / 8) * 128, (i % 8) * 128, 0, smem); continue; }
      i -= nkv;
      if (i < nq) { gemm_tile<EPI_Q, 1>(p, p.qlat, 384, p.Wt_uq, 384, 6, 6, 0, (i / 6) * 128, (i % 6) * 128, 0, smem); continue; }
      i -= nq;
      {
        int g = i >> 3, mt = i & 7;
        gemm_tile<EPI_S, 0>(p, p.Ag + (size_t)g * 1024 * 1152, 1152, p.Fm + (size_t)g * 128 * 1024, 1024, 16, 16, 0,
                            mt * 128, 0, g, smem);
      }
    }
  } else if (PH == 4) {
    const int total = 32768 / 256;
    for (int it = bid; it < total; it += nb) {
      int idx = it * 256 + t;
      int pp = idx & 63, b = (idx >> 6) & 15, g = idx >> 10;
      float2 LL = p.pw[(size_t)(g * 65 + 64) * 64 + pp];
      float2 X = make_float2(0.f, 0.f);
      for (int c = 0; c < 64; ++c) {
        size_t row = (size_t)(g * 1024 + b * 64 + c);
        p.Ag[row * 1152 + 1024 + pp] = f2bf(X.x);
        p.Ag[row * 1152 + 1088 + pp] = f2bf(X.y);
        float sr = p.S[row * 128 + pp], si = p.S[row * 128 + 64 + pp];
        float2 nx = cmul(LL, X);
        X = make_float2(nx.x + sr, nx.y + si);
      }
    }
  } else if (PH == 5) {
    const int na = 4096, ny = 2048;
    const int total = na + ny;
    for (int it = bid; it < total; it += nb) {
      int i = it;
      if (i < na) {
        int qt = 31 - (i >> 7), bh = i & 127;
        attn_item(p, bh, qt, smem);
        continue;
      }
      i -= na;
      {
        int g = i >> 6, mt = (i >> 3) & 7, nt = i & 7;
        int nk1 = 2 * nt + 2;
        gemm_tile<EPI_Y, 0>(p, p.Ag + (size_t)g * 1024 * 1152, 1152, p.Bty + (size_t)g * 1024 * 1152, 1152, nk1 + 2,
                            nk1, 16, mt * 128, nt * 128, g, smem);
      }
    }
  } else if (PH == 6) {
    const int total = 512 * 8;
    for (int it = bid; it < total; it += nb)
      gemm_tile<EPI_GLU, 0>(p, p.ygelu, 512, p.Wt_glu, 512, 8, 8, 0, (it / 8) * 128, (it % 8) * 128, 0, smem);
  } else if (PH == 7) {
    const int total = 512 * 8;
    for (int it = bid; it < total; it += nb)
      gemm_tile<EPI_OUT, 2>(p, p.ycat, 1024, p.Wt_out, 1024, 16, 16, 0, (it / 8) * 128, (it % 8) * 128, 0, smem);
  } else if (PH == 8) {
    for (int it = bid; it < 16384; it += nb) norm_rows<true>(p, p.out, p.norm2_g, 3072, 4096, p.hbuf, nullptr, it);
  } else if (PH == 9) {
    const int total = 512 * 32;
    for (int it = bid; it < total; it += nb)
      gemm_tile<EPI_FF1, 0>(p, p.hbuf, 1024, p.Wt_ff1, 1024, 16, 16, 0, (it / 32) * 128, (it % 32) * 128, 0, smem);
  } else if (PH == 10) {
    const int total = 512 * 8;
    for (int it = bid; it < total; it += nb)
      gemm_tile<EPI_FF2, 0>(p, p.hid, 4096, p.Wt_ff2, 4096, 64, 64, 0, (it / 8) * 128, (it % 8) * 128, 0, smem);
  } else if (PH == 11) {
    for (int it = bid; it < 16384; it += nb) norm_rows<false>(p, p.out, p.fnorm_g, 6144, 7168, nullptr, p.out, it);
  }
}

template <int PH>
__global__ void __launch_bounds__(NT, 2) k_phase(P p) {
  __shared__ __attribute__((aligned(16))) char smem[SMEM_BYTES];
  run_phase<PH>(p, blockIdx.x, gridDim.x, smem);
}

__global__ void __launch_bounds__(NT, 2) k_mega(P p) {
  __shared__ __attribute__((aligned(16))) char smem[SMEM_BYTES];
  cg::grid_group grid = cg::this_grid();
  const int bid = blockIdx.x, nb = gridDim.x;
  run_phase<0>(p, bid, nb, smem); grid.sync();
  run_phase<1>(p, bid, nb, smem); grid.sync();
  run_phase<2>(p, bid, nb, smem); grid.sync();
  run_phase<3>(p, bid, nb, smem); grid.sync();
  run_phase<4>(p, bid, nb, smem); grid.sync();
  run_phase<5>(p, bid, nb, smem); grid.sync();
  run_phase<6>(p, bid, nb, smem); grid.sync();
  run_phase<7>(p, bid, nb, smem); grid.sync();
  run_phase<8>(p, bid, nb, smem); grid.sync();
  run_phase<9>(p, bid, nb, smem); grid.sync();
  run_phase<10>(p, bid, nb, smem); grid.sync();
  run_phase<11>(p, bid, nb, smem);
}

extern "C" void kernel_launch(void* const* d_in, const int* in_sizes, int n_in, void* d_out, int out_size, void* d_ws,
                              size_t ws_size, hipStream_t stream) {
  P p{};
  p.x = (const float*)d_in[0]; p.c = (const float*)d_in[1]; p.pos = (const int*)d_in[2];
  p.ada_w = (const float*)d_in[3]; p.ada_b = (const float*)d_in[4]; p.norm1_g = (const float*)d_in[5];
  p.w_in = (const float*)d_in[6]; p.lam_re = (const float*)d_in[7]; p.lam_im = (const float*)d_in[8];
  p.b_re = (const float*)d_in[9]; p.b_im = (const float*)d_in[10]; p.c_re = (const float*)d_in[11];
  p.c_im = (const float*)d_in[12]; p.ssm_d = (const float*)d_in[13]; p.log_dt = (const float*)d_in[14];
  p.w_glu = (const float*)d_in[15]; p.q_norm_g = (const float*)d_in[16]; p.w_uq = (const float*)d_in[17];
  p.kv_norm_g = (const float*)d_in[18]; p.w_ukv = (const float*)d_in[19]; p.ssm_out_g = (const float*)d_in[20];
  p.attn_out_g = (const float*)d_in[21]; p.w_out = (const float*)d_in[22]; p.norm2_g = (const float*)d_in[23];
  p.w_ff1 = (const float*)d_in[24]; p.w_ff2 = (const float*)d_in[25]; p.fada_w = (const float*)d_in[26];
  p.fada_b = (const float*)d_in[27]; p.fnorm_g = (const float*)d_in[28];
  p.out = (float*)d_out;
  char* ws = (char*)d_ws;
  size_t off = 0;
  auto take = [&](size_t bytes) { char* r = ws + off; off += (bytes + 255) & ~(size_t)255; return r; };
  p.Wt_in = (bf16*)take(1280ull * 1024 * 2);
  p.Wt_glu = (bf16*)take(1024ull * 512 * 2);
  p.Wt_uq = (bf16*)take(768ull * 384 * 2);
  p.Wt_ukv = (bf16*)take(1024ull * 256 * 2);
  p.Wt_out = (bf16*)take(1024ull * 1024 * 2);
  p.Wt_ff1 = (bf16*)take(4096ull * 1024 * 2);
  p.Wt_ff2 = (bf16*)take(1024ull * 4096 * 2);
  p.mod = (float*)take(16ull * 8192 * 4);
  p.pw = (float2*)take(32ull * 65 * 64 * 8);
  p.bbar = (float2*)take(32ull * 64 * 16 * 8);
  p.ktab = (float*)take(32ull * 64 * 256 * 4);
  p.cs = (float2*)take(65536ull * 16 * 8);
  p.hbuf = (bf16*)take(65536ull * 1024 * 2);
  size_t region = off;
  p.Ag = (bf16*)take(32ull * 1024 * 1152 * 2);
  p.Bty = (bf16*)take(32ull * 1024 * 1152 * 2);
  p.Fm = (bf16*)take(32ull * 128 * 1024 * 2);
  p.S = (float*)take(32ull * 1024 * 128 * 4);
  p.qlat = (bf16*)take(65536ull * 384 * 2);
  p.kvlat = (bf16*)take(65536ull * 256 * 2);
  p.Q = (bf16*)take(128ull * 4096 * 96 * 2);
  p.Kc = (bf16*)take(128ull * 4096 * 96 * 2);
  p.Vt = (bf16*)take(128ull * 64 * 4096 * 2);
  p.ygelu = (bf16*)take(65536ull * 512 * 2);
  p.ycat = (bf16*)take(65536ull * 1024 * 2);
  p.hid = (bf16*)(ws + region);

#if ONE_LAUNCH
  static int grid_blocks = 0;
  if (!grid_blocks) {
    int dev = 0, cus = 0, per_cu = 0;
    hipGetDevice(&dev);
    hipDeviceGetAttribute(&cus, hipDeviceAttributeMultiprocessorCount, dev);
    hipOccupancyMaxActiveBlocksPerMultiprocessor(&per_cu, k_mega, NT, 0);
    if (per_cu > 2) per_cu = 2;
    if (per_cu < 1) per_cu = 1;
    grid_blocks = cus * per_cu;
  }
  void* args[] = {&p};
  hipError_t e = hipLaunchCooperativeKernel((void*)k_mega, dim3(grid_blocks), dim3(NT), args, 0, stream);
  if (e != hipSuccess) fprintf(stderr, "cooperative launch failed: %s (grid %d)\n", hipGetErrorString(e), grid_blocks);
#else
  const int G = 1024;
  k_phase<0><<<G, NT, 0, stream>>>(p);
  k_phase<1><<<G, NT, 0, stream>>>(p);
  k_phase<2><<<G, NT, 0, stream>>>(p);
  k_phase<3><<<G, NT, 0, stream>>>(p);
  k_phase<4><<<G, NT, 0, stream>>>(p);
  k_phase<5><<<G, NT, 0, stream>>>(p);
  k_phase<6><<<G, NT, 0, stream>>>(p);
  k_phase<7><<<G, NT, 0, stream>>>(p);
  k_phase<8><<<G, NT, 0, stream>>>(p);
  k_phase<9><<<G, NT, 0, stream>>>(p);
  k_phase<10><<<G, NT, 0, stream>>>(p);
  k_phase<11><<<G, NT, 0, stream>>>(p);
#endif
}
```

```cpp
#include <hip/hip_runtime.h>
#include <hip/hip_cooperative_groups.h>
#include <stdint.h>
#include <cstdio>
namespace cg = cooperative_groups;

#ifndef ONE_LAUNCH
#define ONE_LAUNCH 1
#endif

typedef unsigned short bf16;
typedef __attribute__((ext_vector_type(8))) short bf16x8;
typedef __attribute__((ext_vector_type(4))) float f32x4;
typedef __attribute__((ext_vector_type(16))) float f32x16;

#define NT 512
#define HSMEM (73728 + 1024)
#define SMEM_BYTES (2 * HSMEM)
#define LAS __attribute__((address_space(3)))
#define EPSN 1e-6f
#define QSCALE (0.10206207261596577f * 1.4426950408889634f)

struct P {
  const float *x, *c; const int* pos;
  const float *ada_w, *ada_b, *norm1_g, *w_in, *lam_re, *lam_im, *b_re, *b_im, *c_re, *c_im, *ssm_d, *log_dt,
      *w_glu, *q_norm_g, *w_uq, *kv_norm_g, *w_ukv, *ssm_out_g, *attn_out_g, *w_out, *norm2_g, *w_ff1, *w_ff2,
      *fada_w, *fada_b, *fnorm_g;
  float* out;
  bf16 *Wt_in, *Wt_glu, *Wt_uq, *Wt_ukv, *Wt_out, *Wt_ff1, *Wt_ff2;
  float* mod; float2* pw; float2* bbar; float* ktab; float2* cs;
  bf16* hbuf; bf16 *Ag, *Bty, *Fm; float* S;
  bf16 *qlat, *kvlat, *Q, *Kc, *Vt, *ygelu, *ycat, *hid;
  float *rss_q, *rss_kv, *rss_s, *rss_a, *rss_x, *biasff;
};

__device__ __forceinline__ int otid() { int t = threadIdx.x; asm volatile("" : "+v"(t)); return t; }
__device__ __forceinline__ float bf2f(unsigned h) { return __uint_as_float(h << 16); }
__device__ __forceinline__ unsigned pack2(float a, float b) {
  typedef __attribute__((ext_vector_type(2))) __bf16 bf2;
  bf2 v; v[0] = (__bf16)a; v[1] = (__bf16)b;
  return __builtin_bit_cast(unsigned, v);
}
__device__ __forceinline__ bf16 f2bf(float a) { return (bf16)(pack2(a, 0.f) & 0xffffu); }
__device__ __forceinline__ float sq2(unsigned w) {
  float a = __uint_as_float(w << 16), b = __uint_as_float(w & 0xffff0000u);
  return a * a + b * b;
}
__device__ __forceinline__ float4 ld_nt4(const float* q) { f32x4 w = __builtin_nontemporal_load((const f32x4*)q); return make_float4(w[0], w[1], w[2], w[3]); }
__device__ __forceinline__ void st_nt4(float* q, float4 v) { f32x4 w; w[0] = v.x; w[1] = v.y; w[2] = v.z; w[3] = v.w; __builtin_nontemporal_store(w, (f32x4*)q); }
__device__ __forceinline__ float gelu_tanh(float x) {
  float z = 0.7978845608028654f * (x + 0.044715f * x * x * x);
  float e = __expf(2.f * z);
  float th = 1.f - 2.f / (e + 1.f);
  return 0.5f * x * (1.f + th);
}
__device__ __forceinline__ float sigmoidf(float x) { return 1.f / (1.f + __expf(-x)); }

enum { EPI_INPROJ = 0, EPI_Q, EPI_KV, EPI_S, EPI_Y, EPI_GLU, EPI_OUT, EPI_FF1, EPI_FF2 };

template <int EPI, int PRE>
__device__ __forceinline__ void gemm_tile(const P& p, const bf16* __restrict__ A, int lda, const bf16* __restrict__ Bt,
                                          int ldb, int nt_total, int nk1, int kjump, int m0, int n0, int g,
                                          char* smem) {
  bf16* As = (bf16*)smem;
  bf16* Bs = As + 2 * 128 * 72;
  float* rs = (float*)(Bs + 2 * 128 * 72);
  const int t = otid() & 255, w = __builtin_amdgcn_readfirstlane(t >> 6), l = t & 63, wm = w >> 1, wn = w & 1, lr = l & 15, lq = l >> 4;

  if (PRE == 1) {
    const int K = nt_total * 64;
    int row = t >> 1, hf = t & 1;
    const bf16* ap = A + (size_t)(m0 + row) * lda + hf * (K / 2);
    float ss = 0.f;
    for (int c = 0; c < K / 16; ++c) {
      uint4 v = *(const uint4*)(ap + c * 8);
      ss += sq2(v.x) + sq2(v.y) + sq2(v.z) + sq2(v.w);
    }
    ss += __shfl_xor(ss, 1);
    if (!hf) rs[row] = rsqrtf(ss / (float)K + EPSN);
  }
  if (PRE == 2) {
    int row = t >> 1, hf = t & 1;
    const bf16* ap = A + (size_t)(m0 + row) * lda + hf * 512;
    float ss = 0.f;
    for (int c = 0; c < 64; ++c) {
      uint4 v = *(const uint4*)(ap + c * 8);
      ss += sq2(v.x) + sq2(v.y) + sq2(v.z) + sq2(v.w);
    }
    rs[hf * 128 + row] = rsqrtf(ss / 512.f + EPSN);
  }

  f32x4 acc[4][4];
#pragma unroll
  for (int i = 0; i < 4; ++i)
#pragma unroll
    for (int j = 0; j < 4; ++j) acc[i][j] = (f32x4){0.f, 0.f, 0.f, 0.f};

  const int ldrow = t >> 3, ldkc = (t & 7) * 8;
  const bf16* Ap = A + (size_t)(m0 + ldrow) * lda + ldkc;
  const bf16* Bp = Bt + (size_t)(n0 + ldrow) * ldb + ldkc;
  uint4 ra[4], rb[4];
  {
    int kt = (0 < nk1) ? 0 : kjump;
#pragma unroll
    for (int i = 0; i < 4; ++i) {
      ra[i] = *(const uint4*)(Ap + (size_t)i * 32 * lda + kt * 64);
      rb[i] = *(const uint4*)(Bp + (size_t)i * 32 * ldb + kt * 64);
    }
#pragma unroll
    for (int i = 0; i < 4; ++i) {
      *(uint4*)(As + (ldrow + 32 * i) * 72 + ldkc) = ra[i];
      *(uint4*)(Bs + (ldrow + 32 * i) * 72 + ldkc) = rb[i];
    }
  }
  __syncthreads();

  for (int it = 0; it < nt_total; ++it) {
    const int buf = it & 1;
    const bool more = (it + 1 < nt_total);
    if (more) {
      int kt = (it + 1 < nk1) ? (it + 1) : (it + 1 - nk1 + kjump);
#pragma unroll
      for (int i = 0; i < 4; ++i) {
        ra[i] = *(const uint4*)(Ap + (size_t)i * 32 * lda + kt * 64);
        rb[i] = *(const uint4*)(Bp + (size_t)i * 32 * ldb + kt * 64);
      }
    }
    if (PRE == 2) {
      if (it == 8) {
#pragma unroll
        for (int mt = 0; mt < 4; ++mt)
#pragma unroll
          for (int r = 0; r < 4; ++r) {
            int rl = wm * 64 + mt * 16 + lq * 4 + r;
            float f = rs[rl] / rs[128 + rl];
#pragma unroll
            for (int nt = 0; nt < 4; ++nt) acc[mt][nt][r] *= f;
          }
      }
    }
    const bf16* Ab = As + buf * (128 * 72) + (wm * 64 + lr) * 72 + lq * 8;
    const bf16* Bb = Bs + buf * (128 * 72) + (wn * 64 + lr) * 72 + lq * 8;
#pragma unroll
    for (int ks = 0; ks < 2; ++ks) {
      bf16x8 a[4], b[4];
#pragma unroll
      for (int i = 0; i < 4; ++i) {
        a[i] = *(const bf16x8*)(Ab + i * 16 * 72 + ks * 32);
        b[i] = *(const bf16x8*)(Bb + i * 16 * 72 + ks * 32);
      }
      __builtin_amdgcn_s_setprio(1);
#pragma unroll
      for (int mt = 0; mt < 4; ++mt)
#pragma unroll
        for (int nt = 0; nt < 4; ++nt)
          acc[mt][nt] = __builtin_amdgcn_mfma_f32_16x16x32_bf16(a[mt], b[nt], acc[mt][nt], 0, 0, 0);
      __builtin_amdgcn_s_setprio(0);
    }
    if (more) {
#pragma unroll
      for (int i = 0; i < 4; ++i) {
        *(uint4*)(As + (buf ^ 1) * (128 * 72) + (ldrow + 32 * i) * 72 + ldkc) = ra[i];
        *(uint4*)(Bs + (buf ^ 1) * (128 * 72) + (ldrow + 32 * i) * 72 + ldkc) = rb[i];
      }
    }
    __syncthreads();
  }

#pragma unroll
  for (int mt = 0; mt < 4; ++mt) {
    const int rl0 = wm * 64 + mt * 16 + lq * 4;
    const int row0 = m0 + rl0;
#pragma unroll
    for (int nt = 0; nt < 4; ++nt) {
      const int cb = n0 + wn * 64 + nt * 16;
      const int col = cb + lr;
      if (EPI == EPI_INPROJ) {
        if (cb < 512) {
          const int gg = cb >> 4;
#pragma unroll
          for (int r = 0; r < 4; ++r) {
            int row = row0 + r, b = row >> 12, s = row & 4095, c = s >> 6, j = s & 63;
            p.Ag[((size_t)(gg * 1024 + b * 64 + c)) * 1152 + j * 16 + lr] = f2bf(acc[mt][nt][r]);
          }
        } else if (cb < 896) {
#pragma unroll
          for (int r = 0; r < 4; ++r) p.qlat[(size_t)(row0 + r) * 384 + (col - 512)] = f2bf(acc[mt][nt][r]);
        } else if (cb < 1152) {
#pragma unroll
          for (int r = 0; r < 4; ++r) p.kvlat[(size_t)(row0 + r) * 256 + (col - 896)] = f2bf(acc[mt][nt][r]);
        } else if (cb == 1152) {
          if (nt < 3) {
#pragma unroll
            for (int r = 0; r < 4; ++r) {
              int row = row0 + r, b = row >> 12, s = row & 4095;
              float2 cs = p.cs[(size_t)row * 16 + lr];
              float x1 = acc[mt][nt][r], x2 = acc[mt][nt < 3 ? nt + 1 : nt][r];
              bf16 o1 = f2bf(x1 * cs.x - x2 * cs.y), o2 = f2bf(x1 * cs.y + x2 * cs.x);
#pragma unroll
              for (int h = 0; h < 8; ++h) {
                bf16* kp = p.Kc + ((size_t)((b * 8 + h) * 4096 + s)) * 96;
                kp[64 + lr] = o1;
                kp[80 + lr] = o2;
              }
            }
          }
        }
      } else if (EPI == EPI_Q) {
        const int hq = cb / 96, d0 = cb - hq * 96;
        if (d0 < 64) {
#pragma unroll
          for (int r = 0; r < 4; ++r) {
            int row = row0 + r, b = row >> 12, s = row & 4095;
            float v = acc[mt][nt][r] * rs[rl0 + r] * QSCALE;
            p.Q[((size_t)((b * 8 + hq) * 4096 + s)) * 96 + d0 + lr] = f2bf(v);
          }
        } else if (d0 == 64) {
          if (nt < 3) {
#pragma unroll
            for (int r = 0; r < 4; ++r) {
              int row = row0 + r, b = row >> 12, s = row & 4095;
              float sc = rs[rl0 + r] * QSCALE;
              float x1 = acc[mt][nt][r] * sc, x2 = acc[mt][nt < 3 ? nt + 1 : nt][r] * sc;
              float2 cs = p.cs[(size_t)row * 16 + lr];
              bf16* qp = p.Q + ((size_t)((b * 8 + hq) * 4096 + s)) * 96;
              qp[64 + lr] = f2bf(x1 * cs.x - x2 * cs.y);
              qp[80 + lr] = f2bf(x1 * cs.y + x2 * cs.x);
            }
          }
        }
      } else if (EPI == EPI_KV) {
        const int hk = cb >> 7, d0 = cb & 127;
        const int b = row0 >> 12, s0 = row0 & 4095;
        if (d0 < 64) {
#pragma unroll
          for (int r = 0; r < 4; ++r)
            p.Kc[((size_t)((b * 8 + hk) * 4096 + s0 + r)) * 96 + d0 + lr] = f2bf(acc[mt][nt][r] * rs[rl0 + r]);
        } else {
          uint2 v;
          v.x = pack2(acc[mt][nt][0] * rs[rl0 + 0], acc[mt][nt][1] * rs[rl0 + 1]);
          v.y = pack2(acc[mt][nt][2] * rs[rl0 + 2], acc[mt][nt][3] * rs[rl0 + 3]);
          *(uint2*)(p.Vt + ((size_t)((b * 8 + hk) * 64 + (d0 - 64) + lr)) * 4096 + s0) = v;
        }
      } else if (EPI == EPI_S) {
#pragma unroll
        for (int r = 0; r < 4; ++r) ((float*)smem)[(rl0 + r) * 129 + col] = acc[mt][nt][r];
      } else if (EPI == EPI_Y) {
        const float dd = p.ssm_d[g * 16 + lr];
        const int j = cb >> 4;
#pragma unroll
        for (int r = 0; r < 4; ++r) {
          int row = row0 + r, b = row >> 6, c = row & 63;
          float u = bf2f(p.Ag[((size_t)(g * 1024 + row)) * 1152 + col]);
          float y = gelu_tanh(acc[mt][nt][r] + dd * u);
          p.ygelu[((size_t)(b * 4096 + c * 64 + j)) * 512 + g * 16 + lr] = f2bf(y);
        }
      } else if (EPI == EPI_GLU) {
        if ((nt & 1) == 0) {
          const int oc = (cb >> 5) * 16 + lr;
#pragma unroll
          for (int r = 0; r < 4; ++r) {
            float v = acc[mt][nt][r] * sigmoidf(acc[mt][(nt & 1) == 0 ? nt + 1 : nt][r]);
            p.ycat[(size_t)(row0 + r) * 1024 + oc] = f2bf(v);
          }
        }
      } else if (EPI == EPI_OUT) {
#pragma unroll
        for (int r = 0; r < 4; ++r) {
          int row = row0 + r, b = row >> 12;
          size_t o = (size_t)row * 1024 + col;
          p.out[o] = p.x[o] + p.mod[b * 8192 + 2048 + col] * acc[mt][nt][r] * rs[128 + rl0 + r];
        }
      } else if (EPI == EPI_FF1) {
#pragma unroll
        for (int r = 0; r < 4; ++r) {
          float v = fmaxf(acc[mt][nt][r], 0.f);
          p.hid[(size_t)(row0 + r) * 4096 + col] = f2bf(v * v);
        }
      } else if (EPI == EPI_FF2) {
#pragma unroll
        for (int r = 0; r < 4; ++r) {
          int row = row0 + r, b = row >> 12;
          size_t o = (size_t)row * 1024 + col;
          p.out[o] = p.out[o] + p.mod[b * 8192 + 5120 + col] * acc[mt][nt][r];
        }
      }
    }
  }
  if (PRE != 0) __syncthreads();
}

__device__ __forceinline__ int lds_byte(int r, int c) {
  int st = (r >> 4) * 2 + (c >> 5), rr = r & 15, cc = c & 31, ob = rr * 64 + cc * 2;
  return st * 1024 + (ob ^ (((ob >> 9) & 1) << 5));
}
__device__ __forceinline__ void stage_rc(int b, int& R, int& C) {
  int st = b / 1024, sb = b % 1024, swz = sb ^ (((sb >> 9) & 1) << 5);
  R = (st >> 1) * 16 + swz / 64;
  C = (st & 1) * 32 + (swz % 64) / 2;
}

template <int CTRL>
__device__ __forceinline__ float dpp_f(float v) {
  return __int_as_float(__builtin_amdgcn_update_dpp(0, __float_as_int(v), CTRL, 0xf, 0xf, false));
}
__device__ __forceinline__ float row16_sum(float v) {
  v += dpp_f<0xB1>(v);
  v += dpp_f<0x4E>(v);
  v += dpp_f<0x124>(v);
  v += dpp_f<0x128>(v);
  return v;
}
__device__ __forceinline__ float xhalf_sum(float x) {
  typedef __attribute__((ext_vector_type(2))) unsigned u2_t;
  const unsigned xi = __float_as_uint(x);
  u2_t r = __builtin_amdgcn_permlane32_swap(xi, xi, false, false);
  return __uint_as_float(r[0]) + __uint_as_float(r[1]);
}
#define RS_OFF 139264
#define STB_PITCH 272
#define STF_PITCH 260
#define KST_PITCH 136
#define VT_OFF 69632
#define VT_PITCH 264

typedef __attribute__((ext_vector_type(2))) unsigned u32x2;
typedef __attribute__((ext_vector_type(4))) unsigned u32x4;
__device__ __forceinline__ void lds_st2(LAS bf16* q, uint2 v) { u32x2 w; w[0] = v.x; w[1] = v.y; *(LAS u32x2*)q = w; }
__device__ __forceinline__ void lds_st4f(LAS float* q, float4 v) { f32x4 w; w[0] = v.x; w[1] = v.y; w[2] = v.z; w[3] = v.w; *(LAS f32x4*)q = w; }
__device__ __forceinline__ uint4 lds_ld4(LAS bf16* q) { u32x4 w = *(LAS u32x4*)q; return make_uint4(w[0], w[1], w[2], w[3]); }
__device__ __forceinline__ float4 lds_ld4f(LAS float* q) { f32x4 w = *(LAS f32x4*)q; return make_float4(w[0], w[1], w[2], w[3]); }

#define EPI_BAR asm volatile("s_waitcnt lgkmcnt(0)\n\ts_barrier" ::: "memory")
template <int EPI>
__device__ __forceinline__ void epi256(const P& p, f32x4 (&acc)[2][2][4][2], int brow, int bcol, LAS unsigned char* lds) {
  const int tid = otid(), wid = __builtin_amdgcn_readfirstlane(tid >> 6), lane = tid & 63, wr = wid >> 2,
            wc = wid & 3, fr = lane & 15, fq = lane >> 4;
  LAS bf16* stb = (LAS bf16*)lds;
  LAS float* stf = (LAS float*)lds;

  if (EPI == EPI_OUT || EPI == EPI_FF2) {
    const float* src = (EPI == EPI_OUT) ? p.x : p.out;
    const int goff = (EPI == EPI_OUT) ? 2048 : 5120;
    const int c4 = (tid & 63) * 4, col = bcol + c4, bb = brow >> 12, rw = tid >> 6;
    const float4 g4 = *(const float4*)(p.mod + bb * 8192 + goff + col);
    float4 n4 = make_float4(0.f, 0.f, 0.f, 0.f);
    if (EPI == EPI_OUT) {
      const float4 ng = *(const float4*)(p.norm2_g + col);
      const float4 sc2 = *(const float4*)(p.mod + bb * 8192 + 4096 + col);
      n4 = make_float4(ng.x * (1.f + sc2.x), ng.y * (1.f + sc2.y), ng.z * (1.f + sc2.z), ng.w * (1.f + sc2.w));
    }
#pragma unroll
    for (int ai = 0; ai < 2; ++ai) {
      float4 xp[16];
#pragma unroll
      for (int i = 0; i < 16; ++i) xp[i] = ld_nt4(src + (size_t)(brow + ai * 128 + i * 8 + rw) * 1024 + col);
#pragma unroll
      for (int m = 0; m < 4; ++m) {
        const int rl = wr * 64 + m * 16 + fr;
        float sc = 1.f;
        if (EPI == EPI_OUT) sc = rsqrtf(((LAS float*)(lds + RS_OFF))[ai * 128 + rl] * (1.f / 512.f) + EPSN);
#pragma unroll
        for (int bj = 0; bj < 2; ++bj)
#pragma unroll
          for (int n = 0; n < 2; ++n) {
            const int cl = bj * 128 + wc * 32 + n * 16 + fq * 4;
            f32x4 v = acc[ai][bj][m][n];
            lds_st4f(stf + rl * STF_PITCH + cl, make_float4(v[0] * sc, v[1] * sc, v[2] * sc, v[3] * sc));
          }
      }
      EPI_BAR;
#pragma unroll
      for (int i = 0; i < 16; ++i) {
        const int row = i * 8 + rw;
        float4 v = lds_ld4f(stf + row * STF_PITCH + c4);
        const int grow = brow + ai * 128 + row;
        const float4 x4 = xp[i];
        const float y0 = x4.x + g4.x * v.x, y1 = x4.y + g4.y * v.y, y2 = x4.z + g4.z * v.z, y3 = x4.w + g4.w * v.w;
        st_nt4(p.out + (size_t)grow * 1024 + col, make_float4(y0, y1, y2, y3));
        if (EPI == EPI_OUT) {
          *(uint2*)(p.hbuf + (size_t)grow * 1024 + col) = make_uint2(pack2(y0 * n4.x, y1 * n4.y), pack2(y2 * n4.z, y3 * n4.w));
          float ss = y0 * y0 + y1 * y1 + y2 * y2 + y3 * y3;
          ss = row16_sum(ss); ss += __shfl_xor(ss, 16); ss = xhalf_sum(ss);
          if ((tid & 63) == 0) atomicAdd(p.rss_x + grow, ss);
        }
      }
      EPI_BAR;
    }
    return;
  }

#pragma unroll
  for (int ai = 0; ai < 2; ++ai)
#pragma unroll
    for (int m = 0; m < 4; ++m) {
      const int rl = ai * 128 + wr * 64 + m * 16 + fr;
      const int row = brow + rl;
      float rsv = 1.f;
      LAS float* rsl = (LAS float*)(lds + RS_OFF);
      if (EPI == EPI_FF1) rsv = rsqrtf(rsl[rl] * (1.f / 1024.f) + EPSN);
      if (EPI == EPI_Q) rsv = rsqrtf(rsl[rl] * (1.f / 384.f) + EPSN) * QSCALE;
      if (EPI == EPI_KV) rsv = rsqrtf(rsl[rl] * (1.f / 256.f) + EPSN);
#pragma unroll
      for (int bj = 0; bj < 2; ++bj)
#pragma unroll
        for (int n = 0; n < 2; ++n) {
          const int cl = bj * 128 + wc * 32 + n * 16 + fq * 4;
          const int cb = bcol + bj * 128 + wc * 32 + n * 16;
          const f32x4 v = acc[ai][bj][m][n];
          const f32x4 vn = acc[ai][bj][m][1];
          if (EPI == EPI_FF1) {
            const float4 bi = lds_ld4f((LAS float*)(lds + RS_OFF + 1024) + cl);
            float a0 = fmaxf(v[0] * rsv + bi.x, 0.f), a1 = fmaxf(v[1] * rsv + bi.y, 0.f);
            float a2 = fmaxf(v[2] * rsv + bi.z, 0.f), a3 = fmaxf(v[3] * rsv + bi.w, 0.f);
            lds_st2(stb + rl * STB_PITCH + cl, make_uint2(pack2(a0 * a0, a1 * a1), pack2(a2 * a2, a3 * a3)));
          } else if (EPI == EPI_GLU) {
            if (n == 0) {
              const int oc = bj * 64 + wc * 16 + fq * 4;
              lds_st2(stb + rl * STB_PITCH + oc, make_uint2(pack2(v[0] * sigmoidf(vn[0]), v[1] * sigmoidf(vn[1])),
                             pack2(v[2] * sigmoidf(vn[2]), v[3] * sigmoidf(vn[3]))));
            }
          } else if (EPI == EPI_KV) {
            if (wc < 2) {
              lds_st2(stb + rl * KST_PITCH + bj * 64 + wc * 32 + n * 16 + fq * 4, make_uint2(pack2(v[0] * rsv, v[1] * rsv), pack2(v[2] * rsv, v[3] * rsv)));
            } else {
              LAS bf16* vt = (LAS bf16*)(lds + VT_OFF) + (bj * 64 + (wc - 2) * 32 + n * 16 + fq * 4) * VT_PITCH + rl;
              vt[0] = f2bf(v[0] * rsv); vt[VT_PITCH] = f2bf(v[1] * rsv);
              vt[2 * VT_PITCH] = f2bf(v[2] * rsv); vt[3 * VT_PITCH] = f2bf(v[3] * rsv);
            }
          } else if (EPI == EPI_Q) {
            const int hq = cb / 96, d0 = cb - hq * 96;
            if (d0 < 64) {
              lds_st2(stb + rl * STB_PITCH + cl, make_uint2(pack2(v[0] * rsv, v[1] * rsv), pack2(v[2] * rsv, v[3] * rsv)));
            } else if (d0 == 64) {
              if (n == 0) {
                const float4 c01 = *(const float4*)(p.cs + (size_t)row * 16 + fq * 4);
                const float4 c23 = *(const float4*)(p.cs + (size_t)row * 16 + fq * 4 + 2);
                float x10 = v[0] * rsv, x11 = v[1] * rsv, x12 = v[2] * rsv, x13 = v[3] * rsv;
                float x20 = vn[0] * rsv, x21 = vn[1] * rsv, x22 = vn[2] * rsv, x23 = vn[3] * rsv;
                lds_st2(stb + rl * STB_PITCH + cl, make_uint2(pack2(x10 * c01.x - x20 * c01.y, x11 * c01.z - x21 * c01.w),
                               pack2(x12 * c23.x - x22 * c23.y, x13 * c23.z - x23 * c23.w)));
                lds_st2(stb + rl * STB_PITCH + cl + 16, make_uint2(pack2(x10 * c01.y + x20 * c01.x, x11 * c01.w + x21 * c01.z),
                               pack2(x12 * c23.y + x22 * c23.x, x13 * c23.w + x23 * c23.z)));
              }
            }
          } else if (EPI == EPI_INPROJ) {
            if (cb < 1152) {
              lds_st2(stb + rl * STB_PITCH + cl, make_uint2(pack2(v[0], v[1]), pack2(v[2], v[3])));
            } else if (cb == 1152) {
              if (n == 0) {
                const float4 c01 = *(const float4*)(p.cs + (size_t)row * 16 + fq * 4);
                const float4 c23 = *(const float4*)(p.cs + (size_t)row * 16 + fq * 4 + 2);
                lds_st2(stb + rl * STB_PITCH + cl,
                        make_uint2(pack2(v[0] * c01.x - vn[0] * c01.y, v[1] * c01.z - vn[1] * c01.w),
                                   pack2(v[2] * c23.x - vn[2] * c23.y, v[3] * c23.z - vn[3] * c23.w)));
                lds_st2(stb + rl * STB_PITCH + cl + 16,
                        make_uint2(pack2(v[0] * c01.y + vn[0] * c01.x, v[1] * c01.w + vn[1] * c01.z),
                                   pack2(v[2] * c23.y + vn[2] * c23.x, v[3] * c23.w + vn[3] * c23.z)));
              }
            }
          }
        }
    }
  EPI_BAR;

  if (EPI == EPI_FF1) {
#pragma unroll
    for (int i = 0; i < 16; ++i) {
      const int chunk = i * 512 + tid, row = chunk >> 5, c8 = (chunk & 31) * 8;
      uint4 v = lds_ld4(stb + row * STB_PITCH + c8);
      u32x4 vv; vv[0] = v.x; vv[1] = v.y; vv[2] = v.z; vv[3] = v.w;
      __builtin_nontemporal_store(vv, (u32x4*)(p.hid + (size_t)(brow + row) * 4096 + bcol + c8));
    }
  } else if (EPI == EPI_GLU) {
#pragma unroll
    for (int i = 0; i < 8; ++i) {
      const int chunk = i * 512 + tid, row = chunk >> 4, c8 = (chunk & 15) * 8;
      uint4 v = lds_ld4(stb + row * STB_PITCH + c8);
      *(uint4*)(p.ycat + (size_t)(brow + row) * 1024 + (bcol >> 1) + c8) = v;
      float ss = sq2(v.x) + sq2(v.y) + sq2(v.z) + sq2(v.w);
      ss = row16_sum(ss);
      if ((tid & 15) == 0) atomicAdd(p.rss_s + brow + row, ss);
    }
  } else if (EPI == EPI_KV) {
    const int b = brow >> 12, s0 = brow & 4095, h0 = bcol >> 7;
#pragma unroll
    for (int i = 0; i < 8; ++i) {
      const int chunk = i * 512 + tid, row = chunk >> 4, c8 = (chunk & 15) * 8;
      uint4 v = lds_ld4(stb + row * KST_PITCH + c8);
      *(uint4*)(p.Kc + ((size_t)((b * 8 + h0 + (c8 >> 6)) * 4096 + s0 + row)) * 96 + (c8 & 63)) = v;
    }
#pragma unroll
    for (int i = 0; i < 8; ++i) {
      const int chunk = i * 512 + tid, vrow = chunk >> 5, s8 = (chunk & 31) * 8;
      uint4 v = lds_ld4((LAS bf16*)(lds + VT_OFF) + vrow * VT_PITCH + s8);
      *(uint4*)(p.Vt + ((size_t)((b * 8 + h0 + (vrow >> 6)) * 64 + (vrow & 63))) * 4096 + s0 + s8) = v;
    }
  } else if (EPI == EPI_Q) {
    const int b = brow >> 12, s0 = brow & 4095;
#pragma unroll
    for (int i = 0; i < 16; ++i) {
      const int chunk = i * 512 + tid, row = chunk >> 5, c8 = (chunk & 31) * 8;
      uint4 v = lds_ld4(stb + row * STB_PITCH + c8);
      const int cg = bcol + c8, hq = cg / 96, d = cg - hq * 96;
      *(uint4*)(p.Q + ((size_t)((b * 8 + hq) * 4096 + s0 + row)) * 96 + d) = v;
    }
  } else if (EPI == EPI_INPROJ) {
    if (bcol < 512) {
      const int b = brow >> 12, c0 = (brow & 4095) >> 6, g0 = bcol >> 4;
#pragma unroll
      for (int i = 0; i < 16; ++i) {
        const int q = i * 512 + tid, hh = q & 1, j = (q >> 1) & 63, cl = (q >> 7) & 3, gl = q >> 9;
        uint4 v = lds_ld4(stb + (cl * 64 + j) * STB_PITCH + gl * 16 + hh * 8);
        *(uint4*)(p.Ag + ((size_t)((g0 + gl) * 1024 + b * 64 + c0 + cl)) * 1152 + j * 16 + hh * 8) = v;
      }
    } else {
#pragma unroll
      for (int i = 0; i < 16; ++i) {
        const int chunk = i * 512 + tid, row = chunk >> 5, c8 = (chunk & 31) * 8;
        const int cg = bcol + c8;
        float ss = 0.f;
        if (cg >= 1152 && cg < 1184) {
          uint4 v = lds_ld4(stb + row * STB_PITCH + c8);
          const int grow = brow + row, bq = grow >> 12, sq = grow & 4095;
#pragma unroll
          for (int h = 0; h < 8; ++h)
            *(uint4*)(p.Kc + ((size_t)((bq * 8 + h) * 4096 + sq)) * 96 + 64 + (cg - 1152)) = v;
        }
        if (cg < 1152) {
          uint4 v = lds_ld4(stb + row * STB_PITCH + c8);
          if (cg < 896) *(uint4*)(p.qlat + (size_t)(brow + row) * 384 + (cg - 512)) = v;
          else *(uint4*)(p.kvlat + (size_t)(brow + row) * 256 + (cg - 896)) = v;
          ss = sq2(v.x) + sq2(v.y) + sq2(v.z) + sq2(v.w);
        }
        ss = row16_sum(ss);
        if ((tid & 15) == 0 && cg < 1152) atomicAdd((cg < 896 ? p.rss_q : p.rss_kv) + brow + row, ss);
      }
    }
  }
  EPI_BAR;
}

template <int EPI, int PRE>
__device__ __forceinline__ void gemm256(const P& p, const bf16* __restrict__ A, int lda, const bf16* __restrict__ Bt,
                                        int ldb, int K, int brow, int bcol, LAS unsigned char* lds) {
  const int tid = otid(), wid = __builtin_amdgcn_readfirstlane(tid >> 6), lane = tid & 63, wr = wid >> 2,
            wc = wid & 3, fr = lane & 15, fq = lane >> 4;
  const int nt = K / 64;
  if (EPI == EPI_Q || EPI == EPI_KV || EPI == EPI_FF1 || EPI == EPI_OUT) {
    const float* r0 = (EPI == EPI_Q) ? p.rss_q : (EPI == EPI_KV) ? p.rss_kv : (EPI == EPI_FF1) ? p.rss_x : p.rss_a;
    if (wid < 4) {
      __builtin_amdgcn_global_load_lds((const unsigned*)(r0 + brow + wid * 64 + lane), (LAS unsigned*)(lds + RS_OFF + wid * 256), 4, 0, 0);
    } else if (EPI == EPI_OUT) {
      __builtin_amdgcn_global_load_lds((const unsigned*)(p.rss_s + brow + (wid - 4) * 64 + lane), (LAS unsigned*)(lds + RS_OFF + 1024 + (wid - 4) * 256), 4, 0, 0);
    } else if (EPI == EPI_FF1) {
      __builtin_amdgcn_global_load_lds((const unsigned*)(p.biasff + (brow >> 12) * 4096 + bcol + (wid - 4) * 64 + lane), (LAS unsigned*)(lds + RS_OFF + 1024 + (wid - 4) * 256), 4, 0, 0);
    }
  }
  int R0, C0, R1, C1;
  stage_rc(tid * 16, R0, C0);
  stage_rc(tid * 16 + 8192, R1, C1);
  const unsigned voA0 = (unsigned)(R0 * lda + C0) * 2u, voA1 = (unsigned)(R1 * lda + C1) * 2u;
  const unsigned voB0 = (unsigned)(R0 * ldb + C0) * 2u, voB1 = (unsigned)(R1 * ldb + C1) * 2u;
  const char* Abase = (const char*)(A + (size_t)brow * lda);
  const char* Bbase = (const char*)(Bt + (size_t)bcol * ldb);
  const size_t ahalf = (size_t)128 * lda * 2, bhalf = (size_t)128 * ldb * 2;
  const unsigned ldsw = (unsigned)wid * 1024u;
  const int aoff = lds_byte(wr * 64 + fr, fq * 8), boff = lds_byte(wc * 32 + fr, fq * 8);
#define G_SA(b, h) (((b) * 2 + (h)) * 16384)
#define G_SB(b, h) ((4 + (b) * 2 + (h)) * 16384)
#define G_STA(b, h, kt) do { const char* gb_ = Abase + (h) * ahalf + (size_t)(kt) * 128; \
    __builtin_amdgcn_global_load_lds((const unsigned*)(gb_ + voA0), (LAS unsigned*)(lds + G_SA(b, h) + ldsw), 16, 0, 0); \
    __builtin_amdgcn_global_load_lds((const unsigned*)(gb_ + voA1), (LAS unsigned*)(lds + G_SA(b, h) + ldsw + 8192), 16, 0, 0); } while (0)
#define G_STB(b, h, kt) do { const char* gb_ = Bbase + (h) * bhalf + (size_t)(kt) * 128; \
    __builtin_amdgcn_global_load_lds((const unsigned*)(gb_ + voB0), (LAS unsigned*)(lds + G_SB(b, h) + ldsw), 16, 0, 0); \
    __builtin_amdgcn_global_load_lds((const unsigned*)(gb_ + voB1), (LAS unsigned*)(lds + G_SB(b, h) + ldsw + 8192), 16, 0, 0); } while (0)
#define G_LDA(dst, b, h) do { _Pragma("unroll") for (int m = 0; m < 4; ++m) _Pragma("unroll") for (int k = 0; k < 2; ++k) \
    dst[m][k] = *(const LAS bf16x8*)(lds + G_SA(b, h) + aoff + m * 2048 + k * 1024); } while (0)
#define G_LDB(dst, b, h) do { _Pragma("unroll") for (int n = 0; n < 2; ++n) _Pragma("unroll") for (int k = 0; k < 2; ++k) \
    dst[n][k] = *(const LAS bf16x8*)(lds + G_SB(b, h) + boff + n * 2048 + k * 1024); } while (0)
#define G_MMA(ai, bj, At_, Bt_) do { __builtin_amdgcn_s_setprio(1); \
    _Pragma("unroll") for (int m = 0; m < 4; ++m) _Pragma("unroll") for (int n = 0; n < 2; ++n) _Pragma("unroll") for (int k = 0; k < 2; ++k) \
      acc[ai][bj][m][n] = __builtin_amdgcn_mfma_f32_16x16x32_bf16(Bt_[n][k], At_[m][k], acc[ai][bj][m][n], 0, 0, 0); \
    __builtin_amdgcn_s_setprio(0); } while (0)
#define G_WV(n) asm volatile("s_waitcnt vmcnt(" #n ")" ::: "memory")
#define G_WL(n) asm volatile("s_waitcnt lgkmcnt(" #n ")" ::: "memory")
#define G_BAR __builtin_amdgcn_s_barrier()
#define G_SCHED __builtin_amdgcn_sched_barrier(0)

  f32x4 acc[2][2][4][2];
#pragma unroll
  for (int a = 0; a < 2; ++a)
#pragma unroll
    for (int b = 0; b < 2; ++b)
#pragma unroll
      for (int m = 0; m < 4; ++m)
#pragma unroll
        for (int n = 0; n < 2; ++n) acc[a][b][m][n] = (f32x4){0.f, 0.f, 0.f, 0.f};
  bf16x8 At[4][2], B0[2][2], B1[2][2];

  G_STB(0, 0, 0); G_STA(0, 0, 0); G_STB(0, 1, 0); G_STA(0, 1, 0);
  if (wr == 1) G_BAR;
  G_WV(4); G_BAR;
  G_STB(1, 0, 1); G_STA(1, 0, 1); G_STB(1, 1, 1);
  G_WV(6); G_BAR;
  const int tmid = (PRE == 2) ? 8 : (nt - 2);
  for (int t = 0; t < tmid; t += 2) {
    G_LDB(B0, 0, 0); G_SCHED; G_LDA(At, 0, 0); G_STA(1, 1, t + 1);
    G_WL(8); G_BAR; G_WL(0); G_MMA(0, 0, At, B0); G_BAR; G_SCHED;
    G_LDB(B1, 0, 1); G_STB(0, 0, t + 2);
    G_BAR; G_WL(0); G_MMA(0, 1, At, B1); G_BAR;
    G_LDA(At, 0, 1); G_STA(0, 0, t + 2);
    G_BAR; G_WL(0); G_MMA(1, 0, At, B0); G_BAR; G_SCHED;
    G_STB(0, 1, t + 2);
    G_WV(6); G_BAR; G_MMA(1, 1, At, B1); G_BAR;
    G_LDB(B0, 1, 0); G_SCHED; G_LDA(At, 1, 0); G_STA(0, 1, t + 2);
    G_WL(8); G_BAR; G_WL(0); G_MMA(0, 0, At, B0); G_BAR; G_SCHED;
    G_LDB(B1, 1, 1); G_STB(1, 0, t + 3);
    G_BAR; G_WL(0); G_MMA(0, 1, At, B1); G_BAR;
    G_LDA(At, 1, 1); G_STA(1, 0, t + 3);
    G_BAR; G_WL(0); G_MMA(1, 0, At, B0); G_BAR; G_SCHED;
    G_STB(1, 1, t + 3);
    G_WV(6); G_BAR; G_MMA(1, 1, At, B1); G_BAR;
    }
  if (PRE == 2) {
    const int tid2 = otid(), wr2 = __builtin_amdgcn_readfirstlane(tid2 >> 8), fr2 = tid2 & 15;
#pragma unroll
    for (int a = 0; a < 2; ++a)
#pragma unroll
      for (int m = 0; m < 4; ++m) {
        const int rl = a * 128 + wr2 * 64 + m * 16 + fr2;
        LAS float* rsl = (LAS float*)(lds + RS_OFF);
        const float f = rsqrtf(rsl[256 + rl] * (1.f / 512.f) + EPSN) / rsqrtf(rsl[rl] * (1.f / 512.f) + EPSN);
#pragma unroll
        for (int b = 0; b < 2; ++b)
#pragma unroll
          for (int n = 0; n < 2; ++n) acc[a][b][m][n] *= f;
      }
  }
  if (PRE == 2) {
  for (int t = 8; t < nt - 2; t += 2) {
    G_LDB(B0, 0, 0); G_SCHED; G_LDA(At, 0, 0); G_STA(1, 1, t + 1);
    G_WL(8); G_BAR; G_WL(0); G_MMA(0, 0, At, B0); G_BAR; G_SCHED;
    G_LDB(B1, 0, 1); G_STB(0, 0, t + 2);
    G_BAR; G_WL(0); G_MMA(0, 1, At, B1); G_BAR;
    G_LDA(At, 0, 1); G_STA(0, 0, t + 2);
    G_BAR; G_WL(0); G_MMA(1, 0, At, B0); G_BAR; G_SCHED;
    G_STB(0, 1, t + 2);
    G_WV(6); G_BAR; G_MMA(1, 1, At, B1); G_BAR;
    G_LDB(B0, 1, 0); G_SCHED; G_LDA(At, 1, 0); G_STA(0, 1, t + 2);
    G_WL(8); G_BAR; G_WL(0); G_MMA(0, 0, At, B0); G_BAR; G_SCHED;
    G_LDB(B1, 1, 1); G_STB(1, 0, t + 3);
    G_BAR; G_WL(0); G_MMA(0, 1, At, B1); G_BAR;
    G_LDA(At, 1, 1); G_STA(1, 0, t + 3);
    G_BAR; G_WL(0); G_MMA(1, 0, At, B0); G_BAR; G_SCHED;
    G_STB(1, 1, t + 3);
    G_WV(6); G_BAR; G_MMA(1, 1, At, B1); G_BAR;
    }
  }
  {
    G_LDB(B0, 0, 0); G_LDA(At, 0, 0); G_STA(1, 1, nt - 1);
    G_BAR; G_WL(0); G_MMA(0, 0, At, B0); G_BAR;
    G_LDB(B1, 0, 1); G_BAR; G_WL(0); G_MMA(0, 1, At, B1); G_BAR;
    G_LDA(At, 0, 1); G_WV(4); G_BAR; G_WL(0); G_MMA(1, 0, At, B0); G_MMA(1, 1, At, B1); G_BAR;
  }
  {
    G_LDB(B0, 1, 0); G_LDA(At, 1, 0); G_WV(2); G_BAR; G_WL(0); G_MMA(0, 0, At, B0); G_BAR;
    G_LDB(B1, 1, 1); G_WV(0); G_BAR; G_WL(0); G_MMA(0, 1, At, B1); G_BAR;
    G_LDA(At, 1, 1); G_BAR; G_WL(0); G_MMA(1, 0, At, B0); G_MMA(1, 1, At, B1); G_BAR;
  }
  if (wr == 0) G_BAR;

  epi256<EPI>(p, acc, brow, bcol, lds);
}

template <int EPI, int PRE>
__device__ __forceinline__ void gemm256_phase(const P& p, const bf16* A, int lda, const bf16* Bt, int ldb, int K,
                                              int NN, int bid, int nb, LAS unsigned char* lds) {
  if (nb == 256) {
    const int x = bid & 7, j = bid >> 3;
    for (int k = 0; k < NN; ++k) {
      int L = j + 32 * k;
      int mt = x * 32 + L / NN, nt = L % NN;
      if (NN == 16) { mt = x * 32 + (k >> 2) * 8 + (j & 7); nt = (k & 3) * 4 + (j >> 3); }
      gemm256<EPI, PRE>(p, A, lda, Bt, ldb, K, mt * 256, nt * 256, lds);
    }
  } else {
    for (int it = bid; it < 256 * NN; it += nb) gemm256<EPI, PRE>(p, A, lda, Bt, ldb, K, (it / NN) * 256, (it % NN) * 256, lds);
  }
}

#define KSTR 104
#define VSTR 68
#define ATT_BUF (64 * KSTR + 64 * VSTR)

__device__ __forceinline__ void att_qk(const bf16* Kb, const bf16x8 (&qf)[6], int qi, int half, f32x16& s0, f32x16& s1) {
#pragma unroll
  for (int r = 0; r < 16; ++r) { s0[r] = 0.f; s1[r] = 0.f; }
#pragma unroll
  for (int ks = 0; ks < 6; ++ks) {
    bf16x8 a0 = *(const bf16x8*)(Kb + qi * KSTR + ks * 16 + half * 8);
    bf16x8 a1 = *(const bf16x8*)(Kb + (32 + qi) * KSTR + ks * 16 + half * 8);
    s0 = __builtin_amdgcn_mfma_f32_32x32x16_bf16(a0, qf[ks], s0, 0, 0, 0);
    s1 = __builtin_amdgcn_mfma_f32_32x32x16_bf16(a1, qf[ks], s1, 0, 0, 0);
  }
}

__device__ __forceinline__ void att_softmax_pv(const bf16* Vb, f32x16& s0, f32x16& s1, f32x16& o0, f32x16& o1,
                                               float& mrun, float& lsum, int qi, int half, bool domask, int kbase,
                                               int qpos) {
  if (domask) {
#pragma unroll
    for (int r = 0; r < 16; ++r) {
      int key = kbase + (r >> 2) * 8 + half * 4 + (r & 3);
      if (key > qpos) s0[r] = -INFINITY;
      if (key + 32 > qpos) s1[r] = -INFINITY;
    }
  }
  float mt_ = s0[0];
#pragma unroll
  for (int r = 1; r < 16; ++r) mt_ = fmaxf(mt_, s0[r]);
#pragma unroll
  for (int r = 0; r < 16; ++r) mt_ = fmaxf(mt_, s1[r]);
  mt_ = fmaxf(mt_, __shfl_xor(mt_, 32));
  const float mnew = fmaxf(mrun, mt_);
  const float alpha = __builtin_amdgcn_exp2f(mrun - mnew);
  mrun = mnew;
  float ps = 0.f;
#pragma unroll
  for (int r = 0; r < 16; ++r) { s0[r] = __builtin_amdgcn_exp2f(s0[r] - mnew); ps += s0[r]; }
#pragma unroll
  for (int r = 0; r < 16; ++r) { s1[r] = __builtin_amdgcn_exp2f(s1[r] - mnew); ps += s1[r]; }
  lsum = lsum * alpha + ps;
#pragma unroll
  for (int r = 0; r < 16; ++r) { o0[r] *= alpha; o1[r] *= alpha; }
#pragma unroll
  for (int kk = 0; kk < 4; ++kk) {
    unsigned pk[4];
#pragma unroll
    for (int j = 0; j < 4; ++j) {
      float a = (kk < 2) ? s0[(kk & 1) * 8 + 2 * j] : s1[(kk & 1) * 8 + 2 * j];
      float b = (kk < 2) ? s0[(kk & 1) * 8 + 2 * j + 1] : s1[(kk & 1) * 8 + 2 * j + 1];
      pk[j] = pack2(a, b);
    }
    bf16x8 pb = __builtin_bit_cast(bf16x8, make_uint4(pk[0], pk[1], pk[2], pk[3]));
    const bf16* v0p = Vb + qi * VSTR + kk * 16 + half * 4;
    const bf16* v1p = Vb + (32 + qi) * VSTR + kk * 16 + half * 4;
    uint2 a0l = *(const uint2*)(v0p), a0h = *(const uint2*)(v0p + 8);
    uint2 a1l = *(const uint2*)(v1p), a1h = *(const uint2*)(v1p + 8);
    bf16x8 av0 = __builtin_bit_cast(bf16x8, make_uint4(a0l.x, a0l.y, a0h.x, a0h.y));
    bf16x8 av1 = __builtin_bit_cast(bf16x8, make_uint4(a1l.x, a1l.y, a1h.x, a1h.y));
    o0 = __builtin_amdgcn_mfma_f32_32x32x16_bf16(av0, pb, o0, 0, 0, 0);
    o1 = __builtin_amdgcn_mfma_f32_32x32x16_bf16(av1, pb, o1, 0, 0, 0);
  }
}

__device__ __forceinline__ void attn_item(const P& p, int bh, int qt, char* smem) {
  bf16* Ks = (bf16*)smem;
  const int t = otid() & 255, w = __builtin_amdgcn_readfirstlane(t >> 6), l = t & 63, qi = l & 31, half = l >> 5;
  const int q0 = qt * 128, wq0 = q0 + w * 32;
  const bf16* Qp = p.Q + ((size_t)bh * 4096 + wq0 + qi) * 96;
  bf16x8 qf[6];
#pragma unroll
  for (int ks = 0; ks < 6; ++ks) qf[ks] = *(const bf16x8*)(Qp + ks * 16 + half * 8);
  asm volatile("s_waitcnt vmcnt(0)" ::: "memory");
#pragma unroll
  for (int ks = 0; ks < 6; ++ks) asm volatile("" : "+v"(qf[ks]));
  const bf16* Kg = p.Kc + (size_t)bh * 4096 * 96;
  const bf16* Vg = p.Vt + (size_t)bh * 64 * 4096;
  const int nkt = 2 * qt + 2, nfull = 2 * qt;

  const int kr0r = t / 12, kr0c = t - kr0r * 12;
  const int kr1r = (t + 256) / 12, kr1c = (t + 256) - kr1r * 12;
  const int kr2r = (t + 512) / 12, kr2c = (t + 512) - kr2r * 12;
  const int vrow = t >> 3, vkc = t & 7;
  const bf16* kg0 = Kg + (size_t)kr0r * 96 + kr0c * 8;
  const bf16* kg1 = Kg + (size_t)kr1r * 96 + kr1c * 8;
  const bf16* kg2 = Kg + (size_t)kr2r * 96 + kr2c * 8;
  const bf16* vg0 = Vg + (size_t)vrow * 4096 + vkc * 8;
  const bf16* vg1 = Vg + (size_t)(vrow + 32) * 4096 + vkc * 8;
  const int ks0 = kr0r * KSTR + kr0c * 8, ks1 = kr1r * KSTR + kr1c * 8, ks2 = kr2r * KSTR + kr2c * 8;
  const int vs0 = 64 * KSTR + vrow * VSTR + vkc * 8, vs1 = 64 * KSTR + (vrow + 32) * VSTR + vkc * 8;
  uint4 kra, krb, krc, vra, vrb;
#define ATT_GLOAD(kt_) do { kra = *(const uint4*)(kg0 + (size_t)(kt_) * 64 * 96); krb = *(const uint4*)(kg1 + (size_t)(kt_) * 64 * 96); \
    krc = *(const uint4*)(kg2 + (size_t)(kt_) * 64 * 96); vra = *(const uint4*)(vg0 + (kt_) * 64); vrb = *(const uint4*)(vg1 + (kt_) * 64); } while (0)
#define ATT_LSTORE(buf_) do { bf16* kb_ = Ks + (buf_) * ATT_BUF; \
    *(uint4*)(kb_ + ks0) = kra; *(uint4*)(kb_ + ks1) = krb; *(uint4*)(kb_ + ks2) = krc; \
    ((uint2*)(kb_ + vs0))[0] = make_uint2(vra.x, vra.y); ((uint2*)(kb_ + vs0))[1] = make_uint2(vra.z, vra.w); \
    ((uint2*)(kb_ + vs1))[0] = make_uint2(vrb.x, vrb.y); ((uint2*)(kb_ + vs1))[1] = make_uint2(vrb.z, vrb.w); } while (0)
  ATT_GLOAD(0);
  ATT_LSTORE(0);
  ATT_GLOAD(1);
  ATT_LSTORE(1);
  __syncthreads();

  f32x16 o0, o1, sc0, sc1, sn0, sn1;
#pragma unroll
  for (int r = 0; r < 16; ++r) { o0[r] = 0.f; o1[r] = 0.f; sn0[r] = 0.f; sn1[r] = 0.f; }
  float mrun = -INFINITY, lsum = 0.f;
  const int qpos = wq0 + qi;
  att_qk(Ks, qf, qi, half, sc0, sc1);
  int bc = 0, bn = 1, bnn = 2;
  int kt = 0;
  for (; kt < nfull - 1; ++kt) {
    ATT_GLOAD(kt + 2);
    att_qk(Ks + bn * ATT_BUF, qf, qi, half, sn0, sn1);
    att_softmax_pv(Ks + bc * ATT_BUF + 64 * KSTR, sc0, sc1, o0, o1, mrun, lsum, qi, half, false, 0, qpos);
    ATT_LSTORE(bnn);
    __syncthreads();
    sc0 = sn0; sc1 = sn1;
    { int tb = bc; bc = bn; bn = bnn; bnn = tb; }
  }
  for (; kt < nkt; ++kt) {
    const bool more2 = (kt + 2 < nkt);
    if (more2) ATT_GLOAD(kt + 2);
    const bool need_next = (kt + 1 < nkt) && ((kt + 1) * 64 <= wq0 + 31);
    if (need_next) att_qk(Ks + bn * ATT_BUF, qf, qi, half, sn0, sn1);
    if (kt * 64 <= wq0 + 31)
      att_softmax_pv(Ks + bc * ATT_BUF + 64 * KSTR, sc0, sc1, o0, o1, mrun, lsum, qi, half, (kt * 64 + 63 > wq0), kt * 64, qpos);
    if (more2) ATT_LSTORE(bnn);
    __syncthreads();
    sc0 = sn0; sc1 = sn1;
    { int tb = bc; bc = bn; bn = bnn; bnn = tb; }
  }
  const float ltot = lsum + __shfl_xor(lsum, 32);
  const float inv = 1.f / ltot;
  const int b = bh >> 3, h = bh & 7;
  bf16* op = p.ycat + ((size_t)(b * 4096 + wq0 + qi)) * 1024 + 512 + h * 64 + half * 4;
  {
    float ss = 0.f;
#pragma unroll
    for (int r = 0; r < 16; ++r) { float a0 = o0[r] * inv, a1 = o1[r] * inv; ss += a0 * a0 + a1 * a1; }
    ss += __shfl_xor(ss, 32);
    if (half == 0) atomicAdd(p.rss_a + b * 4096 + wq0 + qi, ss);
  }
#pragma unroll
  for (int rg = 0; rg < 4; ++rg) {
    uint2 v0, v1;
    v0.x = pack2(o0[rg * 4 + 0] * inv, o0[rg * 4 + 1] * inv);
    v0.y = pack2(o0[rg * 4 + 2] * inv, o0[rg * 4 + 3] * inv);
    v1.x = pack2(o1[rg * 4 + 0] * inv, o1[rg * 4 + 1] * inv);
    v1.y = pack2(o1[rg * 4 + 2] * inv, o1[rg * 4 + 3] * inv);
    *(uint2*)(op + rg * 8) = v0;
    *(uint2*)(op + 32 + rg * 8) = v1;
  }
}

#define A2_STAGE 20480
#define A2_VOFF 12288
#define A2_NST 6

__device__ __forceinline__ void a2_qk(LAS unsigned char* st, const bf16x8 (&qf)[6], int qi, int half, f32x16& s0, f32x16& s1) {
#pragma unroll
  for (int r = 0; r < 16; ++r) { s0[r] = 0.f; s1[r] = 0.f; }
  bf16x8 a0[6], a1[6];
#pragma unroll
  for (int ks = 0; ks < 6; ++ks) {
    a0[ks] = *(const LAS bf16x8*)(st + ks * 2048 + qi * 32 + half * 16);
    a1[ks] = *(const LAS bf16x8*)(st + ks * 2048 + (32 + qi) * 32 + half * 16);
  }
  __builtin_amdgcn_sched_barrier(0);
  __builtin_amdgcn_s_setprio(1);
#pragma unroll
  for (int ks = 0; ks < 6; ++ks) {
    s0 = __builtin_amdgcn_mfma_f32_32x32x16_bf16(a0[ks], qf[ks], s0, 0, 0, 0);
    s1 = __builtin_amdgcn_mfma_f32_32x32x16_bf16(a1[ks], qf[ks], s1, 0, 0, 0);
  }
  __builtin_amdgcn_s_setprio(0);
}

__device__ __forceinline__ float xhalf_max(float x) {
  typedef __attribute__((ext_vector_type(2))) unsigned u2_t;
  const unsigned xi = __float_as_uint(x);
  u2_t r = __builtin_amdgcn_permlane32_swap(xi, xi, false, false);
  return fmaxf(__uint_as_float(r[0]), __uint_as_float(r[1]));
}
__device__ __forceinline__ void a2_mask(f32x16& s0, f32x16& s1, int half, int kbase, int qpos) {
#pragma unroll
  for (int r = 0; r < 16; ++r) {
    int key = kbase + (r >> 2) * 8 + half * 4 + (r & 3);
    if (key > qpos) s0[r] = -INFINITY;
    if (key + 32 > qpos) s1[r] = -INFINITY;
  }
}
__device__ __forceinline__ float a2_lanemax(const f32x16& s0, const f32x16& s1) {
  float m = s0[0];
#pragma unroll
  for (int r = 1; r < 16; ++r) m = fmaxf(m, s0[r]);
#pragma unroll
  for (int r = 0; r < 16; ++r) m = fmaxf(m, s1[r]);
  return m;
}
__device__ __forceinline__ void a2_update(float mt_, float& mrun, float& lsum, f32x16& o0, f32x16& o1) {
  mt_ = xhalf_max(mt_);
  if (__builtin_amdgcn_ballot_w64(mt_ > mrun + 8.f) != 0) {
    const float mnew = fmaxf(mrun, mt_);
    const float alpha = __builtin_amdgcn_exp2f(mrun - mnew);
    mrun = mnew;
    lsum *= alpha;
#pragma unroll
    for (int r = 0; r < 16; ++r) { o0[r] *= alpha; o1[r] *= alpha; }
  }
}
__device__ __forceinline__ float a2_exp(f32x16& s0, f32x16& s1, float mrun) {
  float ps = 0.f;
#pragma unroll
  for (int r = 0; r < 16; ++r) { s0[r] = __builtin_amdgcn_exp2f(s0[r] - mrun); ps += s0[r]; }
#pragma unroll
  for (int r = 0; r < 16; ++r) { s1[r] = __builtin_amdgcn_exp2f(s1[r] - mrun); ps += s1[r]; }
  return ps;
}
struct A2V { u32x2 vl0[4], vh0[4], vl1[4], vh1[4]; };
__device__ __forceinline__ void a2_vload(LAS unsigned char* vst, int qi, int half, A2V& f) {
  const int sw = (qi >> 1) & 7;
  LAS unsigned char* v0row = vst + qi * 128 + half * 8;
  LAS unsigned char* v1row = vst + (32 + qi) * 128 + half * 8;
#pragma unroll
  for (int kk = 0; kk < 4; ++kk) {
    const int olo = ((kk * 2) ^ sw) * 16, ohi = ((kk * 2 + 1) ^ sw) * 16;
    f.vl0[kk] = *(const LAS u32x2*)(v0row + olo); f.vh0[kk] = *(const LAS u32x2*)(v0row + ohi);
    f.vl1[kk] = *(const LAS u32x2*)(v1row + olo); f.vh1[kk] = *(const LAS u32x2*)(v1row + ohi);
  }
}
__device__ __forceinline__ void a2_pv(const A2V& f, const f32x16& s0, const f32x16& s1, f32x16& o0, f32x16& o1) {
  __builtin_amdgcn_s_setprio(1);
#pragma unroll
  for (int kk = 0; kk < 4; ++kk) {
    unsigned pk[4];
#pragma unroll
    for (int j = 0; j < 4; ++j) {
      float a = (kk < 2) ? s0[(kk & 1) * 8 + 2 * j] : s1[(kk & 1) * 8 + 2 * j];
      float b = (kk < 2) ? s0[(kk & 1) * 8 + 2 * j + 1] : s1[(kk & 1) * 8 + 2 * j + 1];
      pk[j] = pack2(a, b);
    }
    bf16x8 pb = __builtin_bit_cast(bf16x8, make_uint4(pk[0], pk[1], pk[2], pk[3]));
    bf16x8 av0 = __builtin_bit_cast(bf16x8, make_uint4(f.vl0[kk][0], f.vl0[kk][1], f.vh0[kk][0], f.vh0[kk][1]));
    bf16x8 av1 = __builtin_bit_cast(bf16x8, make_uint4(f.vl1[kk][0], f.vl1[kk][1], f.vh1[kk][0], f.vh1[kk][1]));
    o0 = __builtin_amdgcn_mfma_f32_32x32x16_bf16(av0, pb, o0, 0, 0, 0);
    o1 = __builtin_amdgcn_mfma_f32_32x32x16_bf16(av1, pb, o1, 0, 0, 0);
  }
  __builtin_amdgcn_s_setprio(0);
}
__device__ __forceinline__ void a2_softmax_pv(LAS unsigned char* vst, f32x16& s0, f32x16& s1, f32x16& o0, f32x16& o1,
                                              float& mrun, float& lsum, int qi, int half, bool domask, int kbase,
                                              int qpos) {
  A2V f;
  a2_vload(vst, qi, half, f);
  __builtin_amdgcn_sched_barrier(0);
  if (domask) a2_mask(s0, s1, half, kbase, qpos);
  a2_update(a2_lanemax(s0, s1), mrun, lsum, o0, o1);
  lsum += a2_exp(s0, s1, mrun);
  a2_pv(f, s0, s1, o0, o1);
}
__device__ __forceinline__ void a2_softmax_pv2(LAS unsigned char* vstA, LAS unsigned char* vstB, f32x16& a0, f32x16& a1,
                                               f32x16& b0, f32x16& b1, f32x16& o0, f32x16& o1, float& mrun,
                                               float& lsum, int qi, int half) {
  A2V f;
  a2_vload(vstA, qi, half, f);
  __builtin_amdgcn_sched_barrier(0);
  a2_update(fmaxf(a2_lanemax(a0, a1), a2_lanemax(b0, b1)), mrun, lsum, o0, o1);
  lsum += a2_exp(a0, a1, mrun);
  a2_pv(f, a0, a1, o0, o1);
  a2_vload(vstB, qi, half, f);
  lsum += a2_exp(b0, b1, mrun);
  a2_pv(f, b0, b1, o0, o1);
}

__device__ __forceinline__ void attn256_item(const P& p, int bh, int qt, LAS unsigned char* lds, bool do_atomic = true) {
  const int t = otid(), w = __builtin_amdgcn_readfirstlane(t >> 6), l = t & 63, qi = l & 31, half = l >> 5;
  const int q0 = qt * 256, wq0 = q0 + w * 32;
  const bf16* Qp = p.Q + ((size_t)bh * 4096 + wq0 + qi) * 96;
  bf16x8 qf[6];
  const char* Kg = (const char*)(p.Kc + (size_t)bh * 4096 * 96);
  const char* Vg = (const char*)(p.Vt + (size_t)bh * 64 * 4096);
  const int nkt = 4 * qt + 4, nfull = 4 * qt;

  const int p2 = 512 + (t & 255);
  const unsigned ko1 = (unsigned)((((t >> 1) & 63) * 96 + ((t >> 7) * 2 + (t & 1)) * 8) * 2);
  const unsigned ko2 = (unsigned)((((p2 >> 1) & 63) * 96 + ((p2 >> 7) * 2 + (p2 & 1)) * 8) * 2);
  const int vdv = t >> 3;
  const unsigned vo = (unsigned)((vdv * 4096 + (((t & 7) ^ ((vdv >> 1) & 7)) * 8)) * 2);
  const unsigned ldsw = (unsigned)w * 1024u;
#define A2_ISSUE(kt_, st_) do { \
    const char* kb_ = Kg + (size_t)(kt_) * (64 * 96 * 2); const char* vb_ = Vg + (size_t)(kt_) * 128; \
    LAS unsigned char* sb_ = lds + (st_) * A2_STAGE; \
    __builtin_amdgcn_global_load_lds((const unsigned*)(kb_ + ko1), (LAS unsigned*)(sb_ + ldsw), 16, 0, 0); \
    if (w < 4) __builtin_amdgcn_global_load_lds((const unsigned*)(kb_ + ko2), (LAS unsigned*)(sb_ + 8192 + ldsw), 16, 0, 0); \
    __builtin_amdgcn_global_load_lds((const unsigned*)(vb_ + vo), (LAS unsigned*)(sb_ + A2_VOFF + ldsw), 16, 0, 0); } while (0)
#define A2_WAIT3 do { if (w < 4) asm volatile("s_waitcnt vmcnt(9)" ::: "memory"); else asm volatile("s_waitcnt vmcnt(6)" ::: "memory"); } while (0)
#define A2_WAIT0 asm volatile("s_waitcnt vmcnt(0)" ::: "memory")
#define A2_BAR asm volatile("s_waitcnt lgkmcnt(0)\n\ts_barrier" ::: "memory")

  A2_ISSUE(0, 0); A2_ISSUE(1, 1); A2_ISSUE(2, 2); A2_ISSUE(3, 3);
#pragma unroll
  for (int ks = 0; ks < 6; ++ks) qf[ks] = *(const bf16x8*)(Qp + ks * 16 + half * 8);
  A2_WAIT0;
#pragma unroll
  for (int ks = 0; ks < 6; ++ks) asm volatile("" : "+v"(qf[ks]));
  A2_BAR;

  f32x16 o0, o1, sa0, sa1, sb0, sb1;
#pragma unroll
  for (int r = 0; r < 16; ++r) { o0[r] = 0.f; o1[r] = 0.f; }
  float mrun = -INFINITY, lsum = 0.f;
  const int qpos = wq0 + qi;
  int sA = 0;
  int kt = 0;
#define A2_WAIT2 do { if (w < 4) asm volatile("s_waitcnt vmcnt(6)" ::: "memory"); else asm volatile("s_waitcnt vmcnt(4)" ::: "memory"); } while (0)
  for (; kt + 1 < nfull; kt += 2) {
    const int sI = (sA + 4 >= A2_NST) ? sA + 4 - A2_NST : sA + 4;
    A2_ISSUE(kt + 4, sI);
    A2_ISSUE(kt + 5, sI + 1);
    a2_qk(lds + sA * A2_STAGE, qf, qi, half, sa0, sa1);
    a2_qk(lds + (sA + 1) * A2_STAGE, qf, qi, half, sb0, sb1);
    a2_softmax_pv2(lds + sA * A2_STAGE + A2_VOFF, lds + (sA + 1) * A2_STAGE + A2_VOFF, sa0, sa1, sb0, sb1, o0, o1,
                   mrun, lsum, qi, half);
    A2_WAIT2;
    A2_BAR;
    sA = (sA + 2 >= A2_NST) ? 0 : sA + 2;
  }
  for (; kt < nkt; kt += 2) {
#pragma unroll
    for (int u = 0; u < 2; ++u) {
      const int k1 = kt + u;
      if (k1 * 64 <= wq0 + 31) {
        a2_qk(lds + (sA + u) * A2_STAGE, qf, qi, half, sa0, sa1);
        a2_softmax_pv(lds + (sA + u) * A2_STAGE + A2_VOFF, sa0, sa1, o0, o1, mrun, lsum, qi, half, (k1 * 64 + 63 > wq0),
                      k1 * 64, qpos);
      }
    }
    A2_WAIT0;
    A2_BAR;
    sA = (sA + 2 >= A2_NST) ? 0 : sA + 2;
  }
  const float ltot = lsum + __shfl_xor(lsum, 32);
  const float inv = 1.f / ltot;
  const int b = bh >> 3, h = bh & 7;
  bf16* op = p.ycat + ((size_t)(b * 4096 + wq0 + qi)) * 1024 + 512 + h * 64 + half * 4;
  {
    float ss = 0.f;
#pragma unroll
    for (int r = 0; r < 16; ++r) { float a0 = o0[r] * inv, a1 = o1[r] * inv; ss += a0 * a0 + a1 * a1; }
    ss += __shfl_xor(ss, 32);
    if (half == 0 && do_atomic) atomicAdd(p.rss_a + b * 4096 + wq0 + qi, ss);
  }
#pragma unroll
  for (int rg = 0; rg < 4; ++rg) {
    uint2 v0, v1;
    v0.x = pack2(o0[rg * 4 + 0] * inv, o0[rg * 4 + 1] * inv);
    v0.y = pack2(o0[rg * 4 + 2] * inv, o0[rg * 4 + 3] * inv);
    v1.x = pack2(o1[rg * 4 + 0] * inv, o1[rg * 4 + 1] * inv);
    v1.y = pack2(o1[rg * 4 + 2] * inv, o1[rg * 4 + 3] * inv);
    *(uint2*)(op + rg * 8) = v0;
    *(uint2*)(op + 32 + rg * 8) = v1;
  }
}

template <bool TOBF>
__device__ __forceinline__ void norm_rows(const P& p, const float* __restrict__ src, const float* __restrict__ g,
                                          int shift_off, int scale_off, bf16* dstb, float* dstf, int item) {
  const int t = otid() & 255, w = t >> 6, l = t & 63;
  const int row0 = item * 16 + w;
  float4 v[4][4];
  float ss[4] = {0.f, 0.f, 0.f, 0.f};
#pragma unroll
  for (int q = 0; q < 4; ++q) {
    const float4* sp = (const float4*)(src + (size_t)(row0 + 4 * q) * 1024);
#pragma unroll
    for (int i = 0; i < 4; ++i) v[q][i] = ld_nt4((const float*)(sp + i * 64 + l));
  }
#pragma unroll
  for (int q = 0; q < 4; ++q)
#pragma unroll
    for (int i = 0; i < 4; ++i)
      ss[q] += v[q][i].x * v[q][i].x + v[q][i].y * v[q][i].y + v[q][i].z * v[q][i].z + v[q][i].w * v[q][i].w;
#pragma unroll
  for (int o = 32; o >= 1; o >>= 1) {
#pragma unroll
    for (int q = 0; q < 4; ++q) ss[q] += __shfl_xor(ss[q], o);
  }
  const float* md = p.mod + (row0 >> 12) * 8192;
#pragma unroll
  for (int i = 0; i < 4; ++i) {
    const int col = i * 256 + l * 4;
    float4 gg = *(const float4*)(g + col);
    float4 sc = *(const float4*)(md + scale_off + col);
    float4 sh = *(const float4*)(md + shift_off + col);
    const float m0 = gg.x * (1.f + sc.x), m1 = gg.y * (1.f + sc.y), m2 = gg.z * (1.f + sc.z), m3 = gg.w * (1.f + sc.w);
#pragma unroll
    for (int q = 0; q < 4; ++q) {
      const float rstd = rsqrtf(ss[q] * (1.f / 1024.f) + EPSN);
      const int row = row0 + 4 * q;
      float y0 = v[q][i].x * rstd * m0 + sh.x;
      float y1 = v[q][i].y * rstd * m1 + sh.y;
      float y2 = v[q][i].z * rstd * m2 + sh.z;
      float y3 = v[q][i].w * rstd * m3 + sh.w;
      if (TOBF) {
        uint2 o; o.x = pack2(y0, y1); o.y = pack2(y2, y3);
        *(uint2*)(dstb + (size_t)row * 1024 + col) = o;
      } else {
        st_nt4(dstf + (size_t)row * 1024 + col, make_float4(y0, y1, y2, y3));
      }
    }
  }
}

__device__ __forceinline__ void mod_item(const P& p, int item, char* smem, const int mode = 0) {
  float* cnd = (float*)smem;
  float* red = (float*)(smem + 8192);
  const int t = otid() & 255;
  const int cbk = (mode == 0) ? (item & 31) : (item & 15), ksp = (mode == 0) ? (item >> 5) : (item >> 4);
  const int n0 = cbk * 256, k0 = ksp * 128;
  const float* W; int ldw; int nn0; const float* bias;
  if (mode == 1) { W = p.w_ff1; ldw = 4096; nn0 = n0; bias = nullptr; }
  else if (n0 < 6144) { W = p.ada_w; ldw = 6144; nn0 = n0; bias = p.ada_b; }
  else { W = p.fada_w; ldw = 2048; nn0 = n0 - 6144; bias = p.fada_b; }
#pragma unroll
  for (int i = 0; i < 8; ++i) {
    int idx = i * 256 + t, b = idx >> 7, kk = idx & 127;
    if (mode == 1) {
      cnd[idx] = p.mod[b * 8192 + 3072 + k0 + kk];
    } else {
      float c = p.c[b * 1024 + k0 + kk];
      cnd[idx] = c * sigmoidf(c);
    }
  }
  __syncthreads();
  const int c4 = (t & 63) * 4, kq = t >> 6;
  float4 acc[16];
#pragma unroll
  for (int b = 0; b < 16; ++b) acc[b] = make_float4(0.f, 0.f, 0.f, 0.f);
  const float* wp = W + (size_t)(k0 + kq * 32) * ldw + nn0 + c4;
  for (int kb = 0; kb < 32; kb += 8) {
    float4 w[8];
#pragma unroll
    for (int u = 0; u < 8; ++u) w[u] = *(const float4*)(wp + (size_t)(kb + u) * ldw);
    __builtin_amdgcn_sched_barrier(0);
#pragma unroll
    for (int u = 0; u < 8; ++u) {
#pragma unroll
      for (int b = 0; b < 16; ++b) {
        float cv = cnd[b * 128 + kq * 32 + kb + u];
        acc[b].x += cv * w[u].x; acc[b].y += cv * w[u].y; acc[b].z += cv * w[u].z; acc[b].w += cv * w[u].w;
      }
      __builtin_amdgcn_sched_barrier(0);
    }
  }
#pragma unroll
  for (int b = 0; b < 16; ++b) *(float4*)(red + (kq * 16 + b) * 256 + c4) = acc[b];
  __syncthreads();
#pragma unroll
  for (int i = 0; i < 16; ++i) {
    int o = i * 256 + t, b = o >> 8, c = o & 255;
    float s = red[(0 * 16 + b) * 256 + c] + red[(1 * 16 + b) * 256 + c] + red[(2 * 16 + b) * 256 + c] + red[(3 * 16 + b) * 256 + c];
    if (mode == 1) {
      atomicAdd(p.biasff + b * 4096 + n0 + c, s);
    } else {
      if (ksp == 0) s += bias[nn0 + c];
      atomicAdd(p.mod + b * 8192 + n0 + c, s);
    }
  }
  __syncthreads();
}

__device__ __forceinline__ void tr_tile(const float* __restrict__ W, int K, int N, bf16* __restrict__ Wt,
                                        const float* __restrict__ rsA, const float* __restrict__ rsB, int splitK,
                                        int glu, int kt, int ntile, char* smem) {
  float* tile = (float*)smem;
  const int t = otid() & 255;
  const int k0 = kt * 64, n0 = ntile * 64;
#pragma unroll
  for (int i = 0; i < 4; ++i) {
    int r = (t >> 4) + 16 * i, c4 = (t & 15) * 4;
    float4 v = make_float4(0.f, 0.f, 0.f, 0.f);
    if (n0 + c4 < N) v = *(const float4*)(W + (size_t)(k0 + r) * N + n0 + c4);
    float sc = 1.f;
    if (rsA) { int k = k0 + r; sc = (k < splitK) ? rsA[k] : rsB[k - splitK]; }
    tile[(c4 + 0) * 65 + r] = v.x * sc;
    tile[(c4 + 1) * 65 + r] = v.y * sc;
    tile[(c4 + 2) * 65 + r] = v.z * sc;
    tile[(c4 + 3) * 65 + r] = v.w * sc;
  }
  __syncthreads();
  {
    int n = t >> 2, ks = (t & 3) * 16;
    int no = n0 + n;
    if (glu) { int vv = (no < 512) ? no : no - 512; no = (vv >> 4) * 32 + (vv & 15) + ((no < 512) ? 0 : 16); }
    unsigned o[8];
#pragma unroll
    for (int j = 0; j < 8; ++j) o[j] = pack2(tile[n * 65 + ks + 2 * j], tile[n * 65 + ks + 2 * j + 1]);
    uint4* dp = (uint4*)(Wt + (size_t)no * K + k0 + ks);
    dp[0] = make_uint4(o[0], o[1], o[2], o[3]);
    dp[1] = make_uint4(o[4], o[5], o[6], o[7]);
  }
  __syncthreads();
}

__device__ __forceinline__ float2 cmul(float2 a, float2 b) {
  return make_float2(a.x * b.x - a.y * b.y, a.x * b.y + a.y * b.x);
}
__device__ __forceinline__ float2 lam_pow(float lre, float lim, float dt, int m) {
  float mag = __expf((float)m * lre * dt);
  float s, c;
  sincosf((float)m * lim * dt, &s, &c);
  return make_float2(mag * c, mag * s);
}
__device__ __forceinline__ float2 zoh_fac(float lre, float lim, float dt) {
  float2 lb = lam_pow(lre, lim, dt, 1);
  float nr = lb.x - 1.f, ni = lb.y;
  float den = lre * lre + lim * lim;
  return make_float2((nr * lre + ni * lim) / den, (ni * lre - nr * lim) / den);
}

__device__ __forceinline__ void ktab_item(const P& p, int item, char* smem) {
  float2* lamm = (float2*)smem;
  float2* fac = lamm + 64;
  float2* CL = fac + 64;
  float2* BB = CL + 1024;
  const int t = otid() & 255;
  const int g = item >> 6, m = item & 63;
  if (t < 64) {
    float lre = p.lam_re[g * 64 + t], lim = p.lam_im[g * 64 + t], dt = __expf(p.log_dt[g]);
    lamm[t] = lam_pow(lre, lim, dt, m);
    fac[t] = zoh_fac(lre, lim, dt);
  }
  float cr[4], ci[4], br[4], bi[4];
#pragma unroll
  for (int i = 0; i < 4; ++i) {
    const int idx = g * 1024 + i * 256 + t;
    cr[i] = p.c_re[idx]; ci[i] = p.c_im[idx]; br[i] = p.b_re[idx]; bi[i] = p.b_im[idx];
  }
  __syncthreads();
#pragma unroll
  for (int i = 0; i < 4; ++i) {
    const int idx = i * 256 + t;
    CL[idx] = cmul(make_float2(cr[i], ci[i]), lamm[idx & 63]);
    BB[idx] = cmul(fac[idx >> 4], make_float2(br[i], bi[i]));
  }
  __syncthreads();
  const int h = t >> 4, hp = t & 15;
  float s = 0.f;
#pragma unroll 8
  for (int pp = 0; pp < 64; ++pp) {
    float2 c = CL[h * 64 + pp], bq = BB[pp * 16 + hp];
    s += c.x * bq.x - c.y * bq.y;
  }
  p.ktab[((size_t)(g * 64 + m) * 16 + h) * 16 + hp] = s;
  __syncthreads();
}

#define TR_IN 320
#define TR_GLU 128
#define TR_UQ 72
#define TR_UKV 64
#define TR_OUT 256
#define TR_FF1 1024
#define TR_FF2 1024

template <int PH>
__device__ __forceinline__ void run_phase(const P& p, int bid_, int nb_, char* smem_) {
  const int hb = __builtin_amdgcn_readfirstlane((otid() >> 8));
  const int bid = bid_ * 2 + hb, nb = nb_ * 2;
  char* smem = smem_ + hb * HSMEM;
  LAS unsigned char* lds = (LAS unsigned char*)smem_;
  const int t = otid() & 255;
  if (PH == 0) {
    const int n_mod = 256;
    const int n_tr = TR_IN + TR_GLU + TR_UQ + TR_UKV + TR_OUT + TR_FF1 + TR_FF2;
    const int n_kt = 2048;
    const int n_pw = (32 * 65 * 64) / 256;
    const int n_bb = (32 * 64 * 16) / 256;
    const int n_cs = (65536 * 16) / 256;
    const int total = n_mod + n_tr + n_kt + n_pw + n_bb + n_cs;
    for (int it = bid; it < total; it += nb) {
      int i = it;
      if (i < n_mod) { mod_item(p, i, smem); continue; }
      i -= n_mod;
      if (i < n_tr) {
        if (i < TR_IN) { tr_tile(p.w_in, 1024, 1184, p.Wt_in, nullptr, nullptr, 0, 0, i % 16, i / 16, smem); continue; }
        i -= TR_IN;
        if (i < TR_GLU) { tr_tile(p.w_glu, 512, 1024, p.Wt_glu, nullptr, nullptr, 0, 1, i % 8, i / 8, smem); continue; }
        i -= TR_GLU;
        if (i < TR_UQ) { tr_tile(p.w_uq, 384, 768, p.Wt_uq, p.q_norm_g, p.q_norm_g, 384, 0, i % 6, i / 6, smem); continue; }
        i -= TR_UQ;
        if (i < TR_UKV) { tr_tile(p.w_ukv, 256, 1024, p.Wt_ukv, p.kv_norm_g, p.kv_norm_g, 256, 0, i % 4, i / 4, smem); continue; }
        i -= TR_UKV;
        if (i < TR_OUT) { tr_tile(p.w_out, 1024, 1024, p.Wt_out, p.ssm_out_g, p.attn_out_g, 512, 0, i % 16, i / 16, smem); continue; }
        i -= TR_OUT;
        if (i < TR_FF1) { tr_tile(p.w_ff1, 1024, 4096, p.Wt_ff1, nullptr, nullptr, 0, 0, i % 16, i / 16, smem); continue; }
        i -= TR_FF1;
        tr_tile(p.w_ff2, 4096, 1024, p.Wt_ff2, nullptr, nullptr, 0, 0, i % 64, i / 64, smem);
        continue;
      }
      i -= n_tr;
      if (i < n_kt) { ktab_item(p, i, smem); continue; }
      i -= n_kt;
      if (i < n_pw) {
        int idx = i * 256 + t;
        int pp = idx & 63, m = (idx >> 6) % 65, g = idx / (64 * 65);
        float dt = __expf(p.log_dt[g]);
        p.pw[idx] = lam_pow(p.lam_re[g * 64 + pp], p.lam_im[g * 64 + pp], dt, m);
        continue;
      }
      i -= n_pw;
      if (i < n_bb) {
        int idx = i * 256 + t;
        int gp = idx >> 4;
        int g = gp >> 6;
        float dt = __expf(p.log_dt[g]);
        float2 f = zoh_fac(p.lam_re[gp], p.lam_im[gp], dt);
        p.bbar[idx] = cmul(f, make_float2(p.b_re[idx], p.b_im[idx]));
        continue;
      }
      i -= n_bb;
      {
        int idx = i * 256 + t;
        int tok = idx >> 4, ii = idx & 15;
        float invf = exp2f(-(float)ii * (13.287712379549449f / 16.f));
        float ang = (float)p.pos[tok] * invf;
        float s, c;
        sincosf(ang, &s, &c);
        p.cs[idx] = make_float2(c, s);
      }
    }
  } else if (PH == 1) {
    const int n_norm = 4096;
    const int n_te = (32 * 1024 * 144) / 256;
    const int n_f = (32 * 128 * 128) / 256;
    const int total = n_norm + n_te + n_f;
    for (int it = bid; it < total; it += nb) {
      int i = it;
      if (i < n_norm) { norm_rows<true>(p, p.x, p.norm1_g, 0, 1024, p.hbuf, nullptr, i); continue; }
      i -= n_norm;
      if (i < n_te) {
        int idx = i * 256 + t;
        int k8 = idx % 144, n = (idx / 144) & 1023, g = idx / (144 * 1024);
        int k = k8 * 8, j = n >> 4, h = n & 15;
        if (k < 1024 && k >= ((n >> 7) + 1) * 128) continue;
        float v[8];
        if (k < 1024) {
          int ii = k >> 4, hp0 = k & 15;
          if (ii <= j) {
            const float* kp = p.ktab + ((size_t)(g * 64 + (j - ii)) * 16 + h) * 16 + hp0;
            float4 a = *(const float4*)kp, b = *(const float4*)(kp + 4);
            v[0] = a.x; v[1] = a.y; v[2] = a.z; v[3] = a.w; v[4] = b.x; v[5] = b.y; v[6] = b.z; v[7] = b.w;
          } else {
#pragma unroll
            for (int q = 0; q < 8; ++q) v[q] = 0.f;
          }
        } else {
          int q = k - 1024, p0 = q & 63, isim = q >> 6;
#pragma unroll
          for (int jj = 0; jj < 8; ++jj) {
            int pp = p0 + jj;
            float2 C = make_float2(p.c_re[(g * 16 + h) * 64 + pp], p.c_im[(g * 16 + h) * 64 + pp]);
            float2 L = p.pw[(size_t)(g * 65 + j + 1) * 64 + pp];
            float2 pr = cmul(C, L);
            v[jj] = isim ? -pr.y : pr.x;
          }
        }
        uint4 o = make_uint4(pack2(v[0], v[1]), pack2(v[2], v[3]), pack2(v[4], v[5]), pack2(v[6], v[7]));
        *(uint4*)(p.Bty + ((size_t)(g * 1024 + n)) * 1152 + k) = o;
        continue;
      }
      i -= n_te;
      {
        int idx = i * 256 + t;
        int k8 = idx & 127, n = (idx >> 7) & 127, g = idx >> 14;
        int k = k8 * 8, ii = k >> 4, hp0 = k & 15;
        int pp = n & 63, isim = n >> 6;
        float2 L = p.pw[(size_t)(g * 65 + 63 - ii) * 64 + pp];
        float v[8];
#pragma unroll
        for (int jj = 0; jj < 8; ++jj) {
          float2 pr = cmul(L, p.bbar[(size_t)(g * 64 + pp) * 16 + hp0 + jj]);
          v[jj] = isim ? pr.y : pr.x;
        }
        uint4 o = make_uint4(pack2(v[0], v[1]), pack2(v[2], v[3]), pack2(v[4], v[5]), pack2(v[6], v[7]));
        *(uint4*)(p.Fm + ((size_t)(g * 128 + n)) * 1024 + k) = o;
      }
    }
  } else if (PH == 2) {
    gemm256_phase<EPI_INPROJ, 0>(p, p.hbuf, 1024, p.Wt_in, 1024, 1024, 5, bid_, nb_, lds);
  } else if (PH == 3) {
    gemm256_phase<EPI_KV, 0>(p, p.kvlat, 256, p.Wt_ukv, 256, 256, 4, bid_, nb_, lds);
    gemm256_phase<EPI_Q, 0>(p, p.qlat, 384, p.Wt_uq, 384, 384, 3, bid_, nb_, lds);
    for (int i = bid - 256; i >= 0 && i < 128; i += nb) mod_item(p, i, smem, 1);
    for (int i = bid; i < 256; i += nb) {
      int g = i >> 3, mt = i & 7;
      gemm_tile<EPI_S, 0>(p, p.Ag + (size_t)g * 1024 * 1152, 1152, p.Fm + (size_t)g * 128 * 1024, 1024, 16, 16, 0,
                          mt * 128, 0, g, smem);
      __syncthreads();
      if (t < 128) {
        const int bsel = t >> 6, pp = t & 63;
        const float* Sst = (const float*)smem + (bsel * 64) * 129;
        const float2 LL = p.pw[(size_t)(g * 65 + 64) * 64 + pp];
        float2 X = make_float2(0.f, 0.f);
        bf16* xp_ = p.Ag + ((size_t)(g * 1024 + mt * 128 + bsel * 64)) * 1152 + 1024 + pp;
        for (int c = 0; c < 64; ++c) {
          xp_[(size_t)c * 1152] = f2bf(X.x);
          xp_[(size_t)c * 1152 + 64] = f2bf(X.y);
          const float sr = Sst[c * 129 + pp], si = Sst[c * 129 + 64 + pp];
          const float2 nx = cmul(LL, X);
          X = make_float2(nx.x + sr, nx.y + si);
        }
      }
      __syncthreads();
    }
  } else if (PH == 4) {
    const int total = 32768 / 256;
    for (int it = bid; it < total; it += nb) {
      int idx = it * 256 + t;
      int pp = idx & 63, b = (idx >> 6) & 15, g = idx >> 10;
      float2 LL = p.pw[(size_t)(g * 65 + 64) * 64 + pp];
      float2 X = make_float2(0.f, 0.f);
      const size_t rbase = (size_t)(g * 1024 + b * 64);
      for (int c0 = 0; c0 < 64; c0 += 16) {
        float sr[16], si[16];
#pragma unroll
        for (int q = 0; q < 16; ++q) {
          sr[q] = p.S[(rbase + c0 + q) * 128 + pp];
          si[q] = p.S[(rbase + c0 + q) * 128 + 64 + pp];
        }
#pragma unroll
        for (int q = 0; q < 16; ++q) {
          size_t row = rbase + c0 + q;
          p.Ag[row * 1152 + 1024 + pp] = f2bf(X.x);
          p.Ag[row * 1152 + 1088 + pp] = f2bf(X.y);
          float2 nx = cmul(LL, X);
          X = make_float2(nx.x + sr[q], nx.y + si[q]);
        }
      }
    }
  } else if (PH == 5) {
    const int na = 4096, ny = 2048;
    const int total = na + ny;
    if (nb_ == 256) {
      const int x = bid_ & 7, j = bid_ >> 3;
      for (int r = 0; r < 8; ++r) attn256_item(p, 16 * x + 2 * r + (j >> 4), (r & 1) ? (15 - (j & 15)) : (j & 15), lds);
#ifdef ATTN_TWICE
      for (int r = 0; r < 8; ++r) attn256_item(p, 16 * x + 2 * r + (j >> 4), (r & 1) ? (15 - (j & 15)) : (j & 15), lds, false);
#endif
    } else {
      for (int it = bid_; it < 2048; it += nb_) attn256_item(p, it & 127, 15 - (it >> 7), lds);
    }
    __syncthreads();
    if (nb_ == 256) {
      const int x = bid_ & 7, q = bid_ >> 3;
      for (int r = 0; r < 4; ++r) {
        const int g = x + 8 * r, nt = ((q & 7) + 2 * r) & 7, mt = (q >> 3) * 2 + hb;
        const int nk1 = 2 * nt + 2;
        gemm_tile<EPI_Y, 0>(p, p.Ag + (size_t)g * 1024 * 1152, 1152, p.Bty + (size_t)g * 1024 * 1152, 1152, nk1 + 2,
                            nk1, 16, mt * 128, nt * 128, g, smem);
      }
    } else
    for (int it = na + bid; it < total; it += nb) {
      int i = it;
      i -= na;
      {
        int mt = ((i >> 4) & 3) * 2 + (i & 1), nt = (i >> 1) & 7, g = i >> 6;
        int nk1 = 2 * nt + 2;
        gemm_tile<EPI_Y, 0>(p, p.Ag + (size_t)g * 1024 * 1152, 1152, p.Bty + (size_t)g * 1024 * 1152, 1152, nk1 + 2,
                            nk1, 16, mt * 128, nt * 128, g, smem);
      }
    }
  } else if (PH == 6) {
    gemm256_phase<EPI_GLU, 0>(p, p.ygelu, 512, p.Wt_glu, 512, 512, 4, bid_, nb_, lds);
  } else if (PH == 7) {
    gemm256_phase<EPI_OUT, 2>(p, p.ycat, 1024, p.Wt_out, 1024, 1024, 4, bid_, nb_, lds);
  } else if (PH == 8) {
    for (int it = bid; it < 4096; it += nb) norm_rows<true>(p, p.out, p.norm2_g, 3072, 4096, p.hbuf, nullptr, it);
  } else if (PH == 9) {
    gemm256_phase<EPI_FF1, 0>(p, p.hbuf, 1024, p.Wt_ff1, 1024, 1024, 16, bid_, nb_, lds);
  } else if (PH == 10) {
    gemm256_phase<EPI_FF2, 0>(p, p.hid, 4096, p.Wt_ff2, 4096, 4096, 4, bid_, nb_, lds);
  } else if (PH == 11) {
    for (int it = bid; it < 4096; it += nb) norm_rows<false>(p, p.out, p.fnorm_g, 6144, 7168, nullptr, p.out, it);
  }
}

template <int PH>
__global__ void __launch_bounds__(NT, 2) k_phase(P p) {
  __shared__ __attribute__((aligned(16))) char smem[SMEM_BYTES];
  run_phase<PH>(p, blockIdx.x, gridDim.x, smem);
}

__global__ void __launch_bounds__(NT, 2) k_mega(P p) {
  __shared__ __attribute__((aligned(16))) char smem[SMEM_BYTES];
  cg::grid_group grid = cg::this_grid();
  const int bid = blockIdx.x, nb = gridDim.x;
#ifndef DUPMASK
#define DUPMASK 0
#endif
#define RUNP(ph) run_phase<ph>(p, bid, nb, smem); grid.sync(); if (DUPMASK & (1 << ph)) { run_phase<ph>(p, bid, nb, smem); grid.sync(); }
  RUNP(0) RUNP(1) RUNP(2) RUNP(3) RUNP(5) RUNP(6) RUNP(7) RUNP(9)
  run_phase<10>(p, bid, nb, smem); grid.sync();
  run_phase<11>(p, bid, nb, smem);
}

extern "C" void kernel_launch(void* const* d_in, const int* in_sizes, int n_in, void* d_out, int out_size, void* d_ws,
                              size_t ws_size, hipStream_t stream) {
  P p{};
  p.x = (const float*)d_in[0]; p.c = (const float*)d_in[1]; p.pos = (const int*)d_in[2];
  p.ada_w = (const float*)d_in[3]; p.ada_b = (const float*)d_in[4]; p.norm1_g = (const float*)d_in[5];
  p.w_in = (const float*)d_in[6]; p.lam_re = (const float*)d_in[7]; p.lam_im = (const float*)d_in[8];
  p.b_re = (const float*)d_in[9]; p.b_im = (const float*)d_in[10]; p.c_re = (const float*)d_in[11];
  p.c_im = (const float*)d_in[12]; p.ssm_d = (const float*)d_in[13]; p.log_dt = (const float*)d_in[14];
  p.w_glu = (const float*)d_in[15]; p.q_norm_g = (const float*)d_in[16]; p.w_uq = (const float*)d_in[17];
  p.kv_norm_g = (const float*)d_in[18]; p.w_ukv = (const float*)d_in[19]; p.ssm_out_g = (const float*)d_in[20];
  p.attn_out_g = (const float*)d_in[21]; p.w_out = (const float*)d_in[22]; p.norm2_g = (const float*)d_in[23];
  p.w_ff1 = (const float*)d_in[24]; p.w_ff2 = (const float*)d_in[25]; p.fada_w = (const float*)d_in[26];
  p.fada_b = (const float*)d_in[27]; p.fnorm_g = (const float*)d_in[28];
  p.out = (float*)d_out;
  char* ws = (char*)d_ws;
  size_t off = 0;
  auto take = [&](size_t bytes) { char* r = ws + off; off += (bytes + 255) & ~(size_t)255; return r; };
  p.Wt_in = (bf16*)take(1280ull * 1024 * 2);
  p.Wt_glu = (bf16*)take(1024ull * 512 * 2);
  p.Wt_uq = (bf16*)take(768ull * 384 * 2);
  p.Wt_ukv = (bf16*)take(1024ull * 256 * 2);
  p.Wt_out = (bf16*)take(1024ull * 1024 * 2);
  p.Wt_ff1 = (bf16*)take(4096ull * 1024 * 2);
  p.Wt_ff2 = (bf16*)take(1024ull * 4096 * 2);
  p.mod = (float*)take(16ull * 8192 * 4);
  p.rss_q = (float*)take(65536ull * 4);
  p.rss_kv = (float*)take(65536ull * 4);
  p.rss_s = (float*)take(65536ull * 4);
  p.rss_a = (float*)take(65536ull * 4);
  p.rss_x = (float*)take(65536ull * 4);
  p.biasff = (float*)take(16ull * 4096 * 4);
  p.pw = (float2*)take(32ull * 65 * 64 * 8);
  p.bbar = (float2*)take(32ull * 64 * 16 * 8);
  p.ktab = (float*)take(32ull * 64 * 256 * 4);
  p.cs = (float2*)take(65536ull * 16 * 8);
  p.hbuf = (bf16*)take(65536ull * 1024 * 2);
  size_t region = off;
  p.Ag = (bf16*)take(32ull * 1024 * 1152 * 2);
  p.Bty = (bf16*)take(32ull * 1024 * 1152 * 2);
  p.Fm = (bf16*)take(32ull * 128 * 1024 * 2);
  p.S = (float*)take(32ull * 1024 * 128 * 4);
  p.qlat = (bf16*)take(65536ull * 384 * 2);
  p.kvlat = (bf16*)take(65536ull * 256 * 2);
  p.Q = (bf16*)take(128ull * 4096 * 96 * 2);
  p.Kc = (bf16*)take(128ull * 4096 * 96 * 2);
  p.Vt = (bf16*)take(128ull * 64 * 4096 * 2);
  p.ygelu = (bf16*)take(65536ull * 512 * 2);
  p.ycat = (bf16*)take(65536ull * 1024 * 2);
  p.hid = (bf16*)(ws + region);

  hipMemsetAsync(p.mod, 0, 16ull * 8192 * 4 + 5ull * 65536 * 4 + 16ull * 4096 * 4, stream);
#if ONE_LAUNCH
  static int grid_blocks = 0;
  if (!grid_blocks) {
    int dev = 0, cus = 0, per_cu = 0;
    hipGetDevice(&dev);
    hipDeviceGetAttribute(&cus, hipDeviceAttributeMultiprocessorCount, dev);
    hipOccupancyMaxActiveBlocksPerMultiprocessor(&per_cu, k_mega, NT, 0);
    if (per_cu > 1) per_cu = 1;
    if (per_cu < 1) per_cu = 1;
    grid_blocks = cus * per_cu;
  }
  void* args[] = {&p};
  hipError_t e = hipLaunchCooperativeKernel((void*)k_mega, dim3(grid_blocks), dim3(NT), args, 0, stream);
  if (e != hipSuccess) fprintf(stderr, "cooperative launch failed: %s (grid %d)\n", hipGetErrorString(e), grid_blocks);
#else
  const int G = 256;
  k_phase<0><<<G, NT, 0, stream>>>(p);
  k_phase<1><<<G, NT, 0, stream>>>(p);
  k_phase<2><<<G, NT, 0, stream>>>(p);
  k_phase<3><<<G, NT, 0, stream>>>(p);
  k_phase<5><<<G, NT, 0, stream>>>(p);
  k_phase<6><<<G, NT, 0, stream>>>(p);
  k_phase<7><<<G, NT, 0, stream>>>(p);
  k_phase<9><<<G, NT, 0, stream>>>(p);
  k_phase<10><<<G, NT, 0, stream>>>(p);
  k_phase<11><<<G, NT, 0, stream>>>(p);
#endif
}
```

```cpp
#include <hip/hip_runtime.h>
#include <hip/hip_cooperative_groups.h>
#include <stdint.h>
#include <cstdio>
namespace cg = cooperative_groups;

#ifndef ONE_LAUNCH
#define ONE_LAUNCH 1
#endif

typedef unsigned short bf16;
typedef __attribute__((ext_vector_type(8))) short bf16x8;
typedef __attribute__((ext_vector_type(4))) float f32x4;
typedef __attribute__((ext_vector_type(16))) float f32x16;

#define NT 512
#define HSMEM (73728 + 1024)
#define SMEM_BYTES (2 * HSMEM)
#define LAS __attribute__((address_space(3)))
#define EPSN 1e-6f
#define QSCALE (0.10206207261596577f * 1.4426950408889634f)

struct P {
  const float *x, *c; const int* pos;
  const float *ada_w, *ada_b, *norm1_g, *w_in, *lam_re, *lam_im, *b_re, *b_im, *c_re, *c_im, *ssm_d, *log_dt,
      *w_glu, *q_norm_g, *w_uq, *kv_norm_g, *w_ukv, *ssm_out_g, *attn_out_g, *w_out, *norm2_g, *w_ff1, *w_ff2,
      *fada_w, *fada_b, *fnorm_g;
  float* out;
  bf16 *Wt_in, *Wt_glu, *Wt_uq, *Wt_ukv, *Wt_out, *Wt_ff1, *Wt_ff2;
  float* mod; float2* pw; float2* bbar; float* ktab; float2* cs;
  bf16* hbuf; bf16 *Ag, *Bty, *Fm; float* S;
  bf16 *qlat, *kvlat, *Q, *Kc, *Vt, *ygelu, *ycat, *hid;
  float *rss_q, *rss_kv, *rss_s, *rss_a, *rss_x, *biasff;
};

__device__ __forceinline__ int otid() { int t = threadIdx.x; asm volatile("" : "+v"(t)); return t; }
__device__ __forceinline__ float bf2f(unsigned h) { return __uint_as_float(h << 16); }
__device__ __forceinline__ unsigned pack2(float a, float b) {
  typedef __attribute__((ext_vector_type(2))) __bf16 bf2;
  bf2 v; v[0] = (__bf16)a; v[1] = (__bf16)b;
  return __builtin_bit_cast(unsigned, v);
}
__device__ __forceinline__ bf16 f2bf(float a) { return (bf16)(pack2(a, 0.f) & 0xffffu); }
__device__ __forceinline__ float sq2(unsigned w) {
  float a = __uint_as_float(w << 16), b = __uint_as_float(w & 0xffff0000u);
  return a * a + b * b;
}
__device__ __forceinline__ float4 ld_nt4(const float* q) { f32x4 w = __builtin_nontemporal_load((const f32x4*)q); return make_float4(w[0], w[1], w[2], w[3]); }
__device__ __forceinline__ void st_nt4(float* q, float4 v) { f32x4 w; w[0] = v.x; w[1] = v.y; w[2] = v.z; w[3] = v.w; __builtin_nontemporal_store(w, (f32x4*)q); }
__device__ __forceinline__ float gelu_tanh(float x) {
  float z = 0.7978845608028654f * (x + 0.044715f * x * x * x);
  float e = __expf(2.f * z);
  float th = 1.f - 2.f / (e + 1.f);
  return 0.5f * x * (1.f + th);
}
__device__ __forceinline__ float sigmoidf(float x) { return 1.f / (1.f + __expf(-x)); }

enum { EPI_INPROJ = 0, EPI_Q, EPI_KV, EPI_S, EPI_Y, EPI_GLU, EPI_OUT, EPI_FF1, EPI_FF2 };

template <int EPI, int PRE>
__device__ __forceinline__ void gemm_tile(const P& p, const bf16* __restrict__ A, int lda, const bf16* __restrict__ Bt,
                                          int ldb, int nt_total, int nk1, int kjump, int m0, int n0, int g,
                                          char* smem) {
  bf16* As = (bf16*)smem;
  bf16* Bs = As + 2 * 128 * 72;
  float* rs = (float*)(Bs + 2 * 128 * 72);
  const int t = otid() & 255, w = __builtin_amdgcn_readfirstlane(t >> 6), l = t & 63, wm = w >> 1, wn = w & 1, lr = l & 15, lq = l >> 4;

  if (PRE == 1) {
    const int K = nt_total * 64;
    int row = t >> 1, hf = t & 1;
    const bf16* ap = A + (size_t)(m0 + row) * lda + hf * (K / 2);
    float ss = 0.f;
    for (int c = 0; c < K / 16; ++c) {
      uint4 v = *(const uint4*)(ap + c * 8);
      ss += sq2(v.x) + sq2(v.y) + sq2(v.z) + sq2(v.w);
    }
    ss += __shfl_xor(ss, 1);
    if (!hf) rs[row] = rsqrtf(ss / (float)K + EPSN);
  }
  if (PRE == 2) {
    int row = t >> 1, hf = t & 1;
    const bf16* ap = A + (size_t)(m0 + row) * lda + hf * 512;
    float ss = 0.f;
    for (int c = 0; c < 64; ++c) {
      uint4 v = *(const uint4*)(ap + c * 8);
      ss += sq2(v.x) + sq2(v.y) + sq2(v.z) + sq2(v.w);
    }
    rs[hf * 128 + row] = rsqrtf(ss / 512.f + EPSN);
  }

  f32x4 acc[4][4];
#pragma unroll
  for (int i = 0; i < 4; ++i)
#pragma unroll
    for (int j = 0; j < 4; ++j) acc[i][j] = (f32x4){0.f, 0.f, 0.f, 0.f};

  const int ldrow = t >> 3, ldkc = (t & 7) * 8;
  const bf16* Ap = A + (size_t)(m0 + ldrow) * lda + ldkc;
  const bf16* Bp = Bt + (size_t)(n0 + ldrow) * ldb + ldkc;
  uint4 ra[4], rb[4];
  {
    int kt = (0 < nk1) ? 0 : kjump;
#pragma unroll
    for (int i = 0; i < 4; ++i) {
      ra[i] = *(const uint4*)(Ap + (size_t)i * 32 * lda + kt * 64);
      rb[i] = *(const uint4*)(Bp + (size_t)i * 32 * ldb + kt * 64);
    }
#pragma unroll
    for (int i = 0; i < 4; ++i) {
      *(uint4*)(As + (ldrow + 32 * i) * 72 + ldkc) = ra[i];
      *(uint4*)(Bs + (ldrow + 32 * i) * 72 + ldkc) = rb[i];
    }
  }
  __syncthreads();

  for (int it = 0; it < nt_total; ++it) {
    const int buf = it & 1;
    const bool more = (it + 1 < nt_total);
    if (more) {
      int kt = (it + 1 < nk1) ? (it + 1) : (it + 1 - nk1 + kjump);
#pragma unroll
      for (int i = 0; i < 4; ++i) {
        ra[i] = *(const uint4*)(Ap + (size_t)i * 32 * lda + kt * 64);
        rb[i] = *(const uint4*)(Bp + (size_t)i * 32 * ldb + kt * 64);
      }
    }
    if (PRE == 2) {
      if (it == 8) {
#pragma unroll
        for (int mt = 0; mt < 4; ++mt)
#pragma unroll
          for (int r = 0; r < 4; ++r) {
            int rl = wm * 64 + mt * 16 + lq * 4 + r;
            float f = rs[rl] / rs[128 + rl];
#pragma unroll
            for (int nt = 0; nt < 4; ++nt) acc[mt][nt][r] *= f;
          }
      }
    }
    const bf16* Ab = As + buf * (128 * 72) + (wm * 64 + lr) * 72 + lq * 8;
    const bf16* Bb = Bs + buf * (128 * 72) + (wn * 64 + lr) * 72 + lq * 8;
#pragma unroll
    for (int ks = 0; ks < 2; ++ks) {
      bf16x8 a[4], b[4];
#pragma unroll
      for (int i = 0; i < 4; ++i) {
        a[i] = *(const bf16x8*)(Ab + i * 16 * 72 + ks * 32);
        b[i] = *(const bf16x8*)(Bb + i * 16 * 72 + ks * 32);
      }
      __builtin_amdgcn_s_setprio(1);
#pragma unroll
      for (int mt = 0; mt < 4; ++mt)
#pragma unroll
        for (int nt = 0; nt < 4; ++nt)
          acc[mt][nt] = __builtin_amdgcn_mfma_f32_16x16x32_bf16(a[mt], b[nt], acc[mt][nt], 0, 0, 0);
      __builtin_amdgcn_s_setprio(0);
    }
    if (more) {
#pragma unroll
      for (int i = 0; i < 4; ++i) {
        *(uint4*)(As + (buf ^ 1) * (128 * 72) + (ldrow + 32 * i) * 72 + ldkc) = ra[i];
        *(uint4*)(Bs + (buf ^ 1) * (128 * 72) + (ldrow + 32 * i) * 72 + ldkc) = rb[i];
      }
    }
    __syncthreads();
  }

#pragma unroll
  for (int mt = 0; mt < 4; ++mt) {
    const int rl0 = wm * 64 + mt * 16 + lq * 4;
    const int row0 = m0 + rl0;
#pragma unroll
    for (int nt = 0; nt < 4; ++nt) {
      const int cb = n0 + wn * 64 + nt * 16;
      const int col = cb + lr;
      if (EPI == EPI_INPROJ) {
        if (cb < 512) {
          const int gg = cb >> 4;
#pragma unroll
          for (int r = 0; r < 4; ++r) {
            int row = row0 + r, b = row >> 12, s = row & 4095, c = s >> 6, j = s & 63;
            p.Ag[((size_t)(gg * 1024 + b * 64 + c)) * 1152 + j * 16 + lr] = f2bf(acc[mt][nt][r]);
          }
        } else if (cb < 896) {
#pragma unroll
          for (int r = 0; r < 4; ++r) p.qlat[(size_t)(row0 + r) * 384 + (col - 512)] = f2bf(acc[mt][nt][r]);
        } else if (cb < 1152) {
#pragma unroll
          for (int r = 0; r < 4; ++r) p.kvlat[(size_t)(row0 + r) * 256 + (col - 896)] = f2bf(acc[mt][nt][r]);
        } else if (cb == 1152) {
          if (nt < 3) {
#pragma unroll
            for (int r = 0; r < 4; ++r) {
              int row = row0 + r, b = row >> 12, s = row & 4095;
              float2 cs = p.cs[(size_t)row * 16 + lr];
              float x1 = acc[mt][nt][r], x2 = acc[mt][nt < 3 ? nt + 1 : nt][r];
              bf16 o1 = f2bf(x1 * cs.x - x2 * cs.y), o2 = f2bf(x1 * cs.y + x2 * cs.x);
#pragma unroll
              for (int h = 0; h < 8; ++h) {
                bf16* kp = p.Kc + ((size_t)((b * 8 + h) * 4096 + s)) * 96;
                kp[64 + lr] = o1;
                kp[80 + lr] = o2;
              }
            }
          }
        }
      } else if (EPI == EPI_Q) {
        const int hq = cb / 96, d0 = cb - hq * 96;
        if (d0 < 64) {
#pragma unroll
          for (int r = 0; r < 4; ++r) {
            int row = row0 + r, b = row >> 12, s = row & 4095;
            float v = acc[mt][nt][r] * rs[rl0 + r] * QSCALE;
            p.Q[((size_t)((b * 8 + hq) * 4096 + s)) * 96 + d0 + lr] = f2bf(v);
          }
        } else if (d0 == 64) {
          if (nt < 3) {
#pragma unroll
            for (int r = 0; r < 4; ++r) {
              int row = row0 + r, b = row >> 12, s = row & 4095;
              float sc = rs[rl0 + r] * QSCALE;
              float x1 = acc[mt][nt][r] * sc, x2 = acc[mt][nt < 3 ? nt + 1 : nt][r] * sc;
              float2 cs = p.cs[(size_t)row * 16 + lr];
              bf16* qp = p.Q + ((size_t)((b * 8 + hq) * 4096 + s)) * 96;
              qp[64 + lr] = f2bf(x1 * cs.x - x2 * cs.y);
              qp[80 + lr] = f2bf(x1 * cs.y + x2 * cs.x);
            }
          }
        }
      } else if (EPI == EPI_KV) {
        const int hk = cb >> 7, d0 = cb & 127;
        const int b = row0 >> 12, s0 = row0 & 4095;
        if (d0 < 64) {
#pragma unroll
          for (int r = 0; r < 4; ++r)
            p.Kc[((size_t)((b * 8 + hk) * 4096 + s0 + r)) * 96 + d0 + lr] = f2bf(acc[mt][nt][r] * rs[rl0 + r]);
        } else {
          uint2 v;
          v.x = pack2(acc[mt][nt][0] * rs[rl0 + 0], acc[mt][nt][1] * rs[rl0 + 1]);
          v.y = pack2(acc[mt][nt][2] * rs[rl0 + 2], acc[mt][nt][3] * rs[rl0 + 3]);
          *(uint2*)(p.Vt + ((size_t)((b * 8 + hk) * 64 + (d0 - 64) + lr)) * 4096 + s0) = v;
        }
      } else if (EPI == EPI_S) {
#pragma unroll
        for (int r = 0; r < 4; ++r) ((float*)smem)[(rl0 + r) * 129 + col] = acc[mt][nt][r];
      } else if (EPI == EPI_Y) {
        const float dd = p.ssm_d[g * 16 + lr];
        const int j = cb >> 4;
#pragma unroll
        for (int r = 0; r < 4; ++r) {
          int row = row0 + r, b = row >> 6, c = row & 63;
          float u = bf2f(p.Ag[((size_t)(g * 1024 + row)) * 1152 + col]);
          float y = gelu_tanh(acc[mt][nt][r] + dd * u);
          p.ygelu[((size_t)(b * 4096 + c * 64 + j)) * 512 + g * 16 + lr] = f2bf(y);
        }
      } else if (EPI == EPI_GLU) {
        if ((nt & 1) == 0) {
          const int oc = (cb >> 5) * 16 + lr;
#pragma unroll
          for (int r = 0; r < 4; ++r) {
            float v = acc[mt][nt][r] * sigmoidf(acc[mt][(nt & 1) == 0 ? nt + 1 : nt][r]);
            p.ycat[(size_t)(row0 + r) * 1024 + oc] = f2bf(v);
          }
        }
      } else if (EPI == EPI_OUT) {
#pragma unroll
        for (int r = 0; r < 4; ++r) {
          int row = row0 + r, b = row >> 12;
          size_t o = (size_t)row * 1024 + col;
          p.out[o] = p.x[o] + p.mod[b * 8192 + 2048 + col] * acc[mt][nt][r] * rs[128 + rl0 + r];
        }
      } else if (EPI == EPI_FF1) {
#pragma unroll
        for (int r = 0; r < 4; ++r) {
          float v = fmaxf(acc[mt][nt][r], 0.f);
          p.hid[(size_t)(row0 + r) * 4096 + col] = f2bf(v * v);
        }
      } else if (EPI == EPI_FF2) {
#pragma unroll
        for (int r = 0; r < 4; ++r) {
          int row = row0 + r, b = row >> 12;
          size_t o = (size_t)row * 1024 + col;
          p.out[o] = p.out[o] + p.mod[b * 8192 + 5120 + col] * acc[mt][nt][r];
        }
      }
    }
  }
  if (PRE != 0) __syncthreads();
}

__device__ __forceinline__ int lds_byte(int r, int c) {
  int st = (r >> 4) * 2 + (c >> 5), rr = r & 15, cc = c & 31, ob = rr * 64 + cc * 2;
  return st * 1024 + (ob ^ (((ob >> 9) & 1) << 5));
}
__device__ __forceinline__ void stage_rc(int b, int& R, int& C) {
  int st = b / 1024, sb = b % 1024, swz = sb ^ (((sb >> 9) & 1) << 5);
  R = (st >> 1) * 16 + swz / 64;
  C = (st & 1) * 32 + (swz % 64) / 2;
}

#define RS_OFF 139264
#define STB_PITCH 272
#define STF_PITCH 260
#define KST_PITCH 136
#define VT_OFF 69632
#define VT_PITCH 264

typedef __attribute__((ext_vector_type(2))) unsigned u32x2;
typedef __attribute__((ext_vector_type(4))) unsigned u32x4;
__device__ __forceinline__ void lds_st2(LAS bf16* q, uint2 v) { u32x2 w; w[0] = v.x; w[1] = v.y; *(LAS u32x2*)q = w; }
__device__ __forceinline__ void lds_st4f(LAS float* q, float4 v) { f32x4 w; w[0] = v.x; w[1] = v.y; w[2] = v.z; w[3] = v.w; *(LAS f32x4*)q = w; }
__device__ __forceinline__ uint4 lds_ld4(LAS bf16* q) { u32x4 w = *(LAS u32x4*)q; return make_uint4(w[0], w[1], w[2], w[3]); }
__device__ __forceinline__ float4 lds_ld4f(LAS float* q) { f32x4 w = *(LAS f32x4*)q; return make_float4(w[0], w[1], w[2], w[3]); }

#define EPI_BAR asm volatile("s_waitcnt lgkmcnt(0)\n\ts_barrier" ::: "memory")
template <int EPI>
__device__ __forceinline__ void epi256(const P& p, f32x4 (&acc)[2][2][4][2], int brow, int bcol, LAS unsigned char* lds) {
  const int tid = otid(), wid = __builtin_amdgcn_readfirstlane(tid >> 6), lane = tid & 63, wr = wid >> 2,
            wc = wid & 3, fr = lane & 15, fq = lane >> 4;
  LAS bf16* stb = (LAS bf16*)lds;
  LAS float* stf = (LAS float*)lds;

  if (EPI == EPI_OUT || EPI == EPI_FF2) {
    const float* src = (EPI == EPI_OUT) ? p.x : p.out;
    const int goff = (EPI == EPI_OUT) ? 2048 : 5120;
    const int c4 = (tid & 63) * 4, col = bcol + c4, bb = brow >> 12, rw = tid >> 6;
    const float4 g4 = *(const float4*)(p.mod + bb * 8192 + goff + col);
    float4 n4 = make_float4(0.f, 0.f, 0.f, 0.f);
    if (EPI == EPI_OUT) {
      const float4 ng = *(const float4*)(p.norm2_g + col);
      const float4 sc2 = *(const float4*)(p.mod + bb * 8192 + 4096 + col);
      n4 = make_float4(ng.x * (1.f + sc2.x), ng.y * (1.f + sc2.y), ng.z * (1.f + sc2.z), ng.w * (1.f + sc2.w));
    }
#pragma unroll
    for (int ai = 0; ai < 2; ++ai) {
      float4 xp[16];
#pragma unroll
      for (int i = 0; i < 16; ++i) xp[i] = ld_nt4(src + (size_t)(brow + ai * 128 + i * 8 + rw) * 1024 + col);
#pragma unroll
      for (int m = 0; m < 4; ++m) {
        const int rl = wr * 64 + m * 16 + fr;
        float sc = 1.f;
        if (EPI == EPI_OUT) sc = rsqrtf(((LAS float*)(lds + RS_OFF))[ai * 128 + rl] * (1.f / 512.f) + EPSN);
#pragma unroll
        for (int bj = 0; bj < 2; ++bj)
#pragma unroll
          for (int n = 0; n < 2; ++n) {
            const int cl = bj * 128 + wc * 32 + n * 16 + fq * 4;
            f32x4 v = acc[ai][bj][m][n];
            lds_st4f(stf + rl * STF_PITCH + cl, make_float4(v[0] * sc, v[1] * sc, v[2] * sc, v[3] * sc));
          }
      }
      EPI_BAR;
#pragma unroll
      for (int i = 0; i < 16; ++i) {
        const int row = i * 8 + rw;
        float4 v = lds_ld4f(stf + row * STF_PITCH + c4);
        const int grow = brow + ai * 128 + row;
        const float4 x4 = xp[i];
        const float y0 = x4.x + g4.x * v.x, y1 = x4.y + g4.y * v.y, y2 = x4.z + g4.z * v.z, y3 = x4.w + g4.w * v.w;
        st_nt4(p.out + (size_t)grow * 1024 + col, make_float4(y0, y1, y2, y3));
        if (EPI == EPI_OUT) {
          *(uint2*)(p.hbuf + (size_t)grow * 1024 + col) = make_uint2(pack2(y0 * n4.x, y1 * n4.y), pack2(y2 * n4.z, y3 * n4.w));
          float ss = y0 * y0 + y1 * y1 + y2 * y2 + y3 * y3;
#pragma unroll
          for (int o = 32; o >= 1; o >>= 1) ss += __shfl_xor(ss, o);
          if ((tid & 63) == 0) atomicAdd(p.rss_x + grow, ss);
        }
      }
      EPI_BAR;
    }
    return;
  }

#pragma unroll
  for (int ai = 0; ai < 2; ++ai)
#pragma unroll
    for (int m = 0; m < 4; ++m) {
      const int rl = ai * 128 + wr * 64 + m * 16 + fr;
      const int row = brow + rl;
      float rsv = 1.f;
      LAS float* rsl = (LAS float*)(lds + RS_OFF);
      if (EPI == EPI_FF1) rsv = rsqrtf(rsl[rl] * (1.f / 1024.f) + EPSN);
      if (EPI == EPI_Q) rsv = rsqrtf(rsl[rl] * (1.f / 384.f) + EPSN) * QSCALE;
      if (EPI == EPI_KV) rsv = rsqrtf(rsl[rl] * (1.f / 256.f) + EPSN);
#pragma unroll
      for (int bj = 0; bj < 2; ++bj)
#pragma unroll
        for (int n = 0; n < 2; ++n) {
          const int cl = bj * 128 + wc * 32 + n * 16 + fq * 4;
          const int cb = bcol + bj * 128 + wc * 32 + n * 16;
          const f32x4 v = acc[ai][bj][m][n];
          const f32x4 vn = acc[ai][bj][m][1];
          if (EPI == EPI_FF1) {
            const float4 bi = lds_ld4f((LAS float*)(lds + RS_OFF + 1024) + cl);
            float a0 = fmaxf(v[0] * rsv + bi.x, 0.f), a1 = fmaxf(v[1] * rsv + bi.y, 0.f);
            float a2 = fmaxf(v[2] * rsv + bi.z, 0.f), a3 = fmaxf(v[3] * rsv + bi.w, 0.f);
            lds_st2(stb + rl * STB_PITCH + cl, make_uint2(pack2(a0 * a0, a1 * a1), pack2(a2 * a2, a3 * a3)));
          } else if (EPI == EPI_GLU) {
            if (n == 0) {
              const int oc = bj * 64 + wc * 16 + fq * 4;
              lds_st2(stb + rl * STB_PITCH + oc, make_uint2(pack2(v[0] * sigmoidf(vn[0]), v[1] * sigmoidf(vn[1])),
                             pack2(v[2] * sigmoidf(vn[2]), v[3] * sigmoidf(vn[3]))));
            }
          } else if (EPI == EPI_KV) {
            if (wc < 2) {
              lds_st2(stb + rl * KST_PITCH + bj * 64 + wc * 32 + n * 16 + fq * 4, make_uint2(pack2(v[0] * rsv, v[1] * rsv), pack2(v[2] * rsv, v[3] * rsv)));
            } else {
              LAS bf16* vt = (LAS bf16*)(lds + VT_OFF) + (bj * 64 + (wc - 2) * 32 + n * 16 + fq * 4) * VT_PITCH + rl;
              vt[0] = f2bf(v[0] * rsv); vt[VT_PITCH] = f2bf(v[1] * rsv);
              vt[2 * VT_PITCH] = f2bf(v[2] * rsv); vt[3 * VT_PITCH] = f2bf(v[3] * rsv);
            }
          } else if (EPI == EPI_Q) {
            const int hq = cb / 96, d0 = cb - hq * 96;
            if (d0 < 64) {
              lds_st2(stb + rl * STB_PITCH + cl, make_uint2(pack2(v[0] * rsv, v[1] * rsv), pack2(v[2] * rsv, v[3] * rsv)));
            } else if (d0 == 64) {
              if (n == 0) {
                const float4 c01 = *(const float4*)(p.cs + (size_t)row * 16 + fq * 4);
                const float4 c23 = *(const float4*)(p.cs + (size_t)row * 16 + fq * 4 + 2);
                float x10 = v[0] * rsv, x11 = v[1] * rsv, x12 = v[2] * rsv, x13 = v[3] * rsv;
                float x20 = vn[0] * rsv, x21 = vn[1] * rsv, x22 = vn[2] * rsv, x23 = vn[3] * rsv;
                lds_st2(stb + rl * STB_PITCH + cl, make_uint2(pack2(x10 * c01.x - x20 * c01.y, x11 * c01.z - x21 * c01.w),
                               pack2(x12 * c23.x - x22 * c23.y, x13 * c23.z - x23 * c23.w)));
                lds_st2(stb + rl * STB_PITCH + cl + 16, make_uint2(pack2(x10 * c01.y + x20 * c01.x, x11 * c01.w + x21 * c01.z),
                               pack2(x12 * c23.y + x22 * c23.x, x13 * c23.w + x23 * c23.z)));
              }
            }
          } else if (EPI == EPI_INPROJ) {
            if (cb < 1152) {
              lds_st2(stb + rl * STB_PITCH + cl, make_uint2(pack2(v[0], v[1]), pack2(v[2], v[3])));
            } else if (cb == 1152) {
              if (n == 0) {
                const float4 c01 = *(const float4*)(p.cs + (size_t)row * 16 + fq * 4);
                const float4 c23 = *(const float4*)(p.cs + (size_t)row * 16 + fq * 4 + 2);
                lds_st2(stb + rl * STB_PITCH + cl,
                        make_uint2(pack2(v[0] * c01.x - vn[0] * c01.y, v[1] * c01.z - vn[1] * c01.w),
                                   pack2(v[2] * c23.x - vn[2] * c23.y, v[3] * c23.z - vn[3] * c23.w)));
                lds_st2(stb + rl * STB_PITCH + cl + 16,
                        make_uint2(pack2(v[0] * c01.y + vn[0] * c01.x, v[1] * c01.w + vn[1] * c01.z),
                                   pack2(v[2] * c23.y + vn[2] * c23.x, v[3] * c23.w + vn[3] * c23.z)));
              }
            }
          }
        }
    }
  EPI_BAR;

  if (EPI == EPI_FF1) {
#pragma unroll
    for (int i = 0; i < 16; ++i) {
      const int chunk = i * 512 + tid, row = chunk >> 5, c8 = (chunk & 31) * 8;
      uint4 v = lds_ld4(stb + row * STB_PITCH + c8);
      u32x4 vv; vv[0] = v.x; vv[1] = v.y; vv[2] = v.z; vv[3] = v.w;
      __builtin_nontemporal_store(vv, (u32x4*)(p.hid + (size_t)(brow + row) * 4096 + bcol + c8));
    }
  } else if (EPI == EPI_GLU) {
#pragma unroll
    for (int i = 0; i < 8; ++i) {
      const int chunk = i * 512 + tid, row = chunk >> 4, c8 = (chunk & 15) * 8;
      uint4 v = lds_ld4(stb + row * STB_PITCH + c8);
      *(uint4*)(p.ycat + (size_t)(brow + row) * 1024 + (bcol >> 1) + c8) = v;
      float ss = sq2(v.x) + sq2(v.y) + sq2(v.z) + sq2(v.w);
#pragma unroll
      for (int o = 8; o >= 1; o >>= 1) ss += __shfl_xor(ss, o);
      if ((tid & 15) == 0) atomicAdd(p.rss_s + brow + row, ss);
    }
  } else if (EPI == EPI_KV) {
    const int b = brow >> 12, s0 = brow & 4095, h0 = bcol >> 7;
#pragma unroll
    for (int i = 0; i < 8; ++i) {
      const int chunk = i * 512 + tid, row = chunk >> 4, c8 = (chunk & 15) * 8;
      uint4 v = lds_ld4(stb + row * KST_PITCH + c8);
      *(uint4*)(p.Kc + ((size_t)((b * 8 + h0 + (c8 >> 6)) * 4096 + s0 + row)) * 96 + (c8 & 63)) = v;
    }
#pragma unroll
    for (int i = 0; i < 8; ++i) {
      const int chunk = i * 512 + tid, vrow = chunk >> 5, s8 = (chunk & 31) * 8;
      uint4 v = lds_ld4((LAS bf16*)(lds + VT_OFF) + vrow * VT_PITCH + s8);
      *(uint4*)(p.Vt + ((size_t)((b * 8 + h0 + (vrow >> 6)) * 64 + (vrow & 63))) * 4096 + s0 + s8) = v;
    }
  } else if (EPI == EPI_Q) {
    const int b = brow >> 12, s0 = brow & 4095;
#pragma unroll
    for (int i = 0; i < 16; ++i) {
      const int chunk = i * 512 + tid, row = chunk >> 5, c8 = (chunk & 31) * 8;
      uint4 v = lds_ld4(stb + row * STB_PITCH + c8);
      const int cg = bcol + c8, hq = cg / 96, d = cg - hq * 96;
      *(uint4*)(p.Q + ((size_t)((b * 8 + hq) * 4096 + s0 + row)) * 96 + d) = v;
    }
  } else if (EPI == EPI_INPROJ) {
    if (bcol < 512) {
      const int b = brow >> 12, c0 = (brow & 4095) >> 6, g0 = bcol >> 4;
#pragma unroll
      for (int i = 0; i < 16; ++i) {
        const int q = i * 512 + tid, hh = q & 1, j = (q >> 1) & 63, cl = (q >> 7) & 3, gl = q >> 9;
        uint4 v = lds_ld4(stb + (cl * 64 + j) * STB_PITCH + gl * 16 + hh * 8);
        *(uint4*)(p.Ag + ((size_t)((g0 + gl) * 1024 + b * 64 + c0 + cl)) * 1152 + j * 16 + hh * 8) = v;
      }
    } else {
#pragma unroll
      for (int i = 0; i < 16; ++i) {
        const int chunk = i * 512 + tid, row = chunk >> 5, c8 = (chunk & 31) * 8;
        const int cg = bcol + c8;
        float ss = 0.f;
        if (cg >= 1152 && cg < 1184) {
          uint4 v = lds_ld4(stb + row * STB_PITCH + c8);
          const int grow = brow + row, bq = grow >> 12, sq = grow & 4095;
#pragma unroll
          for (int h = 0; h < 8; ++h)
            *(uint4*)(p.Kc + ((size_t)((bq * 8 + h) * 4096 + sq)) * 96 + 64 + (cg - 1152)) = v;
        }
        if (cg < 1152) {
          uint4 v = lds_ld4(stb + row * STB_PITCH + c8);
          if (cg < 896) *(uint4*)(p.qlat + (size_t)(brow + row) * 384 + (cg - 512)) = v;
          else *(uint4*)(p.kvlat + (size_t)(brow + row) * 256 + (cg - 896)) = v;
          ss = sq2(v.x) + sq2(v.y) + sq2(v.z) + sq2(v.w);
        }
#pragma unroll
        for (int o = 8; o >= 1; o >>= 1) ss += __shfl_xor(ss, o);
        if ((tid & 15) == 0 && cg < 1152) atomicAdd((cg < 896 ? p.rss_q : p.rss_kv) + brow + row, ss);
      }
    }
  }
  EPI_BAR;
}

template <int EPI, int PRE>
__device__ __forceinline__ void gemm256(const P& p, const bf16* __restrict__ A, int lda, const bf16* __restrict__ Bt,
                                        int ldb, int K, int brow, int bcol, LAS unsigned char* lds) {
  const int tid = otid(), wid = __builtin_amdgcn_readfirstlane(tid >> 6), lane = tid & 63, wr = wid >> 2,
            wc = wid & 3, fr = lane & 15, fq = lane >> 4;
  const int nt = K / 64;
  if (EPI == EPI_Q || EPI == EPI_KV || EPI == EPI_FF1 || EPI == EPI_OUT) {
    const float* r0 = (EPI == EPI_Q) ? p.rss_q : (EPI == EPI_KV) ? p.rss_kv : (EPI == EPI_FF1) ? p.rss_x : p.rss_a;
    if (wid < 4) {
      __builtin_amdgcn_global_load_lds((const unsigned*)(r0 + brow + wid * 64 + lane), (LAS unsigned*)(lds + RS_OFF + wid * 256), 4, 0, 0);
    } else if (EPI == EPI_OUT) {
      __builtin_amdgcn_global_load_lds((const unsigned*)(p.rss_s + brow + (wid - 4) * 64 + lane), (LAS unsigned*)(lds + RS_OFF + 1024 + (wid - 4) * 256), 4, 0, 0);
    } else if (EPI == EPI_FF1) {
      __builtin_amdgcn_global_load_lds((const unsigned*)(p.biasff + (brow >> 12) * 4096 + bcol + (wid - 4) * 64 + lane), (LAS unsigned*)(lds + RS_OFF + 1024 + (wid - 4) * 256), 4, 0, 0);
    }
  }
  int R0, C0, R1, C1;
  stage_rc(tid * 16, R0, C0);
  stage_rc(tid * 16 + 8192, R1, C1);
  const unsigned voA0 = (unsigned)(R0 * lda + C0) * 2u, voA1 = (unsigned)(R1 * lda + C1) * 2u;
  const unsigned voB0 = (unsigned)(R0 * ldb + C0) * 2u, voB1 = (unsigned)(R1 * ldb + C1) * 2u;
  const char* Abase = (const char*)(A + (size_t)brow * lda);
  const char* Bbase = (const char*)(Bt + (size_t)bcol * ldb);
  const size_t ahalf = (size_t)128 * lda * 2, bhalf = (size_t)128 * ldb * 2;
  const unsigned ldsw = (unsigned)wid * 1024u;
  const int aoff = lds_byte(wr * 64 + fr, fq * 8), boff = lds_byte(wc * 32 + fr, fq * 8);
#define G_SA(b, h) (((b) * 2 + (h)) * 16384)
#define G_SB(b, h) ((4 + (b) * 2 + (h)) * 16384)
#define G_STA(b, h, kt) do { const char* gb_ = Abase + (h) * ahalf + (size_t)(kt) * 128; \
    __builtin_amdgcn_global_load_lds((const unsigned*)(gb_ + voA0), (LAS unsigned*)(lds + G_SA(b, h) + ldsw), 16, 0, 0); \
    __builtin_amdgcn_global_load_lds((const unsigned*)(gb_ + voA1), (LAS unsigned*)(lds + G_SA(b, h) + ldsw + 8192), 16, 0, 0); } while (0)
#define G_STB(b, h, kt) do { const char* gb_ = Bbase + (h) * bhalf + (size_t)(kt) * 128; \
    __builtin_amdgcn_global_load_lds((const unsigned*)(gb_ + voB0), (LAS unsigned*)(lds + G_SB(b, h) + ldsw), 16, 0, 0); \
    __builtin_amdgcn_global_load_lds((const unsigned*)(gb_ + voB1), (LAS unsigned*)(lds + G_SB(b, h) + ldsw + 8192), 16, 0, 0); } while (0)
#define G_LDA(dst, b, h) do { _Pragma("unroll") for (int m = 0; m < 4; ++m) _Pragma("unroll") for (int k = 0; k < 2; ++k) \
    dst[m][k] = *(const LAS bf16x8*)(lds + G_SA(b, h) + aoff + m * 2048 + k * 1024); } while (0)
#define G_LDB(dst, b, h) do { _Pragma("unroll") for (int n = 0; n < 2; ++n) _Pragma("unroll") for (int k = 0; k < 2; ++k) \
    dst[n][k] = *(const LAS bf16x8*)(lds + G_SB(b, h) + boff + n * 2048 + k * 1024); } while (0)
#define G_MMA(ai, bj, At_, Bt_) do { __builtin_amdgcn_s_setprio(1); \
    _Pragma("unroll") for (int m = 0; m < 4; ++m) _Pragma("unroll") for (int n = 0; n < 2; ++n) _Pragma("unroll") for (int k = 0; k < 2; ++k) \
      acc[ai][bj][m][n] = __builtin_amdgcn_mfma_f32_16x16x32_bf16(Bt_[n][k], At_[m][k], acc[ai][bj][m][n], 0, 0, 0); \
    __builtin_amdgcn_s_setprio(0); } while (0)
#define G_WV(n) asm volatile("s_waitcnt vmcnt(" #n ")" ::: "memory")
#define G_WL(n) asm volatile("s_waitcnt lgkmcnt(" #n ")" ::: "memory")
#define G_BAR __builtin_amdgcn_s_barrier()
#define G_SCHED __builtin_amdgcn_sched_barrier(0)

  f32x4 acc[2][2][4][2];
#pragma unroll
  for (int a = 0; a < 2; ++a)
#pragma unroll
    for (int b = 0; b < 2; ++b)
#pragma unroll
      for (int m = 0; m < 4; ++m)
#pragma unroll
        for (int n = 0; n < 2; ++n) acc[a][b][m][n] = (f32x4){0.f, 0.f, 0.f, 0.f};
  bf16x8 At[4][2], B0[2][2], B1[2][2];

  G_STB(0, 0, 0); G_STA(0, 0, 0); G_STB(0, 1, 0); G_STA(0, 1, 0);
  if (wr == 1) G_BAR;
  G_WV(4); G_BAR;
  G_STB(1, 0, 1); G_STA(1, 0, 1); G_STB(1, 1, 1);
  G_WV(6); G_BAR;
  const int tmid = (PRE == 2) ? 8 : (nt - 2);
  for (int t = 0; t < tmid; t += 2) {
    G_LDB(B0, 0, 0); G_SCHED; G_LDA(At, 0, 0); G_STA(1, 1, t + 1);
    G_WL(8); G_BAR; G_WL(0); G_MMA(0, 0, At, B0); G_BAR; G_SCHED;
    G_LDB(B1, 0, 1); G_STB(0, 0, t + 2);
    G_BAR; G_WL(0); G_MMA(0, 1, At, B1); G_BAR;
    G_LDA(At, 0, 1); G_STA(0, 0, t + 2);
    G_BAR; G_WL(0); G_MMA(1, 0, At, B0); G_BAR; G_SCHED;
    G_STB(0, 1, t + 2);
    G_WV(6); G_BAR; G_MMA(1, 1, At, B1); G_BAR;
    G_LDB(B0, 1, 0); G_SCHED; G_LDA(At, 1, 0); G_STA(0, 1, t + 2);
    G_WL(8); G_BAR; G_WL(0); G_MMA(0, 0, At, B0); G_BAR; G_SCHED;
    G_LDB(B1, 1, 1); G_STB(1, 0, t + 3);
    G_BAR; G_WL(0); G_MMA(0, 1, At, B1); G_BAR;
    G_LDA(At, 1, 1); G_STA(1, 0, t + 3);
    G_BAR; G_WL(0); G_MMA(1, 0, At, B0); G_BAR; G_SCHED;
    G_STB(1, 1, t + 3);
    G_WV(6); G_BAR; G_MMA(1, 1, At, B1); G_BAR;
    }
  if (PRE == 2) {
    const int tid2 = otid(), wr2 = __builtin_amdgcn_readfirstlane(tid2 >> 8), fr2 = tid2 & 15;
#pragma unroll
    for (int a = 0; a < 2; ++a)
#pragma unroll
      for (int m = 0; m < 4; ++m) {
        const int rl = a * 128 + wr2 * 64 + m * 16 + fr2;
        LAS float* rsl = (LAS float*)(lds + RS_OFF);
        const float f = rsqrtf(rsl[256 + rl] * (1.f / 512.f) + EPSN) / rsqrtf(rsl[rl] * (1.f / 512.f) + EPSN);
#pragma unroll
        for (int b = 0; b < 2; ++b)
#pragma unroll
          for (int n = 0; n < 2; ++n) acc[a][b][m][n] *= f;
      }
  }
  if (PRE == 2) {
  for (int t = 8; t < nt - 2; t += 2) {
    G_LDB(B0, 0, 0); G_SCHED; G_LDA(At, 0, 0); G_STA(1, 1, t + 1);
    G_WL(8); G_BAR; G_WL(0); G_MMA(0, 0, At, B0); G_BAR; G_SCHED;
    G_LDB(B1, 0, 1); G_STB(0, 0, t + 2);
    G_BAR; G_WL(0); G_MMA(0, 1, At, B1); G_BAR;
    G_LDA(At, 0, 1); G_STA(0, 0, t + 2);
    G_BAR; G_WL(0); G_MMA(1, 0, At, B0); G_BAR; G_SCHED;
    G_STB(0, 1, t + 2);
    G_WV(6); G_BAR; G_MMA(1, 1, At, B1); G_BAR;
    G_LDB(B0, 1, 0); G_SCHED; G_LDA(At, 1, 0); G_STA(0, 1, t + 2);
    G_WL(8); G_BAR; G_WL(0); G_MMA(0, 0, At, B0); G_BAR; G_SCHED;
    G_LDB(B1, 1, 1); G_STB(1, 0, t + 3);
    G_BAR; G_WL(0); G_MMA(0, 1, At, B1); G_BAR;
    G_LDA(At, 1, 1); G_STA(1, 0, t + 3);
    G_BAR; G_WL(0); G_MMA(1, 0, At, B0); G_BAR; G_SCHED;
    G_STB(1, 1, t + 3);
    G_WV(6); G_BAR; G_MMA(1, 1, At, B1); G_BAR;
    }
  }
  {
    G_LDB(B0, 0, 0); G_LDA(At, 0, 0); G_STA(1, 1, nt - 1);
    G_BAR; G_WL(0); G_MMA(0, 0, At, B0); G_BAR;
    G_LDB(B1, 0, 1); G_BAR; G_WL(0); G_MMA(0, 1, At, B1); G_BAR;
    G_LDA(At, 0, 1); G_WV(4); G_BAR; G_WL(0); G_MMA(1, 0, At, B0); G_MMA(1, 1, At, B1); G_BAR;
  }
  {
    G_LDB(B0, 1, 0); G_LDA(At, 1, 0); G_WV(2); G_BAR; G_WL(0); G_MMA(0, 0, At, B0); G_BAR;
    G_LDB(B1, 1, 1); G_WV(0); G_BAR; G_WL(0); G_MMA(0, 1, At, B1); G_BAR;
    G_LDA(At, 1, 1); G_BAR; G_WL(0); G_MMA(1, 0, At, B0); G_MMA(1, 1, At, B1); G_BAR;
  }
  if (wr == 0) G_BAR;

  epi256<EPI>(p, acc, brow, bcol, lds);
}

template <int EPI, int PRE>
__device__ __forceinline__ void gemm256_phase(const P& p, const bf16* A, int lda, const bf16* Bt, int ldb, int K,
                                              int NN, int bid, int nb, LAS unsigned char* lds) {
  if (nb == 256) {
    const int x = bid & 7, j = bid >> 3;
    for (int k = 0; k < NN; ++k) {
      int L = j + 32 * k;
      int mt = x * 32 + L / NN, nt = L % NN;
      if (NN == 16) { mt = x * 32 + (k >> 2) * 8 + (j & 7); nt = (k & 3) * 4 + (j >> 3); }
      gemm256<EPI, PRE>(p, A, lda, Bt, ldb, K, mt * 256, nt * 256, lds);
    }
  } else {
    for (int it = bid; it < 256 * NN; it += nb) gemm256<EPI, PRE>(p, A, lda, Bt, ldb, K, (it / NN) * 256, (it % NN) * 256, lds);
  }
}

#define KSTR 104
#define VSTR 68
#define ATT_BUF (64 * KSTR + 64 * VSTR)

__device__ __forceinline__ void att_qk(const bf16* Kb, const bf16x8 (&qf)[6], int qi, int half, f32x16& s0, f32x16& s1) {
#pragma unroll
  for (int r = 0; r < 16; ++r) { s0[r] = 0.f; s1[r] = 0.f; }
#pragma unroll
  for (int ks = 0; ks < 6; ++ks) {
    bf16x8 a0 = *(const bf16x8*)(Kb + qi * KSTR + ks * 16 + half * 8);
    bf16x8 a1 = *(const bf16x8*)(Kb + (32 + qi) * KSTR + ks * 16 + half * 8);
    s0 = __builtin_amdgcn_mfma_f32_32x32x16_bf16(a0, qf[ks], s0, 0, 0, 0);
    s1 = __builtin_amdgcn_mfma_f32_32x32x16_bf16(a1, qf[ks], s1, 0, 0, 0);
  }
}

__device__ __forceinline__ void att_softmax_pv(const bf16* Vb, f32x16& s0, f32x16& s1, f32x16& o0, f32x16& o1,
                                               float& mrun, float& lsum, int qi, int half, bool domask, int kbase,
                                               int qpos) {
  if (domask) {
#pragma unroll
    for (int r = 0; r < 16; ++r) {
      int key = kbase + (r >> 2) * 8 + half * 4 + (r & 3);
      if (key > qpos) s0[r] = -INFINITY;
      if (key + 32 > qpos) s1[r] = -INFINITY;
    }
  }
  float mt_ = s0[0];
#pragma unroll
  for (int r = 1; r < 16; ++r) mt_ = fmaxf(mt_, s0[r]);
#pragma unroll
  for (int r = 0; r < 16; ++r) mt_ = fmaxf(mt_, s1[r]);
  mt_ = fmaxf(mt_, __shfl_xor(mt_, 32));
  const float mnew = fmaxf(mrun, mt_);
  const float alpha = __builtin_amdgcn_exp2f(mrun - mnew);
  mrun = mnew;
  float ps = 0.f;
#pragma unroll
  for (int r = 0; r < 16; ++r) { s0[r] = __builtin_amdgcn_exp2f(s0[r] - mnew); ps += s0[r]; }
#pragma unroll
  for (int r = 0; r < 16; ++r) { s1[r] = __builtin_amdgcn_exp2f(s1[r] - mnew); ps += s1[r]; }
  lsum = lsum * alpha + ps;
#pragma unroll
  for (int r = 0; r < 16; ++r) { o0[r] *= alpha; o1[r] *= alpha; }
#pragma unroll
  for (int kk = 0; kk < 4; ++kk) {
    unsigned pk[4];
#pragma unroll
    for (int j = 0; j < 4; ++j) {
      float a = (kk < 2) ? s0[(kk & 1) * 8 + 2 * j] : s1[(kk & 1) * 8 + 2 * j];
      float b = (kk < 2) ? s0[(kk & 1) * 8 + 2 * j + 1] : s1[(kk & 1) * 8 + 2 * j + 1];
      pk[j] = pack2(a, b);
    }
    bf16x8 pb = __builtin_bit_cast(bf16x8, make_uint4(pk[0], pk[1], pk[2], pk[3]));
    const bf16* v0p = Vb + qi * VSTR + kk * 16 + half * 4;
    const bf16* v1p = Vb + (32 + qi) * VSTR + kk * 16 + half * 4;
    uint2 a0l = *(const uint2*)(v0p), a0h = *(const uint2*)(v0p + 8);
    uint2 a1l = *(const uint2*)(v1p), a1h = *(const uint2*)(v1p + 8);
    bf16x8 av0 = __builtin_bit_cast(bf16x8, make_uint4(a0l.x, a0l.y, a0h.x, a0h.y));
    bf16x8 av1 = __builtin_bit_cast(bf16x8, make_uint4(a1l.x, a1l.y, a1h.x, a1h.y));
    o0 = __builtin_amdgcn_mfma_f32_32x32x16_bf16(av0, pb, o0, 0, 0, 0);
    o1 = __builtin_amdgcn_mfma_f32_32x32x16_bf16(av1, pb, o1, 0, 0, 0);
  }
}

__device__ __forceinline__ void attn_item(const P& p, int bh, int qt, char* smem) {
  bf16* Ks = (bf16*)smem;
  const int t = otid() & 255, w = __builtin_amdgcn_readfirstlane(t >> 6), l = t & 63, qi = l & 31, half = l >> 5;
  const int q0 = qt * 128, wq0 = q0 + w * 32;
  const bf16* Qp = p.Q + ((size_t)bh * 4096 + wq0 + qi) * 96;
  bf16x8 qf[6];
#pragma unroll
  for (int ks = 0; ks < 6; ++ks) qf[ks] = *(const bf16x8*)(Qp + ks * 16 + half * 8);
  asm volatile("s_waitcnt vmcnt(0)" ::: "memory");
#pragma unroll
  for (int ks = 0; ks < 6; ++ks) asm volatile("" : "+v"(qf[ks]));
  const bf16* Kg = p.Kc + (size_t)bh * 4096 * 96;
  const bf16* Vg = p.Vt + (size_t)bh * 64 * 4096;
  const int nkt = 2 * qt + 2, nfull = 2 * qt;

  const int kr0r = t / 12, kr0c = t - kr0r * 12;
  const int kr1r = (t + 256) / 12, kr1c = (t + 256) - kr1r * 12;
  const int kr2r = (t + 512) / 12, kr2c = (t + 512) - kr2r * 12;
  const int vrow = t >> 3, vkc = t & 7;
  const bf16* kg0 = Kg + (size_t)kr0r * 96 + kr0c * 8;
  const bf16* kg1 = Kg + (size_t)kr1r * 96 + kr1c * 8;
  const bf16* kg2 = Kg + (size_t)kr2r * 96 + kr2c * 8;
  const bf16* vg0 = Vg + (size_t)vrow * 4096 + vkc * 8;
  const bf16* vg1 = Vg + (size_t)(vrow + 32) * 4096 + vkc * 8;
  const int ks0 = kr0r * KSTR + kr0c * 8, ks1 = kr1r * KSTR + kr1c * 8, ks2 = kr2r * KSTR + kr2c * 8;
  const int vs0 = 64 * KSTR + vrow * VSTR + vkc * 8, vs1 = 64 * KSTR + (vrow + 32) * VSTR + vkc * 8;
  uint4 kra, krb, krc, vra, vrb;
#define ATT_GLOAD(kt_) do { kra = *(const uint4*)(kg0 + (size_t)(kt_) * 64 * 96); krb = *(const uint4*)(kg1 + (size_t)(kt_) * 64 * 96); \
    krc = *(const uint4*)(kg2 + (size_t)(kt_) * 64 * 96); vra = *(const uint4*)(vg0 + (kt_) * 64); vrb = *(const uint4*)(vg1 + (kt_) * 64); } while (0)
#define ATT_LSTORE(buf_) do { bf16* kb_ = Ks + (buf_) * ATT_BUF; \
    *(uint4*)(kb_ + ks0) = kra; *(uint4*)(kb_ + ks1) = krb; *(uint4*)(kb_ + ks2) = krc; \
    ((uint2*)(kb_ + vs0))[0] = make_uint2(vra.x, vra.y); ((uint2*)(kb_ + vs0))[1] = make_uint2(vra.z, vra.w); \
    ((uint2*)(kb_ + vs1))[0] = make_uint2(vrb.x, vrb.y); ((uint2*)(kb_ + vs1))[1] = make_uint2(vrb.z, vrb.w); } while (0)
  ATT_GLOAD(0);
  ATT_LSTORE(0);
  ATT_GLOAD(1);
  ATT_LSTORE(1);
  __syncthreads();

  f32x16 o0, o1, sc0, sc1, sn0, sn1;
#pragma unroll
  for (int r = 0; r < 16; ++r) { o0[r] = 0.f; o1[r] = 0.f; sn0[r] = 0.f; sn1[r] = 0.f; }
  float mrun = -INFINITY, lsum = 0.f;
  const int qpos = wq0 + qi;
  att_qk(Ks, qf, qi, half, sc0, sc1);
  int bc = 0, bn = 1, bnn = 2;
  int kt = 0;
  for (; kt < nfull - 1; ++kt) {
    ATT_GLOAD(kt + 2);
    att_qk(Ks + bn * ATT_BUF, qf, qi, half, sn0, sn1);
    att_softmax_pv(Ks + bc * ATT_BUF + 64 * KSTR, sc0, sc1, o0, o1, mrun, lsum, qi, half, false, 0, qpos);
    ATT_LSTORE(bnn);
    __syncthreads();
    sc0 = sn0; sc1 = sn1;
    { int tb = bc; bc = bn; bn = bnn; bnn = tb; }
  }
  for (; kt < nkt; ++kt) {
    const bool more2 = (kt + 2 < nkt);
    if (more2) ATT_GLOAD(kt + 2);
    const bool need_next = (kt + 1 < nkt) && ((kt + 1) * 64 <= wq0 + 31);
    if (need_next) att_qk(Ks + bn * ATT_BUF, qf, qi, half, sn0, sn1);
    if (kt * 64 <= wq0 + 31)
      att_softmax_pv(Ks + bc * ATT_BUF + 64 * KSTR, sc0, sc1, o0, o1, mrun, lsum, qi, half, (kt * 64 + 63 > wq0), kt * 64, qpos);
    if (more2) ATT_LSTORE(bnn);
    __syncthreads();
    sc0 = sn0; sc1 = sn1;
    { int tb = bc; bc = bn; bn = bnn; bnn = tb; }
  }
  const float ltot = lsum + __shfl_xor(lsum, 32);
  const float inv = 1.f / ltot;
  const int b = bh >> 3, h = bh & 7;
  bf16* op = p.ycat + ((size_t)(b * 4096 + wq0 + qi)) * 1024 + 512 + h * 64 + half * 4;
  {
    float ss = 0.f;
#pragma unroll
    for (int r = 0; r < 16; ++r) { float a0 = o0[r] * inv, a1 = o1[r] * inv; ss += a0 * a0 + a1 * a1; }
    ss += __shfl_xor(ss, 32);
    if (half == 0) atomicAdd(p.rss_a + b * 4096 + wq0 + qi, ss);
  }
#pragma unroll
  for (int rg = 0; rg < 4; ++rg) {
    uint2 v0, v1;
    v0.x = pack2(o0[rg * 4 + 0] * inv, o0[rg * 4 + 1] * inv);
    v0.y = pack2(o0[rg * 4 + 2] * inv, o0[rg * 4 + 3] * inv);
    v1.x = pack2(o1[rg * 4 + 0] * inv, o1[rg * 4 + 1] * inv);
    v1.y = pack2(o1[rg * 4 + 2] * inv, o1[rg * 4 + 3] * inv);
    *(uint2*)(op + rg * 8) = v0;
    *(uint2*)(op + 32 + rg * 8) = v1;
  }
}

#define A2_STAGE 20480
#define A2_VOFF 12288
#define A2_NST 6

__device__ __forceinline__ void a2_qk(LAS unsigned char* st, const bf16x8 (&qf)[6], int qi, int half, f32x16& s0, f32x16& s1,
                                      float init = 0.f) {
#pragma unroll
  for (int r = 0; r < 16; ++r) { s0[r] = init; s1[r] = init; }
  bf16x8 a0[6], a1[6];
#pragma unroll
  for (int ks = 0; ks < 6; ++ks) {
    a0[ks] = *(const LAS bf16x8*)(st + ks * 2048 + qi * 32 + half * 16);
    a1[ks] = *(const LAS bf16x8*)(st + ks * 2048 + (32 + qi) * 32 + half * 16);
  }
  __builtin_amdgcn_sched_barrier(0);
  __builtin_amdgcn_s_setprio(1);
#pragma unroll
  for (int ks = 0; ks < 6; ++ks) {
    s0 = __builtin_amdgcn_mfma_f32_32x32x16_bf16(a0[ks], qf[ks], s0, 0, 0, 0);
    s1 = __builtin_amdgcn_mfma_f32_32x32x16_bf16(a1[ks], qf[ks], s1, 0, 0, 0);
  }
  __builtin_amdgcn_s_setprio(0);
}

__device__ __forceinline__ float xhalf_max(float x) {
  typedef __attribute__((ext_vector_type(2))) unsigned u2_t;
  const unsigned xi = __float_as_uint(x);
  u2_t r = __builtin_amdgcn_permlane32_swap(xi, xi, false, false);
  return fmaxf(__uint_as_float(r[0]), __uint_as_float(r[1]));
}
__device__ __forceinline__ void a2_mask(f32x16& s0, f32x16& s1, int half, int kbase, int qpos) {
#pragma unroll
  for (int r = 0; r < 16; ++r) {
    int key = kbase + (r >> 2) * 8 + half * 4 + (r & 3);
    if (key > qpos) s0[r] = -INFINITY;
    if (key + 32 > qpos) s1[r] = -INFINITY;
  }
}
__device__ __forceinline__ float a2_lanemax(const f32x16& s0, const f32x16& s1) {
  float m = s0[0];
#pragma unroll
  for (int r = 1; r < 16; ++r) m = fmaxf(m, s0[r]);
#pragma unroll
  for (int r = 0; r < 16; ++r) m = fmaxf(m, s1[r]);
  return m;
}
__device__ __forceinline__ void a2_update(float mt_, float& mrun, float& lsum, f32x16& o0, f32x16& o1) {
  mt_ = xhalf_max(mt_);
  if (__builtin_amdgcn_ballot_w64(mt_ > mrun + 8.f) != 0) {
    const float mnew = fmaxf(mrun, mt_);
    const float alpha = __builtin_amdgcn_exp2f(mrun - mnew);
    mrun = mnew;
    lsum *= alpha;
#pragma unroll
    for (int r = 0; r < 16; ++r) { o0[r] *= alpha; o1[r] *= alpha; }
  }
}
__device__ __forceinline__ bool a2_update_off(float mt_, bool first, float& moff, float& lsum, f32x16& o0, f32x16& o1,
                                              float& delta) {
  mt_ = xhalf_max(mt_);
  delta = 0.f;
  if (first || __builtin_amdgcn_ballot_w64(mt_ > 8.f) != 0) {
    delta = first ? mt_ : fmaxf(mt_, 0.f);
    if (!first) {
      const float alpha = __builtin_amdgcn_exp2f(-delta);
      lsum *= alpha;
#pragma unroll
      for (int r = 0; r < 16; ++r) { o0[r] *= alpha; o1[r] *= alpha; }
    }
    moff += delta;
    return true;
  }
  return false;
}
__device__ __forceinline__ float a2_exp0(f32x16& s0, f32x16& s1) {
  float ps = 0.f;
#pragma unroll
  for (int r = 0; r < 16; ++r) { s0[r] = __builtin_amdgcn_exp2f(s0[r]); ps += s0[r]; }
#pragma unroll
  for (int r = 0; r < 16; ++r) { s1[r] = __builtin_amdgcn_exp2f(s1[r]); ps += s1[r]; }
  return ps;
}
__device__ __forceinline__ float a2_exp(f32x16& s0, f32x16& s1, float mrun) {
  float ps = 0.f;
#pragma unroll
  for (int r = 0; r < 16; ++r) { s0[r] = __builtin_amdgcn_exp2f(s0[r] - mrun); ps += s0[r]; }
#pragma unroll
  for (int r = 0; r < 16; ++r) { s1[r] = __builtin_amdgcn_exp2f(s1[r] - mrun); ps += s1[r]; }
  return ps;
}
struct A2V { u32x2 vl0[4], vh0[4], vl1[4], vh1[4]; };
__device__ __forceinline__ void a2_vload(LAS unsigned char* vst, int qi, int half, A2V& f) {
  const int sw = (qi >> 1) & 7;
  LAS unsigned char* v0row = vst + qi * 128 + half * 8;
  LAS unsigned char* v1row = vst + (32 + qi) * 128 + half * 8;
#pragma unroll
  for (int kk = 0; kk < 4; ++kk) {
    const int olo = ((kk * 2) ^ sw) * 16, ohi = ((kk * 2 + 1) ^ sw) * 16;
    f.vl0[kk] = *(const LAS u32x2*)(v0row + olo); f.vh0[kk] = *(const LAS u32x2*)(v0row + ohi);
    f.vl1[kk] = *(const LAS u32x2*)(v1row + olo); f.vh1[kk] = *(const LAS u32x2*)(v1row + ohi);
  }
}
__device__ __forceinline__ void a2_pv(const A2V& f, const f32x16& s0, const f32x16& s1, f32x16& o0, f32x16& o1) {
  __builtin_amdgcn_s_setprio(1);
#pragma unroll
  for (int kk = 0; kk < 4; ++kk) {
    unsigned pk[4];
#pragma unroll
    for (int j = 0; j < 4; ++j) {
      float a = (kk < 2) ? s0[(kk & 1) * 8 + 2 * j] : s1[(kk & 1) * 8 + 2 * j];
      float b = (kk < 2) ? s0[(kk & 1) * 8 + 2 * j + 1] : s1[(kk & 1) * 8 + 2 * j + 1];
      pk[j] = pack2(a, b);
    }
    bf16x8 pb = __builtin_bit_cast(bf16x8, make_uint4(pk[0], pk[1], pk[2], pk[3]));
    bf16x8 av0 = __builtin_bit_cast(bf16x8, make_uint4(f.vl0[kk][0], f.vl0[kk][1], f.vh0[kk][0], f.vh0[kk][1]));
    bf16x8 av1 = __builtin_bit_cast(bf16x8, make_uint4(f.vl1[kk][0], f.vl1[kk][1], f.vh1[kk][0], f.vh1[kk][1]));
    o0 = __builtin_amdgcn_mfma_f32_32x32x16_bf16(av0, pb, o0, 0, 0, 0);
    o1 = __builtin_amdgcn_mfma_f32_32x32x16_bf16(av1, pb, o1, 0, 0, 0);
  }
  __builtin_amdgcn_s_setprio(0);
}
__device__ __forceinline__ void a2_softmax_pv(LAS unsigned char* vst, f32x16& s0, f32x16& s1, f32x16& o0, f32x16& o1,
                                              float& moff, float& lsum, int qi, int half, bool domask, int kbase,
                                              int qpos, bool first) {
  A2V f;
  a2_vload(vst, qi, half, f);
  __builtin_amdgcn_sched_barrier(0);
  if (domask) a2_mask(s0, s1, half, kbase, qpos);
  float delta;
  if (a2_update_off(a2_lanemax(s0, s1), first, moff, lsum, o0, o1, delta)) {
#pragma unroll
    for (int r = 0; r < 16; ++r) { s0[r] -= delta; s1[r] -= delta; }
  }
  lsum += a2_exp0(s0, s1);
  a2_pv(f, s0, s1, o0, o1);
}
__device__ __forceinline__ void a2_softmax_pv2(LAS unsigned char* vstA, LAS unsigned char* vstB, f32x16& a0, f32x16& a1,
                                               f32x16& b0, f32x16& b1, f32x16& o0, f32x16& o1, float& moff,
                                               float& lsum, int qi, int half, bool first) {
  A2V f;
  a2_vload(vstA, qi, half, f);
  __builtin_amdgcn_sched_barrier(0);
  float delta;
  if (a2_update_off(fmaxf(a2_lanemax(a0, a1), a2_lanemax(b0, b1)), first, moff, lsum, o0, o1, delta)) {
#pragma unroll
    for (int r = 0; r < 16; ++r) { a0[r] -= delta; a1[r] -= delta; b0[r] -= delta; b1[r] -= delta; }
  }
  lsum += a2_exp0(a0, a1);
  a2_pv(f, a0, a1, o0, o1);
  a2_vload(vstB, qi, half, f);
  lsum += a2_exp0(b0, b1);
  a2_pv(f, b0, b1, o0, o1);
}

__device__ __forceinline__ void attn256_item(const P& p, int bh, int qt, LAS unsigned char* lds, bool do_atomic = true) {
  const int t = otid(), w = __builtin_amdgcn_readfirstlane(t >> 6), l = t & 63, qi = l & 31, half = l >> 5;
  const int q0 = qt * 256, wq0 = q0 + w * 32;
  const bf16* Qp = p.Q + ((size_t)bh * 4096 + wq0 + qi) * 96;
  bf16x8 qf[6];
  const char* Kg = (const char*)(p.Kc + (size_t)bh * 4096 * 96);
  const char* Vg = (const char*)(p.Vt + (size_t)bh * 64 * 4096);
  const int nkt = 4 * qt + 4, nfull = 4 * qt;

  const int p2 = 512 + (t & 255);
  const unsigned ko1 = (unsigned)((((t >> 1) & 63) * 96 + ((t >> 7) * 2 + (t & 1)) * 8) * 2);
  const unsigned ko2 = (unsigned)((((p2 >> 1) & 63) * 96 + ((p2 >> 7) * 2 + (p2 & 1)) * 8) * 2);
  const int vdv = t >> 3;
  const unsigned vo = (unsigned)((vdv * 4096 + (((t & 7) ^ ((vdv >> 1) & 7)) * 8)) * 2);
  const unsigned ldsw = (unsigned)w * 1024u;
#define A2_ISSUE(kt_, st_) do { \
    const char* kb_ = Kg + (size_t)(kt_) * (64 * 96 * 2); const char* vb_ = Vg + (size_t)(kt_) * 128; \
    LAS unsigned char* sb_ = lds + (st_) * A2_STAGE; \
    __builtin_amdgcn_global_load_lds((const unsigned*)(kb_ + ko1), (LAS unsigned*)(sb_ + ldsw), 16, 0, 0); \
    if (w < 4) __builtin_amdgcn_global_load_lds((const unsigned*)(kb_ + ko2), (LAS unsigned*)(sb_ + 8192 + ldsw), 16, 0, 0); \
    __builtin_amdgcn_global_load_lds((const unsigned*)(vb_ + vo), (LAS unsigned*)(sb_ + A2_VOFF + ldsw), 16, 0, 0); } while (0)
#define A2_WAIT3 do { if (w < 4) asm volatile("s_waitcnt vmcnt(9)" ::: "memory"); else asm volatile("s_waitcnt vmcnt(6)" ::: "memory"); } while (0)
#define A2_WAIT0 asm volatile("s_waitcnt vmcnt(0)" ::: "memory")
#define A2_BAR asm volatile("s_waitcnt lgkmcnt(0)\n\ts_barrier" ::: "memory")

  A2_ISSUE(0, 0); A2_ISSUE(1, 1); A2_ISSUE(2, 2); A2_ISSUE(3, 3);
#pragma unroll
  for (int ks = 0; ks < 6; ++ks) qf[ks] = *(const bf16x8*)(Qp + ks * 16 + half * 8);
  A2_WAIT0;
#pragma unroll
  for (int ks = 0; ks < 6; ++ks) asm volatile("" : "+v"(qf[ks]));
  A2_BAR;

  f32x16 o0, o1, sa0, sa1, sb0, sb1;
#pragma unroll
  for (int r = 0; r < 16; ++r) { o0[r] = 0.f; o1[r] = 0.f; }
  float mrun = 0.f, lsum = 0.f;
  const int qpos = wq0 + qi;
  int sA = 0;
  int kt = 0;
#define A2_WAIT2 do { if (w < 4) asm volatile("s_waitcnt vmcnt(6)" ::: "memory"); else asm volatile("s_waitcnt vmcnt(4)" ::: "memory"); } while (0)
  for (; kt + 1 < nfull; kt += 2) {
    const int sI = (sA + 4 >= A2_NST) ? sA + 4 - A2_NST : sA + 4;
    A2_ISSUE(kt + 4, sI);
    A2_ISSUE(kt + 5, sI + 1);
    a2_qk(lds + sA * A2_STAGE, qf, qi, half, sa0, sa1, -mrun);
    a2_qk(lds + (sA + 1) * A2_STAGE, qf, qi, half, sb0, sb1, -mrun);
    a2_softmax_pv2(lds + sA * A2_STAGE + A2_VOFF, lds + (sA + 1) * A2_STAGE + A2_VOFF, sa0, sa1, sb0, sb1, o0, o1,
                   mrun, lsum, qi, half, kt == 0);
    A2_WAIT2;
    A2_BAR;
    sA = (sA + 2 >= A2_NST) ? 0 : sA + 2;
  }
  for (; kt < nkt; kt += 2) {
#pragma unroll
    for (int u = 0; u < 2; ++u) {
      const int k1 = kt + u;
      if (k1 * 64 <= wq0 + 31) {
        a2_qk(lds + (sA + u) * A2_STAGE, qf, qi, half, sa0, sa1, -mrun);
        a2_softmax_pv(lds + (sA + u) * A2_STAGE + A2_VOFF, sa0, sa1, o0, o1, mrun, lsum, qi, half, (k1 * 64 + 63 > wq0),
                      k1 * 64, qpos, k1 == 0);
      }
    }
    A2_WAIT0;
    A2_BAR;
    sA = (sA + 2 >= A2_NST) ? 0 : sA + 2;
  }
  const float ltot = lsum + __shfl_xor(lsum, 32);
  const float inv = 1.f / ltot;
  const int b = bh >> 3, h = bh & 7;
  bf16* op = p.ycat + ((size_t)(b * 4096 + wq0 + qi)) * 1024 + 512 + h * 64 + half * 4;
  {
    float ss = 0.f;
#pragma unroll
    for (int r = 0; r < 16; ++r) { float a0 = o0[r] * inv, a1 = o1[r] * inv; ss += a0 * a0 + a1 * a1; }
    ss += __shfl_xor(ss, 32);
    if (half == 0 && do_atomic) atomicAdd(p.rss_a + b * 4096 + wq0 + qi, ss);
  }
#pragma unroll
  for (int rg = 0; rg < 4; ++rg) {
    uint2 v0, v1;
    v0.x = pack2(o0[rg * 4 + 0] * inv, o0[rg * 4 + 1] * inv);
    v0.y = pack2(o0[rg * 4 + 2] * inv, o0[rg * 4 + 3] * inv);
    v1.x = pack2(o1[rg * 4 + 0] * inv, o1[rg * 4 + 1] * inv);
    v1.y = pack2(o1[rg * 4 + 2] * inv, o1[rg * 4 + 3] * inv);
    *(uint2*)(op + rg * 8) = v0;
    *(uint2*)(op + 32 + rg * 8) = v1;
  }
}

template <bool TOBF>
__device__ __forceinline__ void norm_rows(const P& p, const float* __restrict__ src, const float* __restrict__ g,
                                          int shift_off, int scale_off, bf16* dstb, float* dstf, int item) {
  const int t = otid() & 255, w = t >> 6, l = t & 63;
  const int row0 = item * 16 + w;
  float4 v[4][4];
  float ss[4] = {0.f, 0.f, 0.f, 0.f};
#pragma unroll
  for (int q = 0; q < 4; ++q) {
    const float4* sp = (const float4*)(src + (size_t)(row0 + 4 * q) * 1024);
#pragma unroll
    for (int i = 0; i < 4; ++i) v[q][i] = ld_nt4((const float*)(sp + i * 64 + l));
  }
#pragma unroll
  for (int q = 0; q < 4; ++q)
#pragma unroll
    for (int i = 0; i < 4; ++i)
      ss[q] += v[q][i].x * v[q][i].x + v[q][i].y * v[q][i].y + v[q][i].z * v[q][i].z + v[q][i].w * v[q][i].w;
#pragma unroll
  for (int o = 32; o >= 1; o >>= 1) {
#pragma unroll
    for (int q = 0; q < 4; ++q) ss[q] += __shfl_xor(ss[q], o);
  }
  const float* md = p.mod + (row0 >> 12) * 8192;
#pragma unroll
  for (int i = 0; i < 4; ++i) {
    const int col = i * 256 + l * 4;
    float4 gg = *(const float4*)(g + col);
    float4 sc = *(const float4*)(md + scale_off + col);
    float4 sh = *(const float4*)(md + shift_off + col);
    const float m0 = gg.x * (1.f + sc.x), m1 = gg.y * (1.f + sc.y), m2 = gg.z * (1.f + sc.z), m3 = gg.w * (1.f + sc.w);
#pragma unroll
    for (int q = 0; q < 4; ++q) {
      const float rstd = rsqrtf(ss[q] * (1.f / 1024.f) + EPSN);
      const int row = row0 + 4 * q;
      float y0 = v[q][i].x * rstd * m0 + sh.x;
      float y1 = v[q][i].y * rstd * m1 + sh.y;
      float y2 = v[q][i].z * rstd * m2 + sh.z;
      float y3 = v[q][i].w * rstd * m3 + sh.w;
      if (TOBF) {
        uint2 o; o.x = pack2(y0, y1); o.y = pack2(y2, y3);
        *(uint2*)(dstb + (size_t)row * 1024 + col) = o;
      } else {
        st_nt4(dstf + (size_t)row * 1024 + col, make_float4(y0, y1, y2, y3));
      }
    }
  }
}

__device__ __forceinline__ void mod_item(const P& p, int item, char* smem, const int mode = 0) {
  float* cnd = (float*)smem;
  float* red = (float*)(smem + 8192);
  const int t = otid() & 255;
  const int cbk = (mode == 0) ? (item & 31) : (item & 15), ksp = (mode == 0) ? (item >> 5) : (item >> 4);
  const int n0 = cbk * 256, k0 = ksp * 128;
  const float* W; int ldw; int nn0; const float* bias;
  if (mode == 1) { W = p.w_ff1; ldw = 4096; nn0 = n0; bias = nullptr; }
  else if (n0 < 6144) { W = p.ada_w; ldw = 6144; nn0 = n0; bias = p.ada_b; }
  else { W = p.fada_w; ldw = 2048; nn0 = n0 - 6144; bias = p.fada_b; }
#pragma unroll
  for (int i = 0; i < 8; ++i) {
    int idx = i * 256 + t, b = idx >> 7, kk = idx & 127;
    if (mode == 1) {
      cnd[idx] = p.mod[b * 8192 + 3072 + k0 + kk];
    } else {
      float c = p.c[b * 1024 + k0 + kk];
      cnd[idx] = c * sigmoidf(c);
    }
  }
  __syncthreads();
  const int c4 = (t & 63) * 4, kq = t >> 6;
  float4 acc[16];
#pragma unroll
  for (int b = 0; b < 16; ++b) acc[b] = make_float4(0.f, 0.f, 0.f, 0.f);
  const float* wp = W + (size_t)(k0 + kq * 32) * ldw + nn0 + c4;
  for (int kb = 0; kb < 32; kb += 8) {
    float4 w[8];
#pragma unroll
    for (int u = 0; u < 8; ++u) w[u] = *(const float4*)(wp + (size_t)(kb + u) * ldw);
    __builtin_amdgcn_sched_barrier(0);
#pragma unroll
    for (int u = 0; u < 8; ++u) {
#pragma unroll
      for (int b = 0; b < 16; ++b) {
        float cv = cnd[b * 128 + kq * 32 + kb + u];
        acc[b].x += cv * w[u].x; acc[b].y += cv * w[u].y; acc[b].z += cv * w[u].z; acc[b].w += cv * w[u].w;
      }
      __builtin_amdgcn_sched_barrier(0);
    }
  }
#pragma unroll
  for (int b = 0; b < 16; ++b) *(float4*)(red + (kq * 16 + b) * 256 + c4) = acc[b];
  __syncthreads();
#pragma unroll
  for (int i = 0; i < 16; ++i) {
    int o = i * 256 + t, b = o >> 8, c = o & 255;
    float s = red[(0 * 16 + b) * 256 + c] + red[(1 * 16 + b) * 256 + c] + red[(2 * 16 + b) * 256 + c] + red[(3 * 16 + b) * 256 + c];
    if (mode == 1) {
      atomicAdd(p.biasff + b * 4096 + n0 + c, s);
    } else {
      if (ksp == 0) s += bias[nn0 + c];
      atomicAdd(p.mod + b * 8192 + n0 + c, s);
    }
  }
  __syncthreads();
}

__device__ __forceinline__ void tr_tile(const float* __restrict__ W, int K, int N, bf16* __restrict__ Wt,
                                        const float* __restrict__ rsA, const float* __restrict__ rsB, int splitK,
                                        int glu, int kt, int ntile, char* smem) {
  float* tile = (float*)smem;
  const int t = otid() & 255;
  const int k0 = kt * 64, n0 = ntile * 64;
#pragma unroll
  for (int i = 0; i < 4; ++i) {
    int r = (t >> 4) + 16 * i, c4 = (t & 15) * 4;
    float4 v = make_float4(0.f, 0.f, 0.f, 0.f);
    if (n0 + c4 < N) v = *(const float4*)(W + (size_t)(k0 + r) * N + n0 + c4);
    float sc = 1.f;
    if (rsA) { int k = k0 + r; sc = (k < splitK) ? rsA[k] : rsB[k - splitK]; }
    tile[(c4 + 0) * 65 + r] = v.x * sc;
    tile[(c4 + 1) * 65 + r] = v.y * sc;
    tile[(c4 + 2) * 65 + r] = v.z * sc;
    tile[(c4 + 3) * 65 + r] = v.w * sc;
  }
  __syncthreads();
  {
    int n = t >> 2, ks = (t & 3) * 16;
    int no = n0 + n;
    if (glu) { int vv = (no < 512) ? no : no - 512; no = (vv >> 4) * 32 + (vv & 15) + ((no < 512) ? 0 : 16); }
    unsigned o[8];
#pragma unroll
    for (int j = 0; j < 8; ++j) o[j] = pack2(tile[n * 65 + ks + 2 * j], tile[n * 65 + ks + 2 * j + 1]);
    uint4* dp = (uint4*)(Wt + (size_t)no * K + k0 + ks);
    dp[0] = make_uint4(o[0], o[1], o[2], o[3]);
    dp[1] = make_uint4(o[4], o[5], o[6], o[7]);
  }
  __syncthreads();
}

__device__ __forceinline__ float2 cmul(float2 a, float2 b) {
  return make_float2(a.x * b.x - a.y * b.y, a.x * b.y + a.y * b.x);
}
__device__ __forceinline__ float2 lam_pow(float lre, float lim, float dt, int m) {
  float mag = __expf((float)m * lre * dt);
  float s, c;
  sincosf((float)m * lim * dt, &s, &c);
  return make_float2(mag * c, mag * s);
}
__device__ __forceinline__ float2 zoh_fac(float lre, float lim, float dt) {
  float2 lb = lam_pow(lre, lim, dt, 1);
  float nr = lb.x - 1.f, ni = lb.y;
  float den = lre * lre + lim * lim;
  return make_float2((nr * lre + ni * lim) / den, (ni * lre - nr * lim) / den);
}

__device__ __forceinline__ void ktab_item(const P& p, int item, char* smem) {
  float2* lamm = (float2*)smem;
  float2* fac = lamm + 64;
  float2* CL = fac + 64;
  float2* BB = CL + 1024;
  const int t = otid() & 255;
  const int g = item >> 6, m = item & 63;
  if (t < 64) {
    float lre = p.lam_re[g * 64 + t], lim = p.lam_im[g * 64 + t], dt = __expf(p.log_dt[g]);
    lamm[t] = lam_pow(lre, lim, dt, m);
    fac[t] = zoh_fac(lre, lim, dt);
  }
  float cr[4], ci[4], br[4], bi[4];
#pragma unroll
  for (int i = 0; i < 4; ++i) {
    const int idx = g * 1024 + i * 256 + t;
    cr[i] = p.c_re[idx]; ci[i] = p.c_im[idx]; br[i] = p.b_re[idx]; bi[i] = p.b_im[idx];
  }
  __syncthreads();
#pragma unroll
  for (int i = 0; i < 4; ++i) {
    const int idx = i * 256 + t;
    CL[idx] = cmul(make_float2(cr[i], ci[i]), lamm[idx & 63]);
    BB[idx] = cmul(fac[idx >> 4], make_float2(br[i], bi[i]));
  }
  __syncthreads();
  const int h = t >> 4, hp = t & 15;
  float s = 0.f;
#pragma unroll 8
  for (int pp = 0; pp < 64; ++pp) {
    float2 c = CL[h * 64 + pp], bq = BB[pp * 16 + hp];
    s += c.x * bq.x - c.y * bq.y;
  }
  p.ktab[((size_t)(g * 64 + m) * 16 + h) * 16 + hp] = s;
  __syncthreads();
}

#define TR_IN 320
#define TR_GLU 128
#define TR_UQ 72
#define TR_UKV 64
#define TR_OUT 256
#define TR_FF1 1024
#define TR_FF2 1024

template <int PH>
__device__ __forceinline__ void run_phase(const P& p, int bid_, int nb_, char* smem_) {
  const int hb = __builtin_amdgcn_readfirstlane((otid() >> 8));
  const int bid = bid_ * 2 + hb, nb = nb_ * 2;
  char* smem = smem_ + hb * HSMEM;
  LAS unsigned char* lds = (LAS unsigned char*)smem_;
  const int t = otid() & 255;
  if (PH == 0) {
    const int n_mod = 256;
    const int n_tr = TR_IN + TR_GLU + TR_UQ + TR_UKV + TR_OUT + TR_FF1 + TR_FF2;
    const int n_kt = 2048;
    const int n_pw = (32 * 65 * 64) / 256;
    const int n_bb = (32 * 64 * 16) / 256;
    const int n_cs = (65536 * 16) / 256;
    const int total = n_mod + n_tr + n_kt + n_pw + n_bb + n_cs;
    for (int it = bid; it < total; it += nb) {
      int i = it;
      if (i < n_mod) { mod_item(p, i, smem); continue; }
      i -= n_mod;
      if (i < n_tr) {
        if (i < TR_IN) { tr_tile(p.w_in, 1024, 1184, p.Wt_in, nullptr, nullptr, 0, 0, i % 16, i / 16, smem); continue; }
        i -= TR_IN;
        if (i < TR_GLU) { tr_tile(p.w_glu, 512, 1024, p.Wt_glu, nullptr, nullptr, 0, 1, i % 8, i / 8, smem); continue; }
        i -= TR_GLU;
        if (i < TR_UQ) { tr_tile(p.w_uq, 384, 768, p.Wt_uq, p.q_norm_g, p.q_norm_g, 384, 0, i % 6, i / 6, smem); continue; }
        i -= TR_UQ;
        if (i < TR_UKV) { tr_tile(p.w_ukv, 256, 1024, p.Wt_ukv, p.kv_norm_g, p.kv_norm_g, 256, 0, i % 4, i / 4, smem); continue; }
        i -= TR_UKV;
        if (i < TR_OUT) { tr_tile(p.w_out, 1024, 1024, p.Wt_out, p.ssm_out_g, p.attn_out_g, 512, 0, i % 16, i / 16, smem); continue; }
        i -= TR_OUT;
        if (i < TR_FF1) { tr_tile(p.w_ff1, 1024, 4096, p.Wt_ff1, nullptr, nullptr, 0, 0, i % 16, i / 16, smem); continue; }
        i -= TR_FF1;
        tr_tile(p.w_ff2, 4096, 1024, p.Wt_ff2, nullptr, nullptr, 0, 0, i % 64, i / 64, smem);
        continue;
      }
      i -= n_tr;
      if (i < n_kt) { ktab_item(p, i, smem); continue; }
      i -= n_kt;
      if (i < n_pw) {
        int idx = i * 256 + t;
        int pp = idx & 63, m = (idx >> 6) % 65, g = idx / (64 * 65);
        float dt = __expf(p.log_dt[g]);
        p.pw[idx] = lam_pow(p.lam_re[g * 64 + pp], p.lam_im[g * 64 + pp], dt, m);
        continue;
      }
      i -= n_pw;
      if (i < n_bb) {
        int idx = i * 256 + t;
        int gp = idx >> 4;
        int g = gp >> 6;
        float dt = __expf(p.log_dt[g]);
        float2 f = zoh_fac(p.lam_re[gp], p.lam_im[gp], dt);
        p.bbar[idx] = cmul(f, make_float2(p.b_re[idx], p.b_im[idx]));
        continue;
      }
      i -= n_bb;
      {
        int idx = i * 256 + t;
        int tok = idx >> 4, ii = idx & 15;
        float invf = exp2f(-(float)ii * (13.287712379549449f / 16.f));
        float ang = (float)p.pos[tok] * invf;
        float s, c;
        sincosf(ang, &s, &c);
        p.cs[idx] = make_float2(c, s);
      }
    }
  } else if (PH == 1) {
    const int n_norm = 4096;
    const int n_te = (32 * 1024 * 144) / 256;
    const int n_f = (32 * 128 * 128) / 256;
    const int total = n_norm + n_te + n_f;
    for (int it = bid; it < total; it += nb) {
      int i = it;
      if (i < n_norm) { norm_rows<true>(p, p.x, p.norm1_g, 0, 1024, p.hbuf, nullptr, i); continue; }
      i -= n_norm;
      if (i < n_te) {
        int idx = i * 256 + t;
        int k8 = idx % 144, n = (idx / 144) & 1023, g = idx / (144 * 1024);
        int k = k8 * 8, j = n >> 4, h = n & 15;
        if (k < 1024 && k >= ((n >> 7) + 1) * 128) continue;
        float v[8];
        if (k < 1024) {
          int ii = k >> 4, hp0 = k & 15;
          if (ii <= j) {
            const float* kp = p.ktab + ((size_t)(g * 64 + (j - ii)) * 16 + h) * 16 + hp0;
            float4 a = *(const float4*)kp, b = *(const float4*)(kp + 4);
            v[0] = a.x; v[1] = a.y; v[2] = a.z; v[3] = a.w; v[4] = b.x; v[5] = b.y; v[6] = b.z; v[7] = b.w;
          } else {
#pragma unroll
            for (int q = 0; q < 8; ++q) v[q] = 0.f;
          }
        } else {
          int q = k - 1024, p0 = q & 63, isim = q >> 6;
#pragma unroll
          for (int jj = 0; jj < 8; ++jj) {
            int pp = p0 + jj;
            float2 C = make_float2(p.c_re[(g * 16 + h) * 64 + pp], p.c_im[(g * 16 + h) * 64 + pp]);
            float2 L = p.pw[(size_t)(g * 65 + j + 1) * 64 + pp];
            float2 pr = cmul(C, L);
            v[jj] = isim ? -pr.y : pr.x;
          }
        }
        uint4 o = make_uint4(pack2(v[0], v[1]), pack2(v[2], v[3]), pack2(v[4], v[5]), pack2(v[6], v[7]));
        *(uint4*)(p.Bty + ((size_t)(g * 1024 + n)) * 1152 + k) = o;
        continue;
      }
      i -= n_te;
      {
        int idx = i * 256 + t;
        int k8 = idx & 127, n = (idx >> 7) & 127, g = idx >> 14;
        int k = k8 * 8, ii = k >> 4, hp0 = k & 15;
        int pp = n & 63, isim = n >> 6;
        float2 L = p.pw[(size_t)(g * 65 + 63 - ii) * 64 + pp];
        float v[8];
#pragma unroll
        for (int jj = 0; jj < 8; ++jj) {
          float2 pr = cmul(L, p.bbar[(size_t)(g * 64 + pp) * 16 + hp0 + jj]);
          v[jj] = isim ? pr.y : pr.x;
        }
        uint4 o = make_uint4(pack2(v[0], v[1]), pack2(v[2], v[3]), pack2(v[4], v[5]), pack2(v[6], v[7]));
        *(uint4*)(p.Fm + ((size_t)(g * 128 + n)) * 1024 + k) = o;
      }
    }
  } else if (PH == 2) {
    gemm256_phase<EPI_INPROJ, 0>(p, p.hbuf, 1024, p.Wt_in, 1024, 1024, 5, bid_, nb_, lds);
  } else if (PH == 3) {
    gemm256_phase<EPI_KV, 0>(p, p.kvlat, 256, p.Wt_ukv, 256, 256, 4, bid_, nb_, lds);
    gemm256_phase<EPI_Q, 0>(p, p.qlat, 384, p.Wt_uq, 384, 384, 3, bid_, nb_, lds);
    for (int i = bid - 256; i >= 0 && i < 128; i += nb) mod_item(p, i, smem, 1);
    for (int i = bid; i < 256; i += nb) {
      int g = i >> 3, mt = i & 7;
      gemm_tile<EPI_S, 0>(p, p.Ag + (size_t)g * 1024 * 1152, 1152, p.Fm + (size_t)g * 128 * 1024, 1024, 16, 16, 0,
                          mt * 128, 0, g, smem);
      __syncthreads();
      if (t < 128) {
        const int bsel = t >> 6, pp = t & 63;
        const float* Sst = (const float*)smem + (bsel * 64) * 129;
        const float2 LL = p.pw[(size_t)(g * 65 + 64) * 64 + pp];
        float2 X = make_float2(0.f, 0.f);
        bf16* xp_ = p.Ag + ((size_t)(g * 1024 + mt * 128 + bsel * 64)) * 1152 + 1024 + pp;
        for (int c = 0; c < 64; ++c) {
          xp_[(size_t)c * 1152] = f2bf(X.x);
          xp_[(size_t)c * 1152 + 64] = f2bf(X.y);
          const float sr = Sst[c * 129 + pp], si = Sst[c * 129 + 64 + pp];
          const float2 nx = cmul(LL, X);
          X = make_float2(nx.x + sr, nx.y + si);
        }
      }
      __syncthreads();
    }
  } else if (PH == 4) {
    const int total = 32768 / 256;
    for (int it = bid; it < total; it += nb) {
      int idx = it * 256 + t;
      int pp = idx & 63, b = (idx >> 6) & 15, g = idx >> 10;
      float2 LL = p.pw[(size_t)(g * 65 + 64) * 64 + pp];
      float2 X = make_float2(0.f, 0.f);
      const size_t rbase = (size_t)(g * 1024 + b * 64);
      for (int c0 = 0; c0 < 64; c0 += 16) {
        float sr[16], si[16];
#pragma unroll
        for (int q = 0; q < 16; ++q) {
          sr[q] = p.S[(rbase + c0 + q) * 128 + pp];
          si[q] = p.S[(rbase + c0 + q) * 128 + 64 + pp];
        }
#pragma unroll
        for (int q = 0; q < 16; ++q) {
          size_t row = rbase + c0 + q;
          p.Ag[row * 1152 + 1024 + pp] = f2bf(X.x);
          p.Ag[row * 1152 + 1088 + pp] = f2bf(X.y);
          float2 nx = cmul(LL, X);
          X = make_float2(nx.x + sr[q], nx.y + si[q]);
        }
      }
    }
  } else if (PH == 5) {
    const int na = 4096, ny = 2048;
    const int total = na + ny;
    if (nb_ == 256) {
      const int x = bid_ & 7, j = bid_ >> 3;
      for (int r = 0; r < 8; ++r) attn256_item(p, 16 * x + 2 * r + (j >> 4), (r & 1) ? (15 - (j & 15)) : (j & 15), lds);
#ifdef ATTN_TWICE
      for (int r = 0; r < 8; ++r) attn256_item(p, 16 * x + 2 * r + (j >> 4), (r & 1) ? (15 - (j & 15)) : (j & 15), lds, false);
#endif
    } else {
      for (int it = bid_; it < 2048; it += nb_) attn256_item(p, it & 127, 15 - (it >> 7), lds);
    }
    __syncthreads();
    if (nb_ == 256) {
      const int x = bid_ & 7, q = bid_ >> 3;
      for (int r = 0; r < 4; ++r) {
        const int g = x + 8 * r, nt = ((q & 7) + 2 * r) & 7, mt = (q >> 3) * 2 + hb;
        const int nk1 = 2 * nt + 2;
        gemm_tile<EPI_Y, 0>(p, p.Ag + (size_t)g * 1024 * 1152, 1152, p.Bty + (size_t)g * 1024 * 1152, 1152, nk1 + 2,
                            nk1, 16, mt * 128, nt * 128, g, smem);
      }
    } else
    for (int it = na + bid; it < total; it += nb) {
      int i = it;
      i -= na;
      {
        int mt = ((i >> 4) & 3) * 2 + (i & 1), nt = (i >> 1) & 7, g = i >> 6;
        int nk1 = 2 * nt + 2;
        gemm_tile<EPI_Y, 0>(p, p.Ag + (size_t)g * 1024 * 1152, 1152, p.Bty + (size_t)g * 1024 * 1152, 1152, nk1 + 2,
                            nk1, 16, mt * 128, nt * 128, g, smem);
      }
    }
  } else if (PH == 6) {
    gemm256_phase<EPI_GLU, 0>(p, p.ygelu, 512, p.Wt_glu, 512, 512, 4, bid_, nb_, lds);
  } else if (PH == 7) {
    gemm256_phase<EPI_OUT, 2>(p, p.ycat, 1024, p.Wt_out, 1024, 1024, 4, bid_, nb_, lds);
  } else if (PH == 8) {
    for (int it = bid; it < 4096; it += nb) norm_rows<true>(p, p.out, p.norm2_g, 3072, 4096, p.hbuf, nullptr, it);
  } else if (PH == 9) {
    gemm256_phase<EPI_FF1, 0>(p, p.hbuf, 1024, p.Wt_ff1, 1024, 1024, 16, bid_, nb_, lds);
  } else if (PH == 10) {
    gemm256_phase<EPI_FF2, 0>(p, p.hid, 4096, p.Wt_ff2, 4096, 4096, 4, bid_, nb_, lds);
  } else if (PH == 11) {
    for (int it = bid; it < 4096; it += nb) norm_rows<false>(p, p.out, p.fnorm_g, 6144, 7168, nullptr, p.out, it);
  }
}

template <int PH>
__global__ void __launch_bounds__(NT, 2) k_phase(P p) {
  __shared__ __attribute__((aligned(16))) char smem[SMEM_BYTES];
  run_phase<PH>(p, blockIdx.x, gridDim.x, smem);
}

__global__ void __launch_bounds__(NT, 2) k_mega(P p) {
  __shared__ __attribute__((aligned(16))) char smem[SMEM_BYTES];
  cg::grid_group grid = cg::this_grid();
  const int bid = blockIdx.x, nb = gridDim.x;
#ifndef DUPMASK
#define DUPMASK 0
#endif
#define RUNP(ph) run_phase<ph>(p, bid, nb, smem); grid.sync(); if (DUPMASK & (1 << ph)) { run_phase<ph>(p, bid, nb, smem); grid.sync(); }
  RUNP(0) RUNP(1) RUNP(2) RUNP(3) RUNP(5) RUNP(6) RUNP(7) RUNP(9)
  run_phase<10>(p, bid, nb, smem); grid.sync();
  run_phase<11>(p, bid, nb, smem);
}

extern "C" void kernel_launch(void* const* d_in, const int* in_sizes, int n_in, void* d_out, int out_size, void* d_ws,
                              size_t ws_size, hipStream_t stream) {
  P p{};
  p.x = (const float*)d_in[0]; p.c = (const float*)d_in[1]; p.pos = (const int*)d_in[2];
  p.ada_w = (const float*)d_in[3]; p.ada_b = (const float*)d_in[4]; p.norm1_g = (const float*)d_in[5];
  p.w_in = (const float*)d_in[6]; p.lam_re = (const float*)d_in[7]; p.lam_im = (const float*)d_in[8];
  p.b_re = (const float*)d_in[9]; p.b_im = (const float*)d_in[10]; p.c_re = (const float*)d_in[11];
  p.c_im = (const float*)d_in[12]; p.ssm_d = (const float*)d_in[13]; p.log_dt = (const float*)d_in[14];
  p.w_glu = (const float*)d_in[15]; p.q_norm_g = (const float*)d_in[16]; p.w_uq = (const float*)d_in[17];
  p.kv_norm_g = (const float*)d_in[18]; p.w_ukv = (const float*)d_in[19]; p.ssm_out_g = (const float*)d_in[20];
  p.attn_out_g = (const float*)d_in[21]; p.w_out = (const float*)d_in[22]; p.norm2_g = (const float*)d_in[23];
  p.w_ff1 = (const float*)d_in[24]; p.w_ff2 = (const float*)d_in[25]; p.fada_w = (const float*)d_in[26];
  p.fada_b = (const float*)d_in[27]; p.fnorm_g = (const float*)d_in[28];
  p.out = (float*)d_out;
  char* ws = (char*)d_ws;
  size_t off = 0;
  auto take = [&](size_t bytes) { char* r = ws + off; off += (bytes + 255) & ~(size_t)255; return r; };
  p.Wt_in = (bf16*)take(1280ull * 1024 * 2);
  p.Wt_glu = (bf16*)take(1024ull * 512 * 2);
  p.Wt_uq = (bf16*)take(768ull * 384 * 2);
  p.Wt_ukv = (bf16*)take(1024ull * 256 * 2);
  p.Wt_out = (bf16*)take(1024ull * 1024 * 2);
  p.Wt_ff1 = (bf16*)take(4096ull * 1024 * 2);
  p.Wt_ff2 = (bf16*)take(1024ull * 4096 * 2);
  p.mod = (float*)take(16ull * 8192 * 4);
  p.rss_q = (float*)take(65536ull * 4);
  p.rss_kv = (float*)take(65536ull * 4);
  p.rss_s = (float*)take(65536ull * 4);
  p.rss_a = (float*)take(65536ull * 4);
  p.rss_x = (float*)take(65536ull * 4);
  p.biasff = (float*)take(16ull * 4096 * 4);
  p.pw = (float2*)take(32ull * 65 * 64 * 8);
  p.bbar = (float2*)take(32ull * 64 * 16 * 8);
  p.ktab = (float*)take(32ull * 64 * 256 * 4);
  p.cs = (float2*)take(65536ull * 16 * 8);
  p.hbuf = (bf16*)take(65536ull * 1024 * 2);
  size_t region = off;
  p.Ag = (bf16*)take(32ull * 1024 * 1152 * 2);
  p.Bty = (bf16*)take(32ull * 1024 * 1152 * 2);
  p.Fm = (bf16*)take(32ull * 128 * 1024 * 2);
  p.S = (float*)take(32ull * 1024 * 128 * 4);
  p.qlat = (bf16*)take(65536ull * 384 * 2);
  p.kvlat = (bf16*)take(65536ull * 256 * 2);
  p.Q = (bf16*)take(128ull * 4096 * 96 * 2);
  p.Kc = (bf16*)take(128ull * 4096 * 96 * 2);
  p.Vt = (bf16*)take(128ull * 64 * 4096 * 2);
  p.ygelu = (bf16*)take(65536ull * 512 * 2);
  p.ycat = (bf16*)take(65536ull * 1024 * 2);
  p.hid = (bf16*)(ws + region);

  hipMemsetAsync(p.mod, 0, 16ull * 8192 * 4 + 5ull * 65536 * 4 + 16ull * 4096 * 4, stream);
#if ONE_LAUNCH
  static int grid_blocks = 0;
  if (!grid_blocks) {
    int dev = 0, cus = 0, per_cu = 0;
    hipGetDevice(&dev);
    hipDeviceGetAttribute(&cus, hipDeviceAttributeMultiprocessorCount, dev);
    hipOccupancyMaxActiveBlocksPerMultiprocessor(&per_cu, k_mega, NT, 0);
    if (per_cu > 1) per_cu = 1;
    if (per_cu < 1) per_cu = 1;
    grid_blocks = cus * per_cu;
  }
  void* args[] = {&p};
  hipError_t e = hipLaunchCooperativeKernel((void*)k_mega, dim3(grid_blocks), dim3(NT), args, 0, stream);
  if (e != hipSuccess) fprintf(stderr, "cooperative launch failed: %s (grid %d)\n", hipGetErrorString(e), grid_blocks);
#else
  const int G = 256;
  k_phase<0><<<G, NT, 0, stream>>>(p);
  k_phase<1><<<G, NT, 0, stream>>>(p);
  k_phase<2><<<G, NT, 0, stream>>>(p);
  k_phase<3><<<G, NT, 0, stream>>>(p);
  k_phase<5><<<G, NT, 0, stream>>>(p);
  k_phase<6><<<G, NT, 0, stream>>>(p);
  k_phase<7><<<G, NT, 0, stream>>>(p);
  k_phase<9><<<G, NT, 0, stream>>>(p);
  k_phase<10><<<G, NT, 0, stream>>>(p);
  k_phase<11><<<G, NT, 0, stream>>>(p);
#endif
}
```

```cpp
#include <hip/hip_runtime.h>
#include <hip/hip_cooperative_groups.h>
#include <stdint.h>
#include <cstdio>
namespace cg = cooperative_groups;

#ifndef ONE_LAUNCH
#define ONE_LAUNCH 1
#endif

typedef unsigned short bf16;
typedef __attribute__((ext_vector_type(8))) short bf16x8;
typedef __attribute__((ext_vector_type(4))) float f32x4;
typedef __attribute__((ext_vector_type(16))) float f32x16;

#define NT 512
#define HSMEM (73728 + 1024)
#define SMEM_BYTES (2 * HSMEM)
#define LAS __attribute__((address_space(3)))
#define EPSN 1e-6f
#define QSCALE (0.10206207261596577f * 1.4426950408889634f)

struct P {
  const float *x, *c; const int* pos;
  const float *ada_w, *ada_b, *norm1_g, *w_in, *lam_re, *lam_im, *b_re, *b_im, *c_re, *c_im, *ssm_d, *log_dt,
      *w_glu, *q_norm_g, *w_uq, *kv_norm_g, *w_ukv, *ssm_out_g, *attn_out_g, *w_out, *norm2_g, *w_ff1, *w_ff2,
      *fada_w, *fada_b, *fnorm_g;
  float* out;
  bf16 *Wt_in, *Wt_glu, *Wt_uq, *Wt_ukv, *Wt_out, *Wt_ff1, *Wt_ff2;
  float* mod; float2* pw; float2* bbar; float* ktab; float2* cs;
  bf16* hbuf; bf16 *Ag, *Bty, *Fm; float* S;
  bf16 *qlat, *kvlat, *Q, *Kc, *Vt, *ygelu, *ycat, *hid;
  float *rss_q, *rss_kv, *rss_s, *rss_a, *rss_x, *biasff;
};

__device__ __forceinline__ int otid() { int t = threadIdx.x; asm volatile("" : "+v"(t)); return t; }
__device__ __forceinline__ float bf2f(unsigned h) { return __uint_as_float(h << 16); }
__device__ __forceinline__ unsigned pack2(float a, float b) {
  typedef __attribute__((ext_vector_type(2))) __bf16 bf2;
  bf2 v; v[0] = (__bf16)a; v[1] = (__bf16)b;
  return __builtin_bit_cast(unsigned, v);
}
__device__ __forceinline__ bf16 f2bf(float a) { return (bf16)(pack2(a, 0.f) & 0xffffu); }
__device__ __forceinline__ float sq2(unsigned w) {
  float a = __uint_as_float(w << 16), b = __uint_as_float(w & 0xffff0000u);
  return a * a + b * b;
}
__device__ __forceinline__ float4 ld_nt4(const float* q) { f32x4 w = __builtin_nontemporal_load((const f32x4*)q); return make_float4(w[0], w[1], w[2], w[3]); }
__device__ __forceinline__ void st_nt4(float* q, float4 v) { f32x4 w; w[0] = v.x; w[1] = v.y; w[2] = v.z; w[3] = v.w; __builtin_nontemporal_store(w, (f32x4*)q); }
__device__ __forceinline__ float gelu_tanh(float x) {
  float z = 0.7978845608028654f * (x + 0.044715f * x * x * x);
  float e = __expf(2.f * z);
  float th = 1.f - 2.f / (e + 1.f);
  return 0.5f * x * (1.f + th);
}
__device__ __forceinline__ float sigmoidf(float x) { return 1.f / (1.f + __expf(-x)); }

enum { EPI_INPROJ = 0, EPI_Q, EPI_KV, EPI_S, EPI_Y, EPI_GLU, EPI_OUT, EPI_FF1, EPI_FF2 };

template <int EPI, int PRE>
__device__ __forceinline__ void gemm_tile(const P& p, const bf16* __restrict__ A, int lda, const bf16* __restrict__ Bt,
                                          int ldb, int nt_total, int nk1, int kjump, int m0, int n0, int g,
                                          char* smem) {
  bf16* As = (bf16*)smem;
  bf16* Bs = As + 2 * 128 * 72;
  float* rs = (float*)(Bs + 2 * 128 * 72);
  const int t = otid() & 255, w = __builtin_amdgcn_readfirstlane(t >> 6), l = t & 63, wm = w >> 1, wn = w & 1, lr = l & 15, lq = l >> 4;

  if (PRE == 1) {
    const int K = nt_total * 64;
    int row = t >> 1, hf = t & 1;
    const bf16* ap = A + (size_t)(m0 + row) * lda + hf * (K / 2);
    float ss = 0.f;
    for (int c = 0; c < K / 16; ++c) {
      uint4 v = *(const uint4*)(ap + c * 8);
      ss += sq2(v.x) + sq2(v.y) + sq2(v.z) + sq2(v.w);
    }
    ss += __shfl_xor(ss, 1);
    if (!hf) rs[row] = rsqrtf(ss / (float)K + EPSN);
  }
  if (PRE == 2) {
    int row = t >> 1, hf = t & 1;
    const bf16* ap = A + (size_t)(m0 + row) * lda + hf * 512;
    float ss = 0.f;
    for (int c = 0; c < 64; ++c) {
      uint4 v = *(const uint4*)(ap + c * 8);
      ss += sq2(v.x) + sq2(v.y) + sq2(v.z) + sq2(v.w);
    }
    rs[hf * 128 + row] = rsqrtf(ss / 512.f + EPSN);
  }

  f32x4 acc[4][4];
#pragma unroll
  for (int i = 0; i < 4; ++i)
#pragma unroll
    for (int j = 0; j < 4; ++j) acc[i][j] = (f32x4){0.f, 0.f, 0.f, 0.f};

  const int ldrow = t >> 3, ldkc = (t & 7) * 8;
  const bf16* Ap = A + (size_t)(m0 + ldrow) * lda + ldkc;
  const bf16* Bp = Bt + (size_t)(n0 + ldrow) * ldb + ldkc;
  uint4 ra[4], rb[4];
  {
    int kt = (0 < nk1) ? 0 : kjump;
#pragma unroll
    for (int i = 0; i < 4; ++i) {
      ra[i] = *(const uint4*)(Ap + (size_t)i * 32 * lda + kt * 64);
      rb[i] = *(const uint4*)(Bp + (size_t)i * 32 * ldb + kt * 64);
    }
#pragma unroll
    for (int i = 0; i < 4; ++i) {
      *(uint4*)(As + (ldrow + 32 * i) * 72 + ldkc) = ra[i];
      *(uint4*)(Bs + (ldrow + 32 * i) * 72 + ldkc) = rb[i];
    }
  }
  __syncthreads();

  for (int it = 0; it < nt_total; ++it) {
    const int buf = it & 1;
    const bool more = (it + 1 < nt_total);
    if (more) {
      int kt = (it + 1 < nk1) ? (it + 1) : (it + 1 - nk1 + kjump);
#pragma unroll
      for (int i = 0; i < 4; ++i) {
        ra[i] = *(const uint4*)(Ap + (size_t)i * 32 * lda + kt * 64);
        rb[i] = *(const uint4*)(Bp + (size_t)i * 32 * ldb + kt * 64);
      }
    }
    if (PRE == 2) {
      if (it == 8) {
#pragma unroll
        for (int mt = 0; mt < 4; ++mt)
#pragma unroll
          for (int r = 0; r < 4; ++r) {
            int rl = wm * 64 + mt * 16 + lq * 4 + r;
            float f = rs[rl] / rs[128 + rl];
#pragma unroll
            for (int nt = 0; nt < 4; ++nt) acc[mt][nt][r] *= f;
          }
      }
    }
    const bf16* Ab = As + buf * (128 * 72) + (wm * 64 + lr) * 72 + lq * 8;
    const bf16* Bb = Bs + buf * (128 * 72) + (wn * 64 + lr) * 72 + lq * 8;
#pragma unroll
    for (int ks = 0; ks < 2; ++ks) {
      bf16x8 a[4], b[4];
#pragma unroll
      for (int i = 0; i < 4; ++i) {
        a[i] = *(const bf16x8*)(Ab + i * 16 * 72 + ks * 32);
        b[i] = *(const bf16x8*)(Bb + i * 16 * 72 + ks * 32);
      }
      __builtin_amdgcn_s_setprio(1);
#pragma unroll
      for (int mt = 0; mt < 4; ++mt)
#pragma unroll
        for (int nt = 0; nt < 4; ++nt)
          acc[mt][nt] = __builtin_amdgcn_mfma_f32_16x16x32_bf16(a[mt], b[nt], acc[mt][nt], 0, 0, 0);
      __builtin_amdgcn_s_setprio(0);
    }
    if (more) {
#pragma unroll
      for (int i = 0; i < 4; ++i) {
        *(uint4*)(As + (buf ^ 1) * (128 * 72) + (ldrow + 32 * i) * 72 + ldkc) = ra[i];
        *(uint4*)(Bs + (buf ^ 1) * (128 * 72) + (ldrow + 32 * i) * 72 + ldkc) = rb[i];
      }
    }
    __syncthreads();
  }

#pragma unroll
  for (int mt = 0; mt < 4; ++mt) {
    const int rl0 = wm * 64 + mt * 16 + lq * 4;
    const int row0 = m0 + rl0;
#pragma unroll
    for (int nt = 0; nt < 4; ++nt) {
      const int cb = n0 + wn * 64 + nt * 16;
      const int col = cb + lr;
      if (EPI == EPI_INPROJ) {
        if (cb < 512) {
          const int gg = cb >> 4;
#pragma unroll
          for (int r = 0; r < 4; ++r) {
            int row = row0 + r, b = row >> 12, s = row & 4095, c = s >> 6, j = s & 63;
            p.Ag[((size_t)(gg * 1024 + b * 64 + c)) * 1152 + j * 16 + lr] = f2bf(acc[mt][nt][r]);
          }
        } else if (cb < 896) {
#pragma unroll
          for (int r = 0; r < 4; ++r) p.qlat[(size_t)(row0 + r) * 384 + (col - 512)] = f2bf(acc[mt][nt][r]);
        } else if (cb < 1152) {
#pragma unroll
          for (int r = 0; r < 4; ++r) p.kvlat[(size_t)(row0 + r) * 256 + (col - 896)] = f2bf(acc[mt][nt][r]);
        } else if (cb == 1152) {
          if (nt < 3) {
#pragma unroll
            for (int r = 0; r < 4; ++r) {
              int row = row0 + r, b = row >> 12, s = row & 4095;
              float2 cs = p.cs[(size_t)row * 16 + lr];
              float x1 = acc[mt][nt][r], x2 = acc[mt][nt < 3 ? nt + 1 : nt][r];
              bf16 o1 = f2bf(x1 * cs.x - x2 * cs.y), o2 = f2bf(x1 * cs.y + x2 * cs.x);
#pragma unroll
              for (int h = 0; h < 8; ++h) {
                bf16* kp = p.Kc + ((size_t)((b * 8 + h) * 4096 + s)) * 96;
                kp[64 + lr] = o1;
                kp[80 + lr] = o2;
              }
            }
          }
        }
      } else if (EPI == EPI_Q) {
        const int hq = cb / 96, d0 = cb - hq * 96;
        if (d0 < 64) {
#pragma unroll
          for (int r = 0; r < 4; ++r) {
            int row = row0 + r, b = row >> 12, s = row & 4095;
            float v = acc[mt][nt][r] * rs[rl0 + r] * QSCALE;
            p.Q[((size_t)((b * 8 + hq) * 4096 + s)) * 96 + d0 + lr] = f2bf(v);
          }
        } else if (d0 == 64) {
          if (nt < 3) {
#pragma unroll
            for (int r = 0; r < 4; ++r) {
              int row = row0 + r, b = row >> 12, s = row & 4095;
              float sc = rs[rl0 + r] * QSCALE;
              float x1 = acc[mt][nt][r] * sc, x2 = acc[mt][nt < 3 ? nt + 1 : nt][r] * sc;
              float2 cs = p.cs[(size_t)row * 16 + lr];
              bf16* qp = p.Q + ((size_t)((b * 8 + hq) * 4096 + s)) * 96;
              qp[64 + lr] = f2bf(x1 * cs.x - x2 * cs.y);
              qp[80 + lr] = f2bf(x1 * cs.y + x2 * cs.x);
            }
          }
        }
      } else if (EPI == EPI_KV) {
        const int hk = cb >> 7, d0 = cb & 127;
        const int b = row0 >> 12, s0 = row0 & 4095;
        if (d0 < 64) {
#pragma unroll
          for (int r = 0; r < 4; ++r)
            p.Kc[((size_t)((b * 8 + hk) * 4096 + s0 + r)) * 96 + d0 + lr] = f2bf(acc[mt][nt][r] * rs[rl0 + r]);
        } else {
          uint2 v;
          v.x = pack2(acc[mt][nt][0] * rs[rl0 + 0], acc[mt][nt][1] * rs[rl0 + 1]);
          v.y = pack2(acc[mt][nt][2] * rs[rl0 + 2], acc[mt][nt][3] * rs[rl0 + 3]);
          *(uint2*)(p.Vt + ((size_t)((b * 8 + hk) * 64 + (d0 - 64) + lr)) * 4096 + s0) = v;
        }
      } else if (EPI == EPI_S) {
#pragma unroll
        for (int r = 0; r < 4; ++r) ((float*)smem)[(rl0 + r) * 129 + col] = acc[mt][nt][r];
      } else if (EPI == EPI_Y) {
        const float dd = p.ssm_d[g * 16 + lr];
        const int j = cb >> 4;
#pragma unroll
        for (int r = 0; r < 4; ++r) {
          int row = row0 + r, b = row >> 6, c = row & 63;
          float u = bf2f(p.Ag[((size_t)(g * 1024 + row)) * 1152 + col]);
          float y = gelu_tanh(acc[mt][nt][r] + dd * u);
          p.ygelu[((size_t)(b * 4096 + c * 64 + j)) * 512 + g * 16 + lr] = f2bf(y);
        }
      } else if (EPI == EPI_GLU) {
        if ((nt & 1) == 0) {
          const int oc = (cb >> 5) * 16 + lr;
#pragma unroll
          for (int r = 0; r < 4; ++r) {
            float v = acc[mt][nt][r] * sigmoidf(acc[mt][(nt & 1) == 0 ? nt + 1 : nt][r]);
            p.ycat[(size_t)(row0 + r) * 1024 + oc] = f2bf(v);
          }
        }
      } else if (EPI == EPI_OUT) {
#pragma unroll
        for (int r = 0; r < 4; ++r) {
          int row = row0 + r, b = row >> 12;
          size_t o = (size_t)row * 1024 + col;
          p.out[o] = p.x[o] + p.mod[b * 8192 + 2048 + col] * acc[mt][nt][r] * rs[128 + rl0 + r];
        }
      } else if (EPI == EPI_FF1) {
#pragma unroll
        for (int r = 0; r < 4; ++r) {
          float v = fmaxf(acc[mt][nt][r], 0.f);
          p.hid[(size_t)(row0 + r) * 4096 + col] = f2bf(v * v);
        }
      } else if (EPI == EPI_FF2) {
#pragma unroll
        for (int r = 0; r < 4; ++r) {
          int row = row0 + r, b = row >> 12;
          size_t o = (size_t)row * 1024 + col;
          p.out[o] = p.out[o] + p.mod[b * 8192 + 5120 + col] * acc[mt][nt][r];
        }
      }
    }
  }
  if (PRE != 0) __syncthreads();
}

__device__ __forceinline__ int lds_byte(int r, int c) {
  int st = (r >> 4) * 2 + (c >> 5), rr = r & 15, cc = c & 31, ob = rr * 64 + cc * 2;
  return st * 1024 + (ob ^ (((ob >> 9) & 1) << 5));
}
__device__ __forceinline__ void stage_rc(int b, int& R, int& C) {
  int st = b / 1024, sb = b % 1024, swz = sb ^ (((sb >> 9) & 1) << 5);
  R = (st >> 1) * 16 + swz / 64;
  C = (st & 1) * 32 + (swz % 64) / 2;
}

#define RS_OFF 139264
#define STB_PITCH 272
#define STF_PITCH 260
#define KST_PITCH 136
#define VT_OFF 69632
#define VT_PITCH 264

typedef __attribute__((ext_vector_type(2))) unsigned u32x2;
typedef __attribute__((ext_vector_type(4))) unsigned u32x4;
__device__ __forceinline__ void lds_st2(LAS bf16* q, uint2 v) { u32x2 w; w[0] = v.x; w[1] = v.y; *(LAS u32x2*)q = w; }
__device__ __forceinline__ void lds_st4f(LAS float* q, float4 v) { f32x4 w; w[0] = v.x; w[1] = v.y; w[2] = v.z; w[3] = v.w; *(LAS f32x4*)q = w; }
__device__ __forceinline__ uint4 lds_ld4(LAS bf16* q) { u32x4 w = *(LAS u32x4*)q; return make_uint4(w[0], w[1], w[2], w[3]); }
__device__ __forceinline__ float4 lds_ld4f(LAS float* q) { f32x4 w = *(LAS f32x4*)q; return make_float4(w[0], w[1], w[2], w[3]); }

#define EPI_BAR asm volatile("s_waitcnt lgkmcnt(0)\n\ts_barrier" ::: "memory")
template <int EPI>
__device__ __forceinline__ void epi256(const P& p, f32x4 (&acc)[2][2][4][2], int brow, int bcol, LAS unsigned char* lds) {
  const int tid = otid(), wid = __builtin_amdgcn_readfirstlane(tid >> 6), lane = tid & 63, wr = wid >> 2,
            wc = wid & 3, fr = lane & 15, fq = lane >> 4;
  LAS bf16* stb = (LAS bf16*)lds;
  LAS float* stf = (LAS float*)lds;

  if (EPI == EPI_OUT || EPI == EPI_FF2) {
    const float* src = (EPI == EPI_OUT) ? p.x : p.out;
    const int goff = (EPI == EPI_OUT) ? 2048 : 5120;
    const int c4 = (tid & 63) * 4, col = bcol + c4, bb = brow >> 12, rw = tid >> 6;
    const float4 g4 = *(const float4*)(p.mod + bb * 8192 + goff + col);
    float4 n4 = make_float4(0.f, 0.f, 0.f, 0.f);
    if (EPI == EPI_OUT) {
      const float4 ng = *(const float4*)(p.norm2_g + col);
      const float4 sc2 = *(const float4*)(p.mod + bb * 8192 + 4096 + col);
      n4 = make_float4(ng.x * (1.f + sc2.x), ng.y * (1.f + sc2.y), ng.z * (1.f + sc2.z), ng.w * (1.f + sc2.w));
    }
#pragma unroll
    for (int ai = 0; ai < 2; ++ai) {
      float4 xp[16];
#pragma unroll
      for (int i = 0; i < 16; ++i) xp[i] = ld_nt4(src + (size_t)(brow + ai * 128 + i * 8 + rw) * 1024 + col);
#pragma unroll
      for (int m = 0; m < 4; ++m) {
        const int rl = wr * 64 + m * 16 + fr;
        float sc = 1.f;
        if (EPI == EPI_OUT) sc = rsqrtf(((LAS float*)(lds + RS_OFF))[ai * 128 + rl] * (1.f / 512.f) + EPSN);
#pragma unroll
        for (int bj = 0; bj < 2; ++bj)
#pragma unroll
          for (int n = 0; n < 2; ++n) {
            const int cl = bj * 128 + wc * 32 + n * 16 + fq * 4;
            f32x4 v = acc[ai][bj][m][n];
            lds_st4f(stf + rl * STF_PITCH + cl, make_float4(v[0] * sc, v[1] * sc, v[2] * sc, v[3] * sc));
          }
      }
      EPI_BAR;
#pragma unroll
      for (int i = 0; i < 16; ++i) {
        const int row = i * 8 + rw;
        float4 v = lds_ld4f(stf + row * STF_PITCH + c4);
        const int grow = brow + ai * 128 + row;
        const float4 x4 = xp[i];
        const float y0 = x4.x + g4.x * v.x, y1 = x4.y + g4.y * v.y, y2 = x4.z + g4.z * v.z, y3 = x4.w + g4.w * v.w;
        st_nt4(p.out + (size_t)grow * 1024 + col, make_float4(y0, y1, y2, y3));
        if (EPI == EPI_OUT) {
          *(uint2*)(p.hbuf + (size_t)grow * 1024 + col) = make_uint2(pack2(y0 * n4.x, y1 * n4.y), pack2(y2 * n4.z, y3 * n4.w));
          float ss = y0 * y0 + y1 * y1 + y2 * y2 + y3 * y3;
#pragma unroll
          for (int o = 32; o >= 1; o >>= 1) ss += __shfl_xor(ss, o);
          if ((tid & 63) == 0) atomicAdd(p.rss_x + grow, ss);
        }
      }
      EPI_BAR;
    }
    return;
  }

#pragma unroll
  for (int ai = 0; ai < 2; ++ai)
#pragma unroll
    for (int m = 0; m < 4; ++m) {
      const int rl = ai * 128 + wr * 64 + m * 16 + fr;
      const int row = brow + rl;
      float rsv = 1.f;
      LAS float* rsl = (LAS float*)(lds + RS_OFF);
      if (EPI == EPI_FF1) rsv = rsqrtf(rsl[rl] * (1.f / 1024.f) + EPSN);
      if (EPI == EPI_Q) rsv = rsqrtf(rsl[rl] * (1.f / 384.f) + EPSN) * QSCALE;
      if (EPI == EPI_KV) rsv = rsqrtf(rsl[rl] * (1.f / 256.f) + EPSN);
#pragma unroll
      for (int bj = 0; bj < 2; ++bj)
#pragma unroll
        for (int n = 0; n < 2; ++n) {
          const int cl = bj * 128 + wc * 32 + n * 16 + fq * 4;
          const int cb = bcol + bj * 128 + wc * 32 + n * 16;
          const f32x4 v = acc[ai][bj][m][n];
          const f32x4 vn = acc[ai][bj][m][1];
          if (EPI == EPI_FF1) {
            const float4 bi = lds_ld4f((LAS float*)(lds + RS_OFF + 1024) + cl);
            float a0 = fmaxf(v[0] * rsv + bi.x, 0.f), a1 = fmaxf(v[1] * rsv + bi.y, 0.f);
            float a2 = fmaxf(v[2] * rsv + bi.z, 0.f), a3 = fmaxf(v[3] * rsv + bi.w, 0.f);
            lds_st2(stb + rl * STB_PITCH + cl, make_uint2(pack2(a0 * a0, a1 * a1), pack2(a2 * a2, a3 * a3)));
          } else if (EPI == EPI_GLU) {
            if (n == 0) {
              const int oc = bj * 64 + wc * 16 + fq * 4;
              lds_st2(stb + rl * STB_PITCH + oc, make_uint2(pack2(v[0] * sigmoidf(vn[0]), v[1] * sigmoidf(vn[1])),
                             pack2(v[2] * sigmoidf(vn[2]), v[3] * sigmoidf(vn[3]))));
            }
          } else if (EPI == EPI_KV) {
            if (wc < 2) {
              lds_st2(stb + rl * KST_PITCH + bj * 64 + wc * 32 + n * 16 + fq * 4, make_uint2(pack2(v[0] * rsv, v[1] * rsv), pack2(v[2] * rsv, v[3] * rsv)));
            } else {
              LAS bf16* vt = (LAS bf16*)(lds + VT_OFF) + (bj * 64 + (wc - 2) * 32 + n * 16 + fq * 4) * VT_PITCH + rl;
              vt[0] = f2bf(v[0] * rsv); vt[VT_PITCH] = f2bf(v[1] * rsv);
              vt[2 * VT_PITCH] = f2bf(v[2] * rsv); vt[3 * VT_PITCH] = f2bf(v[3] * rsv);
            }
          } else if (EPI == EPI_Q) {
            const int hq = cb / 96, d0 = cb - hq * 96;
            if (d0 < 64) {
              lds_st2(stb + rl * STB_PITCH + cl, make_uint2(pack2(v[0] * rsv, v[1] * rsv), pack2(v[2] * rsv, v[3] * rsv)));
            } else if (d0 == 64) {
              if (n == 0) {
                const float4 c01 = *(const float4*)(p.cs + (size_t)row * 16 + fq * 4);
                const float4 c23 = *(const float4*)(p.cs + (size_t)row * 16 + fq * 4 + 2);
                float x10 = v[0] * rsv, x11 = v[1] * rsv, x12 = v[2] * rsv, x13 = v[3] * rsv;
                float x20 = vn[0] * rsv, x21 = vn[1] * rsv, x22 = vn[2] * rsv, x23 = vn[3] * rsv;
                lds_st2(stb + rl * STB_PITCH + cl, make_uint2(pack2(x10 * c01.x - x20 * c01.y, x11 * c01.z - x21 * c01.w),
                               pack2(x12 * c23.x - x22 * c23.y, x13 * c23.z - x23 * c23.w)));
                lds_st2(stb + rl * STB_PITCH + cl + 16, make_uint2(pack2(x10 * c01.y + x20 * c01.x, x11 * c01.w + x21 * c01.z),
                               pack2(x12 * c23.y + x22 * c23.x, x13 * c23.w + x23 * c23.z)));
              }
            }
          } else if (EPI == EPI_INPROJ) {
            if (cb < 1152) {
              lds_st2(stb + rl * STB_PITCH + cl, make_uint2(pack2(v[0], v[1]), pack2(v[2], v[3])));
            } else if (cb == 1152) {
              if (n == 0) {
                const float4 c01 = *(const float4*)(p.cs + (size_t)row * 16 + fq * 4);
                const float4 c23 = *(const float4*)(p.cs + (size_t)row * 16 + fq * 4 + 2);
                lds_st2(stb + rl * STB_PITCH + cl,
                        make_uint2(pack2(v[0] * c01.x - vn[0] * c01.y, v[1] * c01.z - vn[1] * c01.w),
                                   pack2(v[2] * c23.x - vn[2] * c23.y, v[3] * c23.z - vn[3] * c23.w)));
                lds_st2(stb + rl * STB_PITCH + cl + 16,
                        make_uint2(pack2(v[0] * c01.y + vn[0] * c01.x, v[1] * c01.w + vn[1] * c01.z),
                                   pack2(v[2] * c23.y + vn[2] * c23.x, v[3] * c23.w + vn[3] * c23.z)));
              }
            }
          }
        }
    }
  EPI_BAR;

  if (EPI == EPI_FF1) {
#pragma unroll
    for (int i = 0; i < 16; ++i) {
      const int chunk = i * 512 + tid, row = chunk >> 5, c8 = (chunk & 31) * 8;
      uint4 v = lds_ld4(stb + row * STB_PITCH + c8);
      u32x4 vv; vv[0] = v.x; vv[1] = v.y; vv[2] = v.z; vv[3] = v.w;
      __builtin_nontemporal_store(vv, (u32x4*)(p.hid + (size_t)(brow + row) * 4096 + bcol + c8));
    }
  } else if (EPI == EPI_GLU) {
#pragma unroll
    for (int i = 0; i < 8; ++i) {
      const int chunk = i * 512 + tid, row = chunk >> 4, c8 = (chunk & 15) * 8;
      uint4 v = lds_ld4(stb + row * STB_PITCH + c8);
      *(uint4*)(p.ycat + (size_t)(brow + row) * 1024 + (bcol >> 1) + c8) = v;
      float ss = sq2(v.x) + sq2(v.y) + sq2(v.z) + sq2(v.w);
#pragma unroll
      for (int o = 8; o >= 1; o >>= 1) ss += __shfl_xor(ss, o);
      if ((tid & 15) == 0) atomicAdd(p.rss_s + brow + row, ss);
    }
  } else if (EPI == EPI_KV) {
    const int b = brow >> 12, s0 = brow & 4095, h0 = bcol >> 7;
#pragma unroll
    for (int i = 0; i < 8; ++i) {
      const int chunk = i * 512 + tid, row = chunk >> 4, c8 = (chunk & 15) * 8;
      uint4 v = lds_ld4(stb + row * KST_PITCH + c8);
      *(uint4*)(p.Kc + ((size_t)((b * 8 + h0 + (c8 >> 6)) * 4096 + s0 + row)) * 96 + (c8 & 63)) = v;
    }
#pragma unroll
    for (int i = 0; i < 8; ++i) {
      const int chunk = i * 512 + tid, vrow = chunk >> 5, s8 = (chunk & 31) * 8;
      uint4 v = lds_ld4((LAS bf16*)(lds + VT_OFF) + vrow * VT_PITCH + s8);
      *(uint4*)(p.Vt + ((size_t)((b * 8 + h0 + (vrow >> 6)) * 64 + (vrow & 63))) * 4096 + s0 + s8) = v;
    }
  } else if (EPI == EPI_Q) {
    const int b = brow >> 12, s0 = brow & 4095;
#pragma unroll
    for (int i = 0; i < 16; ++i) {
      const int chunk = i * 512 + tid, row = chunk >> 5, c8 = (chunk & 31) * 8;
      uint4 v = lds_ld4(stb + row * STB_PITCH + c8);
      const int cg = bcol + c8, hq = cg / 96, d = cg - hq * 96;
      *(uint4*)(p.Q + ((size_t)((b * 8 + hq) * 4096 + s0 + row)) * 96 + d) = v;
    }
  } else if (EPI == EPI_INPROJ) {
    if (bcol < 512) {
      const int b = brow >> 12, c0 = (brow & 4095) >> 6, g0 = bcol >> 4;
#pragma unroll
      for (int i = 0; i < 16; ++i) {
        const int q = i * 512 + tid, hh = q & 1, j = (q >> 1) & 63, cl = (q >> 7) & 3, gl = q >> 9;
        uint4 v = lds_ld4(stb + (cl * 64 + j) * STB_PITCH + gl * 16 + hh * 8);
        *(uint4*)(p.Ag + ((size_t)((g0 + gl) * 1024 + b * 64 + c0 + cl)) * 1152 + j * 16 + hh * 8) = v;
      }
    } else {
#pragma unroll
      for (int i = 0; i < 16; ++i) {
        const int chunk = i * 512 + tid, row = chunk >> 5, c8 = (chunk & 31) * 8;
        const int cg = bcol + c8;
        float ss = 0.f;
        if (cg >= 1152 && cg < 1184) {
          uint4 v = lds_ld4(stb + row * STB_PITCH + c8);
          const int grow = brow + row, bq = grow >> 12, sq = grow & 4095;
#pragma unroll
          for (int h = 0; h < 8; ++h)
            *(uint4*)(p.Kc + ((size_t)((bq * 8 + h) * 4096 + sq)) * 96 + 64 + (cg - 1152)) = v;
        }
        if (cg < 1152) {
          uint4 v = lds_ld4(stb + row * STB_PITCH + c8);
          if (cg < 896) *(uint4*)(p.qlat + (size_t)(brow + row) * 384 + (cg - 512)) = v;
          else *(uint4*)(p.kvlat + (size_t)(brow + row) * 256 + (cg - 896)) = v;
          ss = sq2(v.x) + sq2(v.y) + sq2(v.z) + sq2(v.w);
        }
#pragma unroll
        for (int o = 8; o >= 1; o >>= 1) ss += __shfl_xor(ss, o);
        if ((tid & 15) == 0 && cg < 1152) atomicAdd((cg < 896 ? p.rss_q : p.rss_kv) + brow + row, ss);
      }
    }
  }
  EPI_BAR;
}

template <int EPI, int PRE>
__device__ __forceinline__ void gemm256(const P& p, const bf16* __restrict__ A, int lda, const bf16* __restrict__ Bt,
                                        int ldb, int K, int brow, int bcol, LAS unsigned char* lds) {
  const int tid = otid(), wid = __builtin_amdgcn_readfirstlane(tid >> 6), lane = tid & 63, wr = wid >> 2,
            wc = wid & 3, fr = lane & 15, fq = lane >> 4;
  const int nt = K / 64;
  if (EPI == EPI_Q || EPI == EPI_KV || EPI == EPI_FF1 || EPI == EPI_OUT) {
    const float* r0 = (EPI == EPI_Q) ? p.rss_q : (EPI == EPI_KV) ? p.rss_kv : (EPI == EPI_FF1) ? p.rss_x : p.rss_a;
    if (wid < 4) {
      __builtin_amdgcn_global_load_lds((const unsigned*)(r0 + brow + wid * 64 + lane), (LAS unsigned*)(lds + RS_OFF + wid * 256), 4, 0, 0);
    } else if (EPI == EPI_OUT) {
      __builtin_amdgcn_global_load_lds((const unsigned*)(p.rss_s + brow + (wid - 4) * 64 + lane), (LAS unsigned*)(lds + RS_OFF + 1024 + (wid - 4) * 256), 4, 0, 0);
    } else if (EPI == EPI_FF1) {
      __builtin_amdgcn_global_load_lds((const unsigned*)(p.biasff + (brow >> 12) * 4096 + bcol + (wid - 4) * 64 + lane), (LAS unsigned*)(lds + RS_OFF + 1024 + (wid - 4) * 256), 4, 0, 0);
    }
  }
  int R0, C0, R1, C1;
  stage_rc(tid * 16, R0, C0);
  stage_rc(tid * 16 + 8192, R1, C1);
  const unsigned voA0 = (unsigned)(R0 * lda + C0) * 2u, voA1 = (unsigned)(R1 * lda + C1) * 2u;
  const unsigned voB0 = (unsigned)(R0 * ldb + C0) * 2u, voB1 = (unsigned)(R1 * ldb + C1) * 2u;
  const char* Abase = (const char*)(A + (size_t)brow * lda);
  const char* Bbase = (const char*)(Bt + (size_t)bcol * ldb);
  const size_t ahalf = (size_t)128 * lda * 2, bhalf = (size_t)128 * ldb * 2;
  const unsigned ldsw = (unsigned)wid * 1024u;
  const int aoff = lds_byte(wr * 64 + fr, fq * 8), boff = lds_byte(wc * 32 + fr, fq * 8);
#define G_SA(b, h) (((b) * 2 + (h)) * 16384)
#define G_SB(b, h) ((4 + (b) * 2 + (h)) * 16384)
#define G_STA(b, h, kt) do { const char* gb_ = Abase + (h) * ahalf + (size_t)(kt) * 128; \
    __builtin_amdgcn_global_load_lds((const unsigned*)(gb_ + voA0), (LAS unsigned*)(lds + G_SA(b, h) + ldsw), 16, 0, 0); \
    __builtin_amdgcn_global_load_lds((const unsigned*)(gb_ + voA1), (LAS unsigned*)(lds + G_SA(b, h) + ldsw + 8192), 16, 0, 0); } while (0)
#define G_STB(b, h, kt) do { const char* gb_ = Bbase + (h) * bhalf + (size_t)(kt) * 128; \
    __builtin_amdgcn_global_load_lds((const unsigned*)(gb_ + voB0), (LAS unsigned*)(lds + G_SB(b, h) + ldsw), 16, 0, 0); \
    __builtin_amdgcn_global_load_lds((const unsigned*)(gb_ + voB1), (LAS unsigned*)(lds + G_SB(b, h) + ldsw + 8192), 16, 0, 0); } while (0)
#define G_LDA(dst, b, h) do { _Pragma("unroll") for (int m = 0; m < 4; ++m) _Pragma("unroll") for (int k = 0; k < 2; ++k) \
    dst[m][k] = *(const LAS bf16x8*)(lds + G_SA(b, h) + aoff + m * 2048 + k * 1024); } while (0)
#define G_LDB(dst, b, h) do { _Pragma("unroll") for (int n = 0; n < 2; ++n) _Pragma("unroll") for (int k = 0; k < 2; ++k) \
    dst[n][k] = *(const LAS bf16x8*)(lds + G_SB(b, h) + boff + n * 2048 + k * 1024); } while (0)
#define G_MMA(ai, bj, At_, Bt_) do { __builtin_amdgcn_s_setprio(1); \
    _Pragma("unroll") for (int m = 0; m < 4; ++m) _Pragma("unroll") for (int n = 0; n < 2; ++n) _Pragma("unroll") for (int k = 0; k < 2; ++k) \
      acc[ai][bj][m][n] = __builtin_amdgcn_mfma_f32_16x16x32_bf16(Bt_[n][k], At_[m][k], acc[ai][bj][m][n], 0, 0, 0); \
    __builtin_amdgcn_s_setprio(0); } while (0)
#define G_WV(n) asm volatile("s_waitcnt vmcnt(" #n ")" ::: "memory")
#define G_WL(n) asm volatile("s_waitcnt lgkmcnt(" #n ")" ::: "memory")
#define G_BAR __builtin_amdgcn_s_barrier()
#define G_SCHED __builtin_amdgcn_sched_barrier(0)

  f32x4 acc[2][2][4][2];
#pragma unroll
  for (int a = 0; a < 2; ++a)
#pragma unroll
    for (int b = 0; b < 2; ++b)
#pragma unroll
      for (int m = 0; m < 4; ++m)
#pragma unroll
        for (int n = 0; n < 2; ++n) acc[a][b][m][n] = (f32x4){0.f, 0.f, 0.f, 0.f};
  bf16x8 At[4][2], B0[2][2], B1[2][2];

  G_STB(0, 0, 0); G_STA(0, 0, 0); G_STB(0, 1, 0); G_STA(0, 1, 0);
  if (wr == 1) G_BAR;
  G_WV(4); G_BAR;
  G_STB(1, 0, 1); G_STA(1, 0, 1); G_STB(1, 1, 1);
  G_WV(6); G_BAR;
  const int tmid = (PRE == 2) ? 8 : (nt - 2);
  for (int t = 0; t < tmid; t += 2) {
    G_LDB(B0, 0, 0); G_SCHED; G_LDA(At, 0, 0); G_STA(1, 1, t + 1);
    G_WL(8); G_BAR; G_WL(0); G_MMA(0, 0, At, B0); G_BAR; G_SCHED;
    G_LDB(B1, 0, 1); G_STB(0, 0, t + 2);
    G_BAR; G_WL(0); G_MMA(0, 1, At, B1); G_BAR;
    G_LDA(At, 0, 1); G_STA(0, 0, t + 2);
    G_BAR; G_WL(0); G_MMA(1, 0, At, B0); G_BAR; G_SCHED;
    G_STB(0, 1, t + 2);
    G_WV(6); G_BAR; G_MMA(1, 1, At, B1); G_BAR;
    G_LDB(B0, 1, 0); G_SCHED; G_LDA(At, 1, 0); G_STA(0, 1, t + 2);
    G_WL(8); G_BAR; G_WL(0); G_MMA(0, 0, At, B0); G_BAR; G_SCHED;
    G_LDB(B1, 1, 1); G_STB(1, 0, t + 3);
    G_BAR; G_WL(0); G_MMA(0, 1, At, B1); G_BAR;
    G_LDA(At, 1, 1); G_STA(1, 0, t + 3);
    G_BAR; G_WL(0); G_MMA(1, 0, At, B0); G_BAR; G_SCHED;
    G_STB(1, 1, t + 3);
    G_WV(6); G_BAR; G_MMA(1, 1, At, B1); G_BAR;
    }
  if (PRE == 2) {
    const int tid2 = otid(), wr2 = __builtin_amdgcn_readfirstlane(tid2 >> 8), fr2 = tid2 & 15;
#pragma unroll
    for (int a = 0; a < 2; ++a)
#pragma unroll
      for (int m = 0; m < 4; ++m) {
        const int rl = a * 128 + wr2 * 64 + m * 16 + fr2;
        LAS float* rsl = (LAS float*)(lds + RS_OFF);
        const float f = rsqrtf(rsl[256 + rl] * (1.f / 512.f) + EPSN) / rsqrtf(rsl[rl] * (1.f / 512.f) + EPSN);
#pragma unroll
        for (int b = 0; b < 2; ++b)
#pragma unroll
          for (int n = 0; n < 2; ++n) acc[a][b][m][n] *= f;
      }
  }
  if (PRE == 2) {
  for (int t = 8; t < nt - 2; t += 2) {
    G_LDB(B0, 0, 0); G_SCHED; G_LDA(At, 0, 0); G_STA(1, 1, t + 1);
    G_WL(8); G_BAR; G_WL(0); G_MMA(0, 0, At, B0); G_BAR; G_SCHED;
    G_LDB(B1, 0, 1); G_STB(0, 0, t + 2);
    G_BAR; G_WL(0); G_MMA(0, 1, At, B1); G_BAR;
    G_LDA(At, 0, 1); G_STA(0, 0, t + 2);
    G_BAR; G_WL(0); G_MMA(1, 0, At, B0); G_BAR; G_SCHED;
    G_STB(0, 1, t + 2);
    G_WV(6); G_BAR; G_MMA(1, 1, At, B1); G_BAR;
    G_LDB(B0, 1, 0); G_SCHED; G_LDA(At, 1, 0); G_STA(0, 1, t + 2);
    G_WL(8); G_BAR; G_WL(0); G_MMA(0, 0, At, B0); G_BAR; G_SCHED;
    G_LDB(B1, 1, 1); G_STB(1, 0, t + 3);
    G_BAR; G_WL(0); G_MMA(0, 1, At, B1); G_BAR;
    G_LDA(At, 1, 1); G_STA(1, 0, t + 3);
    G_BAR; G_WL(0); G_MMA(1, 0, At, B0); G_BAR; G_SCHED;
    G_STB(1, 1, t + 3);
    G_WV(6); G_BAR; G_MMA(1, 1, At, B1); G_BAR;
    }
  }
  {
    G_LDB(B0, 0, 0); G_LDA(At, 0, 0); G_STA(1, 1, nt - 1);
    G_BAR; G_WL(0); G_MMA(0, 0, At, B0); G_BAR;
    G_LDB(B1, 0, 1); G_BAR; G_WL(0); G_MMA(0, 1, At, B1); G_BAR;
    G_LDA(At, 0, 1); G_WV(4); G_BAR; G_WL(0); G_MMA(1, 0, At, B0); G_MMA(1, 1, At, B1); G_BAR;
  }
  {
    G_LDB(B0, 1, 0); G_LDA(At, 1, 0); G_WV(2); G_BAR; G_WL(0); G_MMA(0, 0, At, B0); G_BAR;
    G_LDB(B1, 1, 1); G_WV(0); G_BAR; G_WL(0); G_MMA(0, 1, At, B1); G_BAR;
    G_LDA(At, 1, 1); G_BAR; G_WL(0); G_MMA(1, 0, At, B0); G_MMA(1, 1, At, B1); G_BAR;
  }
  if (wr == 0) G_BAR;

  epi256<EPI>(p, acc, brow, bcol, lds);
}

template <int EPI, int PRE>
__device__ __forceinline__ void gemm256_phase(const P& p, const bf16* A, int lda, const bf16* Bt, int ldb, int K,
                                              int NN, int bid, int nb, LAS unsigned char* lds) {
  if (nb == 256) {
    const int x = bid & 7, j = bid >> 3;
    for (int k = 0; k < NN; ++k) {
      int L = j + 32 * k;
      int mt = x * 32 + L / NN, nt = L % NN;
      if (NN == 16) { mt = x * 32 + (k >> 2) * 8 + (j & 7); nt = (k & 3) * 4 + (j >> 3); }
      gemm256<EPI, PRE>(p, A, lda, Bt, ldb, K, mt * 256, nt * 256, lds);
    }
  } else {
    for (int it = bid; it < 256 * NN; it += nb) gemm256<EPI, PRE>(p, A, lda, Bt, ldb, K, (it / NN) * 256, (it % NN) * 256, lds);
  }
}

#define KSTR 104
#define VSTR 68
#define ATT_BUF (64 * KSTR + 64 * VSTR)

__device__ __forceinline__ void att_qk(const bf16* Kb, const bf16x8 (&qf)[6], int qi, int half, f32x16& s0, f32x16& s1) {
#pragma unroll
  for (int r = 0; r < 16; ++r) { s0[r] = 0.f; s1[r] = 0.f; }
#pragma unroll
  for (int ks = 0; ks < 6; ++ks) {
    bf16x8 a0 = *(const bf16x8*)(Kb + qi * KSTR + ks * 16 + half * 8);
    bf16x8 a1 = *(const bf16x8*)(Kb + (32 + qi) * KSTR + ks * 16 + half * 8);
    s0 = __builtin_amdgcn_mfma_f32_32x32x16_bf16(a0, qf[ks], s0, 0, 0, 0);
    s1 = __builtin_amdgcn_mfma_f32_32x32x16_bf16(a1, qf[ks], s1, 0, 0, 0);
  }
}

__device__ __forceinline__ void att_softmax_pv(const bf16* Vb, f32x16& s0, f32x16& s1, f32x16& o0, f32x16& o1,
                                               float& mrun, float& lsum, int qi, int half, bool domask, int kbase,
                                               int qpos) {
  if (domask) {
#pragma unroll
    for (int r = 0; r < 16; ++r) {
      int key = kbase + (r >> 2) * 8 + half * 4 + (r & 3);
      if (key > qpos) s0[r] = -INFINITY;
      if (key + 32 > qpos) s1[r] = -INFINITY;
    }
  }
  float mt_ = s0[0];
#pragma unroll
  for (int r = 1; r < 16; ++r) mt_ = fmaxf(mt_, s0[r]);
#pragma unroll
  for (int r = 0; r < 16; ++r) mt_ = fmaxf(mt_, s1[r]);
  mt_ = fmaxf(mt_, __shfl_xor(mt_, 32));
  const float mnew = fmaxf(mrun, mt_);
  const float alpha = __builtin_amdgcn_exp2f(mrun - mnew);
  mrun = mnew;
  float ps = 0.f;
#pragma unroll
  for (int r = 0; r < 16; ++r) { s0[r] = __builtin_amdgcn_exp2f(s0[r] - mnew); ps += s0[r]; }
#pragma unroll
  for (int r = 0; r < 16; ++r) { s1[r] = __builtin_amdgcn_exp2f(s1[r] - mnew); ps += s1[r]; }
  lsum = lsum * alpha + ps;
#pragma unroll
  for (int r = 0; r < 16; ++r) { o0[r] *= alpha; o1[r] *= alpha; }
#pragma unroll
  for (int kk = 0; kk < 4; ++kk) {
    unsigned pk[4];
#pragma unroll
    for (int j = 0; j < 4; ++j) {
      float a = (kk < 2) ? s0[(kk & 1) * 8 + 2 * j] : s1[(kk & 1) * 8 + 2 * j];
      float b = (kk < 2) ? s0[(kk & 1) * 8 + 2 * j + 1] : s1[(kk & 1) * 8 + 2 * j + 1];
      pk[j] = pack2(a, b);
    }
    bf16x8 pb = __builtin_bit_cast(bf16x8, make_uint4(pk[0], pk[1], pk[2], pk[3]));
    const bf16* v0p = Vb + qi * VSTR + kk * 16 + half * 4;
    const bf16* v1p = Vb + (32 + qi) * VSTR + kk * 16 + half * 4;
    uint2 a0l = *(const uint2*)(v0p), a0h = *(const uint2*)(v0p + 8);
    uint2 a1l = *(const uint2*)(v1p), a1h = *(const uint2*)(v1p + 8);
    bf16x8 av0 = __builtin_bit_cast(bf16x8, make_uint4(a0l.x, a0l.y, a0h.x, a0h.y));
    bf16x8 av1 = __builtin_bit_cast(bf16x8, make_uint4(a1l.x, a1l.y, a1h.x, a1h.y));
    o0 = __builtin_amdgcn_mfma_f32_32x32x16_bf16(av0, pb, o0, 0, 0, 0);
    o1 = __builtin_amdgcn_mfma_f32_32x32x16_bf16(av1, pb, o1, 0, 0, 0);
  }
}

__device__ __forceinline__ void attn_item(const P& p, int bh, int qt, char* smem) {
  bf16* Ks = (bf16*)smem;
  const int t = otid() & 255, w = __builtin_amdgcn_readfirstlane(t >> 6), l = t & 63, qi = l & 31, half = l >> 5;
  const int q0 = qt * 128, wq0 = q0 + w * 32;
  const bf16* Qp = p.Q + ((size_t)bh * 4096 + wq0 + qi) * 96;
  bf16x8 qf[6];
#pragma unroll
  for (int ks = 0; ks < 6; ++ks) qf[ks] = *(const bf16x8*)(Qp + ks * 16 + half * 8);
  asm volatile("s_waitcnt vmcnt(0)" ::: "memory");
#pragma unroll
  for (int ks = 0; ks < 6; ++ks) asm volatile("" : "+v"(qf[ks]));
  const bf16* Kg = p.Kc + (size_t)bh * 4096 * 96;
  const bf16* Vg = p.Vt + (size_t)bh * 64 * 4096;
  const int nkt = 2 * qt + 2, nfull = 2 * qt;

  const int kr0r = t / 12, kr0c = t - kr0r * 12;
  const int kr1r = (t + 256) / 12, kr1c = (t + 256) - kr1r * 12;
  const int kr2r = (t + 512) / 12, kr2c = (t + 512) - kr2r * 12;
  const int vrow = t >> 3, vkc = t & 7;
  const bf16* kg0 = Kg + (size_t)kr0r * 96 + kr0c * 8;
  const bf16* kg1 = Kg + (size_t)kr1r * 96 + kr1c * 8;
  const bf16* kg2 = Kg + (size_t)kr2r * 96 + kr2c * 8;
  const bf16* vg0 = Vg + (size_t)vrow * 4096 + vkc * 8;
  const bf16* vg1 = Vg + (size_t)(vrow + 32) * 4096 + vkc * 8;
  const int ks0 = kr0r * KSTR + kr0c * 8, ks1 = kr1r * KSTR + kr1c * 8, ks2 = kr2r * KSTR + kr2c * 8;
  const int vs0 = 64 * KSTR + vrow * VSTR + vkc * 8, vs1 = 64 * KSTR + (vrow + 32) * VSTR + vkc * 8;
  uint4 kra, krb, krc, vra, vrb;
#define ATT_GLOAD(kt_) do { kra = *(const uint4*)(kg0 + (size_t)(kt_) * 64 * 96); krb = *(const uint4*)(kg1 + (size_t)(kt_) * 64 * 96); \
    krc = *(const uint4*)(kg2 + (size_t)(kt_) * 64 * 96); vra = *(const uint4*)(vg0 + (kt_) * 64); vrb = *(const uint4*)(vg1 + (kt_) * 64); } while (0)
#define ATT_LSTORE(buf_) do { bf16* kb_ = Ks + (buf_) * ATT_BUF; \
    *(uint4*)(kb_ + ks0) = kra; *(uint4*)(kb_ + ks1) = krb; *(uint4*)(kb_ + ks2) = krc; \
    ((uint2*)(kb_ + vs0))[0] = make_uint2(vra.x, vra.y); ((uint2*)(kb_ + vs0))[1] = make_uint2(vra.z, vra.w); \
    ((uint2*)(kb_ + vs1))[0] = make_uint2(vrb.x, vrb.y); ((uint2*)(kb_ + vs1))[1] = make_uint2(vrb.z, vrb.w); } while (0)
  ATT_GLOAD(0);
  ATT_LSTORE(0);
  ATT_GLOAD(1);
  ATT_LSTORE(1);
  __syncthreads();

  f32x16 o0, o1, sc0, sc1, sn0, sn1;
#pragma unroll
  for (int r = 0; r < 16; ++r) { o0[r] = 0.f; o1[r] = 0.f; sn0[r] = 0.f; sn1[r] = 0.f; }
  float mrun = -INFINITY, lsum = 0.f;
  const int qpos = wq0 + qi;
  att_qk(Ks, qf, qi, half, sc0, sc1);
  int bc = 0, bn = 1, bnn = 2;
  int kt = 0;
  for (; kt < nfull - 1; ++kt) {
    ATT_GLOAD(kt + 2);
    att_qk(Ks + bn * ATT_BUF, qf, qi, half, sn0, sn1);
    att_softmax_pv(Ks + bc * ATT_BUF + 64 * KSTR, sc0, sc1, o0, o1, mrun, lsum, qi, half, false, 0, qpos);
    ATT_LSTORE(bnn);
    __syncthreads();
    sc0 = sn0; sc1 = sn1;
    { int tb = bc; bc = bn; bn = bnn; bnn = tb; }
  }
  for (; kt < nkt; ++kt) {
    const bool more2 = (kt + 2 < nkt);
    if (more2) ATT_GLOAD(kt + 2);
    const bool need_next = (kt + 1 < nkt) && ((kt + 1) * 64 <= wq0 + 31);
    if (need_next) att_qk(Ks + bn * ATT_BUF, qf, qi, half, sn0, sn1);
    if (kt * 64 <= wq0 + 31)
      att_softmax_pv(Ks + bc * ATT_BUF + 64 * KSTR, sc0, sc1, o0, o1, mrun, lsum, qi, half, (kt * 64 + 63 > wq0), kt * 64, qpos);
    if (more2) ATT_LSTORE(bnn);
    __syncthreads();
    sc0 = sn0; sc1 = sn1;
    { int tb = bc; bc = bn; bn = bnn; bnn = tb; }
  }
  const float ltot = lsum + __shfl_xor(lsum, 32);
  const float inv = 1.f / ltot;
  const int b = bh >> 3, h = bh & 7;
  bf16* op = p.ycat + ((size_t)(b * 4096 + wq0 + qi)) * 1024 + 512 + h * 64 + half * 4;
  {
    float ss = 0.f;
#pragma unroll
    for (int r = 0; r < 16; ++r) { float a0 = o0[r] * inv, a1 = o1[r] * inv; ss += a0 * a0 + a1 * a1; }
    ss += __shfl_xor(ss, 32);
    if (half == 0) atomicAdd(p.rss_a + b * 4096 + wq0 + qi, ss);
  }
#pragma unroll
  for (int rg = 0; rg < 4; ++rg) {
    uint2 v0, v1;
    v0.x = pack2(o0[rg * 4 + 0] * inv, o0[rg * 4 + 1] * inv);
    v0.y = pack2(o0[rg * 4 + 2] * inv, o0[rg * 4 + 3] * inv);
    v1.x = pack2(o1[rg * 4 + 0] * inv, o1[rg * 4 + 1] * inv);
    v1.y = pack2(o1[rg * 4 + 2] * inv, o1[rg * 4 + 3] * inv);
    *(uint2*)(op + rg * 8) = v0;
    *(uint2*)(op + 32 + rg * 8) = v1;
  }
}

#define A2_STAGE 20480
#define A2_VOFF 12288
#define A2_NST 6

__device__ __forceinline__ void a2_qk(LAS unsigned char* st, const bf16x8 (&qf)[6], int qi, int half, f32x16& s0, f32x16& s1,
                                      float init = 0.f) {
#pragma unroll
  for (int r = 0; r < 16; ++r) { s0[r] = init; s1[r] = init; }
  bf16x8 a0[6], a1[6];
#pragma unroll
  for (int ks = 0; ks < 6; ++ks) {
    a0[ks] = *(const LAS bf16x8*)(st + ks * 2048 + qi * 32 + half * 16);
    a1[ks] = *(const LAS bf16x8*)(st + ks * 2048 + (32 + qi) * 32 + half * 16);
  }
  __builtin_amdgcn_sched_barrier(0);
  __builtin_amdgcn_s_setprio(1);
#pragma unroll
  for (int ks = 0; ks < 6; ++ks) {
    s0 = __builtin_amdgcn_mfma_f32_32x32x16_bf16(a0[ks], qf[ks], s0, 0, 0, 0);
    s1 = __builtin_amdgcn_mfma_f32_32x32x16_bf16(a1[ks], qf[ks], s1, 0, 0, 0);
  }
  __builtin_amdgcn_s_setprio(0);
}

__device__ __forceinline__ float xhalf_max(float x) {
  typedef __attribute__((ext_vector_type(2))) unsigned u2_t;
  const unsigned xi = __float_as_uint(x);
  u2_t r = __builtin_amdgcn_permlane32_swap(xi, xi, false, false);
  return fmaxf(__uint_as_float(r[0]), __uint_as_float(r[1]));
}
__device__ __forceinline__ void a2_mask(f32x16& s0, f32x16& s1, int half, int kbase, int qpos) {
#pragma unroll
  for (int r = 0; r < 16; ++r) {
    int key = kbase + (r >> 2) * 8 + half * 4 + (r & 3);
    if (key > qpos) s0[r] = -INFINITY;
    if (key + 32 > qpos) s1[r] = -INFINITY;
  }
}
__device__ __forceinline__ float a2_lanemax(const f32x16& s0, const f32x16& s1) {
  float m = s0[0];
#pragma unroll
  for (int r = 1; r < 16; ++r) m = fmaxf(m, s0[r]);
#pragma unroll
  for (int r = 0; r < 16; ++r) m = fmaxf(m, s1[r]);
  return m;
}
__device__ __forceinline__ void a2_update(float mt_, float& mrun, float& lsum, f32x16& o0, f32x16& o1) {
  mt_ = xhalf_max(mt_);
  if (__builtin_amdgcn_ballot_w64(mt_ > mrun + 8.f) != 0) {
    const float mnew = fmaxf(mrun, mt_);
    const float alpha = __builtin_amdgcn_exp2f(mrun - mnew);
    mrun = mnew;
    lsum *= alpha;
#pragma unroll
    for (int r = 0; r < 16; ++r) { o0[r] *= alpha; o1[r] *= alpha; }
  }
}
__device__ __forceinline__ bool a2_update_off(float mt_, bool first, float& moff, float& lsum, f32x16& o0, f32x16& o1,
                                              float& delta) {
  mt_ = xhalf_max(mt_);
  delta = 0.f;
  if (first || __builtin_amdgcn_ballot_w64(mt_ > 8.f) != 0) {
    delta = first ? mt_ : fmaxf(mt_, 0.f);
    if (!first) {
      const float alpha = __builtin_amdgcn_exp2f(-delta);
      lsum *= alpha;
#pragma unroll
      for (int r = 0; r < 16; ++r) { o0[r] *= alpha; o1[r] *= alpha; }
    }
    moff += delta;
    return true;
  }
  return false;
}
__device__ __forceinline__ float a2_exp0(f32x16& s0, f32x16& s1) {
  typedef __attribute__((ext_vector_type(2))) float f32x2_t;
  f32x2_t ps2 = {0.f, 0.f};
#pragma unroll
  for (int r = 0; r < 16; ++r) s0[r] = __builtin_amdgcn_exp2f(s0[r]);
#pragma unroll
  for (int r = 0; r < 16; ++r) s1[r] = __builtin_amdgcn_exp2f(s1[r]);
#pragma unroll
  for (int r = 0; r < 8; ++r) {
    ps2 += (f32x2_t){s0[2 * r], s0[2 * r + 1]};
    ps2 += (f32x2_t){s1[2 * r], s1[2 * r + 1]};
  }
  return ps2[0] + ps2[1];
}
__device__ __forceinline__ float a2_exp(f32x16& s0, f32x16& s1, float mrun) {
  float ps = 0.f;
#pragma unroll
  for (int r = 0; r < 16; ++r) { s0[r] = __builtin_amdgcn_exp2f(s0[r] - mrun); ps += s0[r]; }
#pragma unroll
  for (int r = 0; r < 16; ++r) { s1[r] = __builtin_amdgcn_exp2f(s1[r] - mrun); ps += s1[r]; }
  return ps;
}
struct A2V { u32x2 vl0[4], vh0[4], vl1[4], vh1[4]; };
__device__ __forceinline__ void a2_vload(LAS unsigned char* vst, int qi, int half, A2V& f) {
  const int sw = (qi >> 1) & 7;
  LAS unsigned char* v0row = vst + qi * 128 + half * 8;
  LAS unsigned char* v1row = vst + (32 + qi) * 128 + half * 8;
#pragma unroll
  for (int kk = 0; kk < 4; ++kk) {
    const int olo = ((kk * 2) ^ sw) * 16, ohi = ((kk * 2 + 1) ^ sw) * 16;
    f.vl0[kk] = *(const LAS u32x2*)(v0row + olo); f.vh0[kk] = *(const LAS u32x2*)(v0row + ohi);
    f.vl1[kk] = *(const LAS u32x2*)(v1row + olo); f.vh1[kk] = *(const LAS u32x2*)(v1row + ohi);
  }
}
__device__ __forceinline__ void a2_pv(const A2V& f, const f32x16& s0, const f32x16& s1, f32x16& o0, f32x16& o1) {
  __builtin_amdgcn_s_setprio(1);
#pragma unroll
  for (int kk = 0; kk < 4; ++kk) {
    unsigned pk[4];
#pragma unroll
    for (int j = 0; j < 4; ++j) {
      float a = (kk < 2) ? s0[(kk & 1) * 8 + 2 * j] : s1[(kk & 1) * 8 + 2 * j];
      float b = (kk < 2) ? s0[(kk & 1) * 8 + 2 * j + 1] : s1[(kk & 1) * 8 + 2 * j + 1];
      pk[j] = pack2(a, b);
    }
    bf16x8 pb = __builtin_bit_cast(bf16x8, make_uint4(pk[0], pk[1], pk[2], pk[3]));
    bf16x8 av0 = __builtin_bit_cast(bf16x8, make_uint4(f.vl0[kk][0], f.vl0[kk][1], f.vh0[kk][0], f.vh0[kk][1]));
    bf16x8 av1 = __builtin_bit_cast(bf16x8, make_uint4(f.vl1[kk][0], f.vl1[kk][1], f.vh1[kk][0], f.vh1[kk][1]));
    o0 = __builtin_amdgcn_mfma_f32_32x32x16_bf16(av0, pb, o0, 0, 0, 0);
    o1 = __builtin_amdgcn_mfma_f32_32x32x16_bf16(av1, pb, o1, 0, 0, 0);
  }
  __builtin_amdgcn_s_setprio(0);
}
__device__ __forceinline__ void a2_softmax_pv(LAS unsigned char* vst, f32x16& s0, f32x16& s1, f32x16& o0, f32x16& o1,
                                              float& moff, float& lsum, int qi, int half, bool domask, int kbase,
                                              int qpos, bool first) {
  A2V f;
  a2_vload(vst, qi, half, f);
  __builtin_amdgcn_sched_barrier(0);
  if (domask) a2_mask(s0, s1, half, kbase, qpos);
  float delta;
  if (a2_update_off(a2_lanemax(s0, s1), first, moff, lsum, o0, o1, delta)) {
#pragma unroll
    for (int r = 0; r < 16; ++r) { s0[r] -= delta; s1[r] -= delta; }
  }
  lsum += a2_exp0(s0, s1);
  a2_pv(f, s0, s1, o0, o1);
}
__device__ __forceinline__ void a2_softmax_pv2(LAS unsigned char* vstA, LAS unsigned char* vstB, f32x16& a0, f32x16& a1,
                                               f32x16& b0, f32x16& b1, f32x16& o0, f32x16& o1, float& moff,
                                               float& lsum, int qi, int half, bool first) {
  A2V f;
  a2_vload(vstA, qi, half, f);
  __builtin_amdgcn_sched_barrier(0);
  float delta;
  if (a2_update_off(fmaxf(a2_lanemax(a0, a1), a2_lanemax(b0, b1)), first, moff, lsum, o0, o1, delta)) {
#pragma unroll
    for (int r = 0; r < 16; ++r) { a0[r] -= delta; a1[r] -= delta; b0[r] -= delta; b1[r] -= delta; }
  }
  lsum += a2_exp0(a0, a1);
  a2_pv(f, a0, a1, o0, o1);
  a2_vload(vstB, qi, half, f);
  lsum += a2_exp0(b0, b1);
  a2_pv(f, b0, b1, o0, o1);
}

__device__ __forceinline__ void attn256_item(const P& p, int bh, int qt, LAS unsigned char* lds, bool do_atomic = true) {
  const int t = otid(), w = __builtin_amdgcn_readfirstlane(t >> 6), l = t & 63, qi = l & 31, half = l >> 5;
  const int q0 = qt * 256, wq0 = q0 + w * 32;
  const bf16* Qp = p.Q + ((size_t)bh * 4096 + wq0 + qi) * 96;
  bf16x8 qf[6];
  const char* Kg = (const char*)(p.Kc + (size_t)bh * 4096 * 96);
  const char* Vg = (const char*)(p.Vt + (size_t)bh * 64 * 4096);
  const int nkt = 4 * qt + 4, nfull = 4 * qt;

  const int p2 = 512 + (t & 255);
  const unsigned ko1 = (unsigned)((((t >> 1) & 63) * 96 + ((t >> 7) * 2 + (t & 1)) * 8) * 2);
  const unsigned ko2 = (unsigned)((((p2 >> 1) & 63) * 96 + ((p2 >> 7) * 2 + (p2 & 1)) * 8) * 2);
  const int vdv = t >> 3;
  const unsigned vo = (unsigned)((vdv * 4096 + (((t & 7) ^ ((vdv >> 1) & 7)) * 8)) * 2);
  const unsigned ldsw = (unsigned)w * 1024u;
#define A2_ISSUE(kt_, st_) do { \
    const char* kb_ = Kg + (size_t)(kt_) * (64 * 96 * 2); const char* vb_ = Vg + (size_t)(kt_) * 128; \
    LAS unsigned char* sb_ = lds + (st_) * A2_STAGE; \
    __builtin_amdgcn_global_load_lds((const unsigned*)(kb_ + ko1), (LAS unsigned*)(sb_ + ldsw), 16, 0, 0); \
    if (w < 4) __builtin_amdgcn_global_load_lds((const unsigned*)(kb_ + ko2), (LAS unsigned*)(sb_ + 8192 + ldsw), 16, 0, 0); \
    __builtin_amdgcn_global_load_lds((const unsigned*)(vb_ + vo), (LAS unsigned*)(sb_ + A2_VOFF + ldsw), 16, 0, 0); } while (0)
#define A2_WAIT3 do { if (w < 4) asm volatile("s_waitcnt vmcnt(9)" ::: "memory"); else asm volatile("s_waitcnt vmcnt(6)" ::: "memory"); } while (0)
#define A2_WAIT0 asm volatile("s_waitcnt vmcnt(0)" ::: "memory")
#define A2_BAR asm volatile("s_waitcnt lgkmcnt(0)\n\ts_barrier" ::: "memory")

  A2_ISSUE(0, 0); A2_ISSUE(1, 1); A2_ISSUE(2, 2); A2_ISSUE(3, 3);
#pragma unroll
  for (int ks = 0; ks < 6; ++ks) qf[ks] = *(const bf16x8*)(Qp + ks * 16 + half * 8);
  A2_WAIT0;
#pragma unroll
  for (int ks = 0; ks < 6; ++ks) asm volatile("" : "+v"(qf[ks]));
  A2_BAR;

  f32x16 o0, o1, sa0, sa1, sb0, sb1;
#pragma unroll
  for (int r = 0; r < 16; ++r) { o0[r] = 0.f; o1[r] = 0.f; }
  float mrun = 0.f, lsum = 0.f;
  const int qpos = wq0 + qi;
  int sA = 0;
  int kt = 0;
#define A2_WAIT2 do { if (w < 4) asm volatile("s_waitcnt vmcnt(6)" ::: "memory"); else asm volatile("s_waitcnt vmcnt(4)" ::: "memory"); } while (0)
  for (; kt + 1 < nfull; kt += 2) {
    const int sI = (sA + 4 >= A2_NST) ? sA + 4 - A2_NST : sA + 4;
    A2_ISSUE(kt + 4, sI);
    A2_ISSUE(kt + 5, sI + 1);
    a2_qk(lds + sA * A2_STAGE, qf, qi, half, sa0, sa1, -mrun);
    a2_qk(lds + (sA + 1) * A2_STAGE, qf, qi, half, sb0, sb1, -mrun);
    a2_softmax_pv2(lds + sA * A2_STAGE + A2_VOFF, lds + (sA + 1) * A2_STAGE + A2_VOFF, sa0, sa1, sb0, sb1, o0, o1,
                   mrun, lsum, qi, half, kt == 0);
    A2_WAIT2;
    A2_BAR;
    sA = (sA + 2 >= A2_NST) ? 0 : sA + 2;
  }
  for (; kt < nkt; kt += 2) {
#pragma unroll
    for (int u = 0; u < 2; ++u) {
      const int k1 = kt + u;
      if (k1 * 64 <= wq0 + 31) {
        a2_qk(lds + (sA + u) * A2_STAGE, qf, qi, half, sa0, sa1, -mrun);
        a2_softmax_pv(lds + (sA + u) * A2_STAGE + A2_VOFF, sa0, sa1, o0, o1, mrun, lsum, qi, half, (k1 * 64 + 63 > wq0),
                      k1 * 64, qpos, k1 == 0);
      }
    }
    A2_WAIT0;
    A2_BAR;
    sA = (sA + 2 >= A2_NST) ? 0 : sA + 2;
  }
  const float ltot = lsum + __shfl_xor(lsum, 32);
  const float inv = 1.f / ltot;
  const int b = bh >> 3, h = bh & 7;
  bf16* op = p.ycat + ((size_t)(b * 4096 + wq0 + qi)) * 1024 + 512 + h * 64 + half * 4;
  {
    float ss = 0.f;
#pragma unroll
    for (int r = 0; r < 16; ++r) { float a0 = o0[r] * inv, a1 = o1[r] * inv; ss += a0 * a0 + a1 * a1; }
    ss += __shfl_xor(ss, 32);
    if (half == 0 && do_atomic) atomicAdd(p.rss_a + b * 4096 + wq0 + qi, ss);
  }
#pragma unroll
  for (int rg = 0; rg < 4; ++rg) {
    uint2 v0, v1;
    v0.x = pack2(o0[rg * 4 + 0] * inv, o0[rg * 4 + 1] * inv);
    v0.y = pack2(o0[rg * 4 + 2] * inv, o0[rg * 4 + 3] * inv);
    v1.x = pack2(o1[rg * 4 + 0] * inv, o1[rg * 4 + 1] * inv);
    v1.y = pack2(o1[rg * 4 + 2] * inv, o1[rg * 4 + 3] * inv);
    *(uint2*)(op + rg * 8) = v0;
    *(uint2*)(op + 32 + rg * 8) = v1;
  }
}

template <bool TOBF>
__device__ __forceinline__ void norm_rows(const P& p, const float* __restrict__ src, const float* __restrict__ g,
                                          int shift_off, int scale_off, bf16* dstb, float* dstf, int item) {
  const int t = otid() & 255, w = t >> 6, l = t & 63;
  const int row0 = item * 16 + w;
  float4 v[4][4];
  float ss[4] = {0.f, 0.f, 0.f, 0.f};
#pragma unroll
  for (int q = 0; q < 4; ++q) {
    const float4* sp = (const float4*)(src + (size_t)(row0 + 4 * q) * 1024);
#pragma unroll
    for (int i = 0; i < 4; ++i) v[q][i] = ld_nt4((const float*)(sp + i * 64 + l));
  }
#pragma unroll
  for (int q = 0; q < 4; ++q)
#pragma unroll
    for (int i = 0; i < 4; ++i)
      ss[q] += v[q][i].x * v[q][i].x + v[q][i].y * v[q][i].y + v[q][i].z * v[q][i].z + v[q][i].w * v[q][i].w;
#pragma unroll
  for (int o = 32; o >= 1; o >>= 1) {
#pragma unroll
    for (int q = 0; q < 4; ++q) ss[q] += __shfl_xor(ss[q], o);
  }
  const float* md = p.mod + (row0 >> 12) * 8192;
#pragma unroll
  for (int i = 0; i < 4; ++i) {
    const int col = i * 256 + l * 4;
    float4 gg = *(const float4*)(g + col);
    float4 sc = *(const float4*)(md + scale_off + col);
    float4 sh = *(const float4*)(md + shift_off + col);
    const float m0 = gg.x * (1.f + sc.x), m1 = gg.y * (1.f + sc.y), m2 = gg.z * (1.f + sc.z), m3 = gg.w * (1.f + sc.w);
#pragma unroll
    for (int q = 0; q < 4; ++q) {
      const float rstd = rsqrtf(ss[q] * (1.f / 1024.f) + EPSN);
      const int row = row0 + 4 * q;
      float y0 = v[q][i].x * rstd * m0 + sh.x;
      float y1 = v[q][i].y * rstd * m1 + sh.y;
      float y2 = v[q][i].z * rstd * m2 + sh.z;
      float y3 = v[q][i].w * rstd * m3 + sh.w;
      if (TOBF) {
        uint2 o; o.x = pack2(y0, y1); o.y = pack2(y2, y3);
        *(uint2*)(dstb + (size_t)row * 1024 + col) = o;
      } else {
        st_nt4(dstf + (size_t)row * 1024 + col, make_float4(y0, y1, y2, y3));
      }
    }
  }
}

__device__ __forceinline__ void mod_item(const P& p, int item, char* smem, const int mode = 0) {
  float* cnd = (float*)smem;
  float* red = (float*)(smem + 8192);
  const int t = otid() & 255;
  const int cbk = (mode == 0) ? (item & 31) : (item & 15), ksp = (mode == 0) ? (item >> 5) : (item >> 4);
  const int n0 = cbk * 256, k0 = ksp * 128;
  const float* W; int ldw; int nn0; const float* bias;
  if (mode == 1) { W = p.w_ff1; ldw = 4096; nn0 = n0; bias = nullptr; }
  else if (n0 < 6144) { W = p.ada_w; ldw = 6144; nn0 = n0; bias = p.ada_b; }
  else { W = p.fada_w; ldw = 2048; nn0 = n0 - 6144; bias = p.fada_b; }
#pragma unroll
  for (int i = 0; i < 8; ++i) {
    int idx = i * 256 + t, b = idx >> 7, kk = idx & 127;
    if (mode == 1) {
      cnd[idx] = p.mod[b * 8192 + 3072 + k0 + kk];
    } else {
      float c = p.c[b * 1024 + k0 + kk];
      cnd[idx] = c * sigmoidf(c);
    }
  }
  __syncthreads();
  const int c4 = (t & 63) * 4, kq = t >> 6;
  float4 acc[16];
#pragma unroll
  for (int b = 0; b < 16; ++b) acc[b] = make_float4(0.f, 0.f, 0.f, 0.f);
  const float* wp = W + (size_t)(k0 + kq * 32) * ldw + nn0 + c4;
  for (int kb = 0; kb < 32; kb += 8) {
    float4 w[8];
#pragma unroll
    for (int u = 0; u < 8; ++u) w[u] = *(const float4*)(wp + (size_t)(kb + u) * ldw);
    __builtin_amdgcn_sched_barrier(0);
#pragma unroll
    for (int u = 0; u < 8; ++u) {
#pragma unroll
      for (int b = 0; b < 16; ++b) {
        float cv = cnd[b * 128 + kq * 32 + kb + u];
        acc[b].x += cv * w[u].x; acc[b].y += cv * w[u].y; acc[b].z += cv * w[u].z; acc[b].w += cv * w[u].w;
      }
      __builtin_amdgcn_sched_barrier(0);
    }
  }
#pragma unroll
  for (int b = 0; b < 16; ++b) *(float4*)(red + (kq * 16 + b) * 256 + c4) = acc[b];
  __syncthreads();
#pragma unroll
  for (int i = 0; i < 16; ++i) {
    int o = i * 256 + t, b = o >> 8, c = o & 255;
    float s = red[(0 * 16 + b) * 256 + c] + red[(1 * 16 + b) * 256 + c] + red[(2 * 16 + b) * 256 + c] + red[(3 * 16 + b) * 256 + c];
    if (mode == 1) {
      atomicAdd(p.biasff + b * 4096 + n0 + c, s);
    } else {
      if (ksp == 0) s += bias[nn0 + c];
      atomicAdd(p.mod + b * 8192 + n0 + c, s);
    }
  }
  __syncthreads();
}

__device__ __forceinline__ void tr_tile(const float* __restrict__ W, int K, int N, bf16* __restrict__ Wt,
                                        const float* __restrict__ rsA, const float* __restrict__ rsB, int splitK,
                                        int glu, int kt, int ntile, char* smem) {
  float* tile = (float*)smem;
  const int t = otid() & 255;
  const int k0 = kt * 64, n0 = ntile * 64;
#pragma unroll
  for (int i = 0; i < 4; ++i) {
    int r = (t >> 4) + 16 * i, c4 = (t & 15) * 4;
    float4 v = make_float4(0.f, 0.f, 0.f, 0.f);
    if (n0 + c4 < N) v = *(const float4*)(W + (size_t)(k0 + r) * N + n0 + c4);
    float sc = 1.f;
    if (rsA) { int k = k0 + r; sc = (k < splitK) ? rsA[k] : rsB[k - splitK]; }
    tile[(c4 + 0) * 65 + r] = v.x * sc;
    tile[(c4 + 1) * 65 + r] = v.y * sc;
    tile[(c4 + 2) * 65 + r] = v.z * sc;
    tile[(c4 + 3) * 65 + r] = v.w * sc;
  }
  __syncthreads();
  {
    int n = t >> 2, ks = (t & 3) * 16;
    int no = n0 + n;
    if (glu) { int vv = (no < 512) ? no : no - 512; no = (vv >> 4) * 32 + (vv & 15) + ((no < 512) ? 0 : 16); }
    unsigned o[8];
#pragma unroll
    for (int j = 0; j < 8; ++j) o[j] = pack2(tile[n * 65 + ks + 2 * j], tile[n * 65 + ks + 2 * j + 1]);
    uint4* dp = (uint4*)(Wt + (size_t)no * K + k0 + ks);
    dp[0] = make_uint4(o[0], o[1], o[2], o[3]);
    dp[1] = make_uint4(o[4], o[5], o[6], o[7]);
  }
  __syncthreads();
}

__device__ __forceinline__ float2 cmul(float2 a, float2 b) {
  return make_float2(a.x * b.x - a.y * b.y, a.x * b.y + a.y * b.x);
}
__device__ __forceinline__ float2 lam_pow(float lre, float lim, float dt, int m) {
  float mag = __expf((float)m * lre * dt);
  float s, c;
  sincosf((float)m * lim * dt, &s, &c);
  return make_float2(mag * c, mag * s);
}
__device__ __forceinline__ float2 zoh_fac(float lre, float lim, float dt) {
  float2 lb = lam_pow(lre, lim, dt, 1);
  float nr = lb.x - 1.f, ni = lb.y;
  float den = lre * lre + lim * lim;
  return make_float2((nr * lre + ni * lim) / den, (ni * lre - nr * lim) / den);
}

__device__ __forceinline__ void ktab_item(const P& p, int item, char* smem) {
  float2* lamm = (float2*)smem;
  float2* fac = lamm + 64;
  float2* CL = fac + 64;
  float2* BB = CL + 1024;
  const int t = otid() & 255;
  const int g = item >> 6, m = item & 63;
  if (t < 64) {
    float lre = p.lam_re[g * 64 + t], lim = p.lam_im[g * 64 + t], dt = __expf(p.log_dt[g]);
    lamm[t] = lam_pow(lre, lim, dt, m);
    fac[t] = zoh_fac(lre, lim, dt);
  }
  float cr[4], ci[4], br[4], bi[4];
#pragma unroll
  for (int i = 0; i < 4; ++i) {
    const int idx = g * 1024 + i * 256 + t;
    cr[i] = p.c_re[idx]; ci[i] = p.c_im[idx]; br[i] = p.b_re[idx]; bi[i] = p.b_im[idx];
  }
  __syncthreads();
#pragma unroll
  for (int i = 0; i < 4; ++i) {
    const int idx = i * 256 + t;
    CL[idx] = cmul(make_float2(cr[i], ci[i]), lamm[idx & 63]);
    BB[idx] = cmul(fac[idx >> 4], make_float2(br[i], bi[i]));
  }
  __syncthreads();
  const int h = t >> 4, hp = t & 15;
  float s = 0.f;
#pragma unroll 8
  for (int pp = 0; pp < 64; ++pp) {
    float2 c = CL[h * 64 + pp], bq = BB[pp * 16 + hp];
    s += c.x * bq.x - c.y * bq.y;
  }
  p.ktab[((size_t)(g * 64 + m) * 16 + h) * 16 + hp] = s;
  __syncthreads();
}

#define TR_IN 320
#define TR_GLU 128
#define TR_UQ 72
#define TR_UKV 64
#define TR_OUT 256
#define TR_FF1 1024
#define TR_FF2 1024

template <int PH>
__device__ __forceinline__ void run_phase(const P& p, int bid_, int nb_, char* smem_) {
  const int hb = __builtin_amdgcn_readfirstlane((otid() >> 8));
  const int bid = bid_ * 2 + hb, nb = nb_ * 2;
  char* smem = smem_ + hb * HSMEM;
  LAS unsigned char* lds = (LAS unsigned char*)smem_;
  const int t = otid() & 255;
  if (PH == 0) {
    const int n_mod = 256;
    const int n_tr = TR_IN + TR_GLU + TR_UQ + TR_UKV + TR_OUT + TR_FF1 + TR_FF2;
    const int n_kt = 2048;
    const int n_pw = (32 * 65 * 64) / 256;
    const int n_bb = (32 * 64 * 16) / 256;
    const int n_cs = (65536 * 16) / 256;
    const int total = n_mod + n_tr + n_kt + n_pw + n_bb + n_cs;
    for (int it = bid; it < total; it += nb) {
      int i = it;
      if (i < n_mod) { mod_item(p, i, smem); continue; }
      i -= n_mod;
      if (i < n_tr) {
        if (i < TR_IN) { tr_tile(p.w_in, 1024, 1184, p.Wt_in, nullptr, nullptr, 0, 0, i % 16, i / 16, smem); continue; }
        i -= TR_IN;
        if (i < TR_GLU) { tr_tile(p.w_glu, 512, 1024, p.Wt_glu, nullptr, nullptr, 0, 1, i % 8, i / 8, smem); continue; }
        i -= TR_GLU;
        if (i < TR_UQ) { tr_tile(p.w_uq, 384, 768, p.Wt_uq, p.q_norm_g, p.q_norm_g, 384, 0, i % 6, i / 6, smem); continue; }
        i -= TR_UQ;
        if (i < TR_UKV) { tr_tile(p.w_ukv, 256, 1024, p.Wt_ukv, p.kv_norm_g, p.kv_norm_g, 256, 0, i % 4, i / 4, smem); continue; }
        i -= TR_UKV;
        if (i < TR_OUT) { tr_tile(p.w_out, 1024, 1024, p.Wt_out, p.ssm_out_g, p.attn_out_g, 512, 0, i % 16, i / 16, smem); continue; }
        i -= TR_OUT;
        if (i < TR_FF1) { tr_tile(p.w_ff1, 1024, 4096, p.Wt_ff1, nullptr, nullptr, 0, 0, i % 16, i / 16, smem); continue; }
        i -= TR_FF1;
        tr_tile(p.w_ff2, 4096, 1024, p.Wt_ff2, nullptr, nullptr, 0, 0, i % 64, i / 64, smem);
        continue;
      }
      i -= n_tr;
      if (i < n_kt) { ktab_item(p, i, smem); continue; }
      i -= n_kt;
      if (i < n_pw) {
        int idx = i * 256 + t;
        int pp = idx & 63, m = (idx >> 6) % 65, g = idx / (64 * 65);
        float dt = __expf(p.log_dt[g]);
        p.pw[idx] = lam_pow(p.lam_re[g * 64 + pp], p.lam_im[g * 64 + pp], dt, m);
        continue;
      }
      i -= n_pw;
      if (i < n_bb) {
        int idx = i * 256 + t;
        int gp = idx >> 4;
        int g = gp >> 6;
        float dt = __expf(p.log_dt[g]);
        float2 f = zoh_fac(p.lam_re[gp], p.lam_im[gp], dt);
        p.bbar[idx] = cmul(f, make_float2(p.b_re[idx], p.b_im[idx]));
        continue;
      }
      i -= n_bb;
      {
        int idx = i * 256 + t;
        int tok = idx >> 4, ii = idx & 15;
        float invf = exp2f(-(float)ii * (13.287712379549449f / 16.f));
        float ang = (float)p.pos[tok] * invf;
        float s, c;
        sincosf(ang, &s, &c);
        p.cs[idx] = make_float2(c, s);
      }
    }
  } else if (PH == 1) {
    const int n_norm = 4096;
    const int n_te = (32 * 1024 * 144) / 256;
    const int n_f = (32 * 128 * 128) / 256;
    const int total = n_norm + n_te + n_f;
    for (int it = bid; it < total; it += nb) {
      int i = it;
      if (i < n_norm) { norm_rows<true>(p, p.x, p.norm1_g, 0, 1024, p.hbuf, nullptr, i); continue; }
      i -= n_norm;
      if (i < n_te) {
        int idx = i * 256 + t;
        int k8 = idx % 144, n = (idx / 144) & 1023, g = idx / (144 * 1024);
        int k = k8 * 8, j = n >> 4, h = n & 15;
        if (k < 1024 && k >= ((n >> 7) + 1) * 128) continue;
        float v[8];
        if (k < 1024) {
          int ii = k >> 4, hp0 = k & 15;
          if (ii <= j) {
            const float* kp = p.ktab + ((size_t)(g * 64 + (j - ii)) * 16 + h) * 16 + hp0;
            float4 a = *(const float4*)kp, b = *(const float4*)(kp + 4);
            v[0] = a.x; v[1] = a.y; v[2] = a.z; v[3] = a.w; v[4] = b.x; v[5] = b.y; v[6] = b.z; v[7] = b.w;
          } else {
#pragma unroll
            for (int q = 0; q < 8; ++q) v[q] = 0.f;
          }
        } else {
          int q = k - 1024, p0 = q & 63, isim = q >> 6;
#pragma unroll
          for (int jj = 0; jj < 8; ++jj) {
            int pp = p0 + jj;
            float2 C = make_float2(p.c_re[(g * 16 + h) * 64 + pp], p.c_im[(g * 16 + h) * 64 + pp]);
            float2 L = p.pw[(size_t)(g * 65 + j + 1) * 64 + pp];
            float2 pr = cmul(C, L);
            v[jj] = isim ? -pr.y : pr.x;
          }
        }
        uint4 o = make_uint4(pack2(v[0], v[1]), pack2(v[2], v[3]), pack2(v[4], v[5]), pack2(v[6], v[7]));
        *(uint4*)(p.Bty + ((size_t)(g * 1024 + n)) * 1152 + k) = o;
        continue;
      }
      i -= n_te;
      {
        int idx = i * 256 + t;
        int k8 = idx & 127, n = (idx >> 7) & 127, g = idx >> 14;
        int k = k8 * 8, ii = k >> 4, hp0 = k & 15;
        int pp = n & 63, isim = n >> 6;
        float2 L = p.pw[(size_t)(g * 65 + 63 - ii) * 64 + pp];
        float v[8];
#pragma unroll
        for (int jj = 0; jj < 8; ++jj) {
          float2 pr = cmul(L, p.bbar[(size_t)(g * 64 + pp) * 16 + hp0 + jj]);
          v[jj] = isim ? pr.y : pr.x;
        }
        uint4 o = make_uint4(pack2(v[0], v[1]), pack2(v[2], v[3]), pack2(v[4], v[5]), pack2(v[6], v[7]));
        *(uint4*)(p.Fm + ((size_t)(g * 128 + n)) * 1024 + k) = o;
      }
    }
  } else if (PH == 2) {
    gemm256_phase<EPI_INPROJ, 0>(p, p.hbuf, 1024, p.Wt_in, 1024, 1024, 5, bid_, nb_, lds);
  } else if (PH == 3) {
    gemm256_phase<EPI_KV, 0>(p, p.kvlat, 256, p.Wt_ukv, 256, 256, 4, bid_, nb_, lds);
    gemm256_phase<EPI_Q, 0>(p, p.qlat, 384, p.Wt_uq, 384, 384, 3, bid_, nb_, lds);
    for (int i = bid - 256; i >= 0 && i < 128; i += nb) mod_item(p, i, smem, 1);
    for (int i = bid; i < 256; i += nb) {
      int g = i >> 3, mt = i & 7;
      gemm_tile<EPI_S, 0>(p, p.Ag + (size_t)g * 1024 * 1152, 1152, p.Fm + (size_t)g * 128 * 1024, 1024, 16, 16, 0,
                          mt * 128, 0, g, smem);
      __syncthreads();
      if (t < 128) {
        const int bsel = t >> 6, pp = t & 63;
        const float* Sst = (const float*)smem + (bsel * 64) * 129;
        const float2 LL = p.pw[(size_t)(g * 65 + 64) * 64 + pp];
        float2 X = make_float2(0.f, 0.f);
        bf16* xp_ = p.Ag + ((size_t)(g * 1024 + mt * 128 + bsel * 64)) * 1152 + 1024 + pp;
        for (int c = 0; c < 64; ++c) {
          xp_[(size_t)c * 1152] = f2bf(X.x);
          xp_[(size_t)c * 1152 + 64] = f2bf(X.y);
          const float sr = Sst[c * 129 + pp], si = Sst[c * 129 + 64 + pp];
          const float2 nx = cmul(LL, X);
          X = make_float2(nx.x + sr, nx.y + si);
        }
      }
      __syncthreads();
    }
  } else if (PH == 4) {
    const int total = 32768 / 256;
    for (int it = bid; it < total; it += nb) {
      int idx = it * 256 + t;
      int pp = idx & 63, b = (idx >> 6) & 15, g = idx >> 10;
      float2 LL = p.pw[(size_t)(g * 65 + 64) * 64 + pp];
      float2 X = make_float2(0.f, 0.f);
      const size_t rbase = (size_t)(g * 1024 + b * 64);
      for (int c0 = 0; c0 < 64; c0 += 16) {
        float sr[16], si[16];
#pragma unroll
        for (int q = 0; q < 16; ++q) {
          sr[q] = p.S[(rbase + c0 + q) * 128 + pp];
          si[q] = p.S[(rbase + c0 + q) * 128 + 64 + pp];
        }
#pragma unroll
        for (int q = 0; q < 16; ++q) {
          size_t row = rbase + c0 + q;
          p.Ag[row * 1152 + 1024 + pp] = f2bf(X.x);
          p.Ag[row * 1152 + 1088 + pp] = f2bf(X.y);
          float2 nx = cmul(LL, X);
          X = make_float2(nx.x + sr[q], nx.y + si[q]);
        }
      }
    }
  } else if (PH == 5) {
    const int na = 4096, ny = 2048;
    const int total = na + ny;
    if (nb_ == 256) {
      const int x = bid_ & 7, j = bid_ >> 3;
      for (int r = 0; r < 8; ++r) attn256_item(p, 16 * x + 2 * r + (j >> 4), (r & 1) ? (15 - (j & 15)) : (j & 15), lds);
#ifdef ATTN_TWICE
      for (int r = 0; r < 8; ++r) attn256_item(p, 16 * x + 2 * r + (j >> 4), (r & 1) ? (15 - (j & 15)) : (j & 15), lds, false);
#endif
    } else {
      for (int it = bid_; it < 2048; it += nb_) attn256_item(p, it & 127, 15 - (it >> 7), lds);
    }
    __syncthreads();
    if (nb_ == 256) {
      const int x = bid_ & 7, q = bid_ >> 3;
      for (int r = 0; r < 4; ++r) {
        const int g = x + 8 * r, nt = ((q & 7) + 2 * r) & 7, mt = (q >> 3) * 2 + hb;
        const int nk1 = 2 * nt + 2;
        gemm_tile<EPI_Y, 0>(p, p.Ag + (size_t)g * 1024 * 1152, 1152, p.Bty + (size_t)g * 1024 * 1152, 1152, nk1 + 2,
                            nk1, 16, mt * 128, nt * 128, g, smem);
      }
    } else
    for (int it = na + bid; it < total; it += nb) {
      int i = it;
      i -= na;
      {
        int mt = ((i >> 4) & 3) * 2 + (i & 1), nt = (i >> 1) & 7, g = i >> 6;
        int nk1 = 2 * nt + 2;
        gemm_tile<EPI_Y, 0>(p, p.Ag + (size_t)g * 1024 * 1152, 1152, p.Bty + (size_t)g * 1024 * 1152, 1152, nk1 + 2,
                            nk1, 16, mt * 128, nt * 128, g, smem);
      }
    }
  } else if (PH == 6) {
    gemm256_phase<EPI_GLU, 0>(p, p.ygelu, 512, p.Wt_glu, 512, 512, 4, bid_, nb_, lds);
  } else if (PH == 7) {
    gemm256_phase<EPI_OUT, 2>(p, p.ycat, 1024, p.Wt_out, 1024, 1024, 4, bid_, nb_, lds);
  } else if (PH == 8) {
    for (int it = bid; it < 4096; it += nb) norm_rows<true>(p, p.out, p.norm2_g, 3072, 4096, p.hbuf, nullptr, it);
  } else if (PH == 9) {
    gemm256_phase<EPI_FF1, 0>(p, p.hbuf, 1024, p.Wt_ff1, 1024, 1024, 16, bid_, nb_, lds);
  } else if (PH == 10) {
    gemm256_phase<EPI_FF2, 0>(p, p.hid, 4096, p.Wt_ff2, 4096, 4096, 4, bid_, nb_, lds);
  } else if (PH == 11) {
    for (int it = bid; it < 4096; it += nb) norm_rows<false>(p, p.out, p.fnorm_g, 6144, 7168, nullptr, p.out, it);
  }
}

template <int PH>
__global__ void __launch_bounds__(NT, 2) k_phase(P p) {
  __shared__ __attribute__((aligned(16))) char smem[SMEM_BYTES];
  run_phase<PH>(p, blockIdx.x, gridDim.x, smem);
}

__global__ void __launch_bounds__(NT, 2) k_mega(P p) {
  __shared__ __attribute__((aligned(16))) char smem[SMEM_BYTES];
  cg::grid_group grid = cg::this_grid();
  const int bid = blockIdx.x, nb = gridDim.x;
#ifndef DUPMASK
#define DUPMASK 0
#endif
#define RUNP(ph) run_phase<ph>(p, bid, nb, smem); grid.sync(); if (DUPMASK & (1 << ph)) { run_phase<ph>(p, bid, nb, smem); grid.sync(); }
  RUNP(0) RUNP(1) RUNP(2) RUNP(3) RUNP(5) RUNP(6) RUNP(7) RUNP(9)
  run_phase<10>(p, bid, nb, smem); grid.sync();
  run_phase<11>(p, bid, nb, smem);
}

extern "C" void kernel_launch(void* const* d_in, const int* in_sizes, int n_in, void* d_out, int out_size, void* d_ws,
                              size_t ws_size, hipStream_t stream) {
  P p{};
  p.x = (const float*)d_in[0]; p.c = (const float*)d_in[1]; p.pos = (const int*)d_in[2];
  p.ada_w = (const float*)d_in[3]; p.ada_b = (const float*)d_in[4]; p.norm1_g = (const float*)d_in[5];
  p.w_in = (const float*)d_in[6]; p.lam_re = (const float*)d_in[7]; p.lam_im = (const float*)d_in[8];
  p.b_re = (const float*)d_in[9]; p.b_im = (const float*)d_in[10]; p.c_re = (const float*)d_in[11];
  p.c_im = (const float*)d_in[12]; p.ssm_d = (const float*)d_in[13]; p.log_dt = (const float*)d_in[14];
  p.w_glu = (const float*)d_in[15]; p.q_norm_g = (const float*)d_in[16]; p.w_uq = (const float*)d_in[17];
  p.kv_norm_g = (const float*)d_in[18]; p.w_ukv = (const float*)d_in[19]; p.ssm_out_g = (const float*)d_in[20];
  p.attn_out_g = (const float*)d_in[21]; p.w_out = (const float*)d_in[22]; p.norm2_g = (const float*)d_in[23];
  p.w_ff1 = (const float*)d_in[24]; p.w_ff2 = (const float*)d_in[25]; p.fada_w = (const float*)d_in[26];
  p.fada_b = (const float*)d_in[27]; p.fnorm_g = (const float*)d_in[28];
  p.out = (float*)d_out;
  char* ws = (char*)d_ws;
  size_t off = 0;
  auto take = [&](size_t bytes) { char* r = ws + off; off += (bytes + 255) & ~(size_t)255; return r; };
  p.Wt_in = (bf16*)take(1280ull * 1024 * 2);
  p.Wt_glu = (bf16*)take(1024ull * 512 * 2);
  p.Wt_uq = (bf16*)take(768ull * 384 * 2);
  p.Wt_ukv = (bf16*)take(1024ull * 256 * 2);
  p.Wt_out = (bf16*)take(1024ull * 1024 * 2);
  p.Wt_ff1 = (bf16*)take(4096ull * 1024 * 2);
  p.Wt_ff2 = (bf16*)take(1024ull * 4096 * 2);
  p.mod = (float*)take(16ull * 8192 * 4);
  p.rss_q = (float*)take(65536ull * 4);
  p.rss_kv = (float*)take(65536ull * 4);
  p.rss_s = (float*)take(65536ull * 4);
  p.rss_a = (float*)take(65536ull * 4);
  p.rss_x = (float*)take(65536ull * 4);
  p.biasff = (float*)take(16ull * 4096 * 4);
  p.pw = (float2*)take(32ull * 65 * 64 * 8);
  p.bbar = (float2*)take(32ull * 64 * 16 * 8);
  p.ktab = (float*)take(32ull * 64 * 256 * 4);
  p.cs = (float2*)take(65536ull * 16 * 8);
  p.hbuf = (bf16*)take(65536ull * 1024 * 2);
  size_t region = off;
  p.Ag = (bf16*)take(32ull * 1024 * 1152 * 2);
  p.Bty = (bf16*)take(32ull * 1024 * 1152 * 2);
  p.Fm = (bf16*)take(32ull * 128 * 1024 * 2);
  p.S = (float*)take(32ull * 1024 * 128 * 4);
  p.qlat = (bf16*)take(65536ull * 384 * 2);
  p.kvlat = (bf16*)take(65536ull * 256 * 2);
  p.Q = (bf16*)take(128ull * 4096 * 96 * 2);
  p.Kc = (bf16*)take(128ull * 4096 * 96 * 2);
  p.Vt = (bf16*)take(128ull * 64 * 4096 * 2);
  p.ygelu = (bf16*)take(65536ull * 512 * 2);
  p.ycat = (bf16*)take(65536ull * 1024 * 2);
  p.hid = (bf16*)(ws + region);

  hipMemsetAsync(p.mod, 0, 16ull * 8192 * 4 + 5ull * 65536 * 4 + 16ull * 4096 * 4, stream);
#if ONE_LAUNCH
  static int grid_blocks = 0;
  if (!grid_blocks) {
    int dev = 0, cus = 0, per_cu = 0;
    hipGetDevice(&dev);
    hipDeviceGetAttribute(&cus, hipDeviceAttributeMultiprocessorCount, dev);
    hipOccupancyMaxActiveBlocksPerMultiprocessor(&per_cu, k_mega, NT, 0);
    if (per_cu > 1) per_cu = 1;
    if (per_cu < 1) per_cu = 1;
    grid_blocks = cus * per_cu;
  }
  void* args[] = {&p};
  hipError_t e = hipLaunchCooperativeKernel((void*)k_mega, dim3(grid_blocks), dim3(NT), args, 0, stream);
  if (e != hipSuccess) fprintf(stderr, "cooperative launch failed: %s (grid %d)\n", hipGetErrorString(e), grid_blocks);
#else
  const int G = 256;
  k_phase<0><<<G, NT, 0, stream>>>(p);
  k_phase<1><<<G, NT, 0, stream>>>(p);
  k_phase<2><<<G, NT, 0, stream>>>(p);
  k_phase<3><<<G, NT, 0, stream>>>(p);
  k_phase<5><<<G, NT, 0, stream>>>(p);
  k_phase<6><<<G, NT, 0, stream>>>(p);
  k_phase<7><<<G, NT, 0, stream>>>(p);
  k_phase<9><<<G, NT, 0, stream>>>(p);
  k_phase<10><<<G, NT, 0, stream>>>(p);
  k_phase<11><<<G, NT, 0, stream>>>(p);
#endif
}
```

```cpp
#include <hip/hip_runtime.h>
#include <hip/hip_cooperative_groups.h>
#include <stdint.h>
#include <cstdio>
namespace cg = cooperative_groups;

#ifndef ONE_LAUNCH
#define ONE_LAUNCH 1
#endif

typedef unsigned short bf16;
typedef __attribute__((ext_vector_type(8))) short bf16x8;
typedef __attribute__((ext_vector_type(4))) float f32x4;
typedef __attribute__((ext_vector_type(16))) float f32x16;

#define NT 512
#define HSMEM (73728 + 1024)
#define SMEM_BYTES (2 * HSMEM)
#define LAS __attribute__((address_space(3)))
#define EPSN 1e-6f
#define QSCALE (0.10206207261596577f * 1.4426950408889634f)

struct P {
  const float *x, *c; const int* pos;
  const float *ada_w, *ada_b, *norm1_g, *w_in, *lam_re, *lam_im, *b_re, *b_im, *c_re, *c_im, *ssm_d, *log_dt,
      *w_glu, *q_norm_g, *w_uq, *kv_norm_g, *w_ukv, *ssm_out_g, *attn_out_g, *w_out, *norm2_g, *w_ff1, *w_ff2,
      *fada_w, *fada_b, *fnorm_g;
  float* out;
  bf16 *Wt_in, *Wt_glu, *Wt_uq, *Wt_ukv, *Wt_out, *Wt_ff1, *Wt_ff2;
  float* mod; float2* pw; float2* bbar; float* ktab; float2* cs;
  bf16* hbuf; bf16 *Ag, *Bty, *Fm; float* S;
  bf16 *qlat, *kvlat, *Q, *Kc, *Vt, *ygelu, *ycat, *hid;
  float *rss_q, *rss_kv, *rss_s, *rss_a, *rss_x, *biasff;
};

__device__ __forceinline__ int otid() { int t = threadIdx.x; asm volatile("" : "+v"(t)); return t; }
__device__ __forceinline__ float bf2f(unsigned h) { return __uint_as_float(h << 16); }
__device__ __forceinline__ unsigned pack2(float a, float b) {
  typedef __attribute__((ext_vector_type(2))) __bf16 bf2;
  bf2 v; v[0] = (__bf16)a; v[1] = (__bf16)b;
  return __builtin_bit_cast(unsigned, v);
}
__device__ __forceinline__ bf16 f2bf(float a) { return (bf16)(pack2(a, 0.f) & 0xffffu); }
__device__ __forceinline__ float sq2(unsigned w) {
  float a = __uint_as_float(w << 16), b = __uint_as_float(w & 0xffff0000u);
  return a * a + b * b;
}
__device__ __forceinline__ float4 ld_nt4(const float* q) { f32x4 w = __builtin_nontemporal_load((const f32x4*)q); return make_float4(w[0], w[1], w[2], w[3]); }
__device__ __forceinline__ void st_nt4(float* q, float4 v) { f32x4 w; w[0] = v.x; w[1] = v.y; w[2] = v.z; w[3] = v.w; __builtin_nontemporal_store(w, (f32x4*)q); }
__device__ __forceinline__ float gelu_tanh(float x) {
  float z = 0.7978845608028654f * (x + 0.044715f * x * x * x);
  float e = __expf(2.f * z);
  float th = 1.f - 2.f * __builtin_amdgcn_rcpf(e + 1.f);
  return 0.5f * x * (1.f + th);
}
__device__ __forceinline__ float sigmoidf(float x) { return __builtin_amdgcn_rcpf(1.f + __expf(-x)); }

enum { EPI_INPROJ = 0, EPI_Q, EPI_KV, EPI_S, EPI_Y, EPI_GLU, EPI_OUT, EPI_FF1, EPI_FF2 };

template <int EPI, int PRE>
__device__ __forceinline__ void gemm_tile(const P& p, const bf16* __restrict__ A, int lda, const bf16* __restrict__ Bt,
                                          int ldb, int nt_total, int nk1, int kjump, int m0, int n0, int g,
                                          char* smem) {
  bf16* As = (bf16*)smem;
  bf16* Bs = As + 2 * 128 * 72;
  float* rs = (float*)(Bs + 2 * 128 * 72);
  const int t = otid() & 255, w = __builtin_amdgcn_readfirstlane(t >> 6), l = t & 63, wm = w >> 1, wn = w & 1, lr = l & 15, lq = l >> 4;

  if (PRE == 1) {
    const int K = nt_total * 64;
    int row = t >> 1, hf = t & 1;
    const bf16* ap = A + (size_t)(m0 + row) * lda + hf * (K / 2);
    float ss = 0.f;
    for (int c = 0; c < K / 16; ++c) {
      uint4 v = *(const uint4*)(ap + c * 8);
      ss += sq2(v.x) + sq2(v.y) + sq2(v.z) + sq2(v.w);
    }
    ss += __shfl_xor(ss, 1);
    if (!hf) rs[row] = rsqrtf(ss / (float)K + EPSN);
  }
  if (PRE == 2) {
    int row = t >> 1, hf = t & 1;
    const bf16* ap = A + (size_t)(m0 + row) * lda + hf * 512;
    float ss = 0.f;
    for (int c = 0; c < 64; ++c) {
      uint4 v = *(const uint4*)(ap + c * 8);
      ss += sq2(v.x) + sq2(v.y) + sq2(v.z) + sq2(v.w);
    }
    rs[hf * 128 + row] = rsqrtf(ss / 512.f + EPSN);
  }

  f32x4 acc[4][4];
#pragma unroll
  for (int i = 0; i < 4; ++i)
#pragma unroll
    for (int j = 0; j < 4; ++j) acc[i][j] = (f32x4){0.f, 0.f, 0.f, 0.f};

  const int ldrow = t >> 3, ldkc = (t & 7) * 8;
  const bf16* Ap = A + (size_t)(m0 + ldrow) * lda + ldkc;
  const bf16* Bp = Bt + (size_t)(n0 + ldrow) * ldb + ldkc;
  uint4 ra[4], rb[4];
  {
    int kt = (0 < nk1) ? 0 : kjump;
#pragma unroll
    for (int i = 0; i < 4; ++i) {
      ra[i] = *(const uint4*)(Ap + (size_t)i * 32 * lda + kt * 64);
      rb[i] = *(const uint4*)(Bp + (size_t)i * 32 * ldb + kt * 64);
    }
#pragma unroll
    for (int i = 0; i < 4; ++i) {
      *(uint4*)(As + (ldrow + 32 * i) * 72 + ldkc) = ra[i];
      *(uint4*)(Bs + (ldrow + 32 * i) * 72 + ldkc) = rb[i];
    }
  }
  __syncthreads();

  for (int it = 0; it < nt_total; ++it) {
    const int buf = it & 1;
    const bool more = (it + 1 < nt_total);
    if (more) {
      int kt = (it + 1 < nk1) ? (it + 1) : (it + 1 - nk1 + kjump);
#pragma unroll
      for (int i = 0; i < 4; ++i) {
        ra[i] = *(const uint4*)(Ap + (size_t)i * 32 * lda + kt * 64);
        rb[i] = *(const uint4*)(Bp + (size_t)i * 32 * ldb + kt * 64);
      }
    }
    if (PRE == 2) {
      if (it == 8) {
#pragma unroll
        for (int mt = 0; mt < 4; ++mt)
#pragma unroll
          for (int r = 0; r < 4; ++r) {
            int rl = wm * 64 + mt * 16 + lq * 4 + r;
            float f = rs[rl] / rs[128 + rl];
#pragma unroll
            for (int nt = 0; nt < 4; ++nt) acc[mt][nt][r] *= f;
          }
      }
    }
    const bf16* Ab = As + buf * (128 * 72) + (wm * 64 + lr) * 72 + lq * 8;
    const bf16* Bb = Bs + buf * (128 * 72) + (wn * 64 + lr) * 72 + lq * 8;
#pragma unroll
    for (int ks = 0; ks < 2; ++ks) {
      bf16x8 a[4], b[4];
#pragma unroll
      for (int i = 0; i < 4; ++i) {
        a[i] = *(const bf16x8*)(Ab + i * 16 * 72 + ks * 32);
        b[i] = *(const bf16x8*)(Bb + i * 16 * 72 + ks * 32);
      }
      __builtin_amdgcn_s_setprio(1);
#pragma unroll
      for (int mt = 0; mt < 4; ++mt)
#pragma unroll
        for (int nt = 0; nt < 4; ++nt)
          acc[mt][nt] = __builtin_amdgcn_mfma_f32_16x16x32_bf16(a[mt], b[nt], acc[mt][nt], 0, 0, 0);
      __builtin_amdgcn_s_setprio(0);
    }
    if (more) {
#pragma unroll
      for (int i = 0; i < 4; ++i) {
        *(uint4*)(As + (buf ^ 1) * (128 * 72) + (ldrow + 32 * i) * 72 + ldkc) = ra[i];
        *(uint4*)(Bs + (buf ^ 1) * (128 * 72) + (ldrow + 32 * i) * 72 + ldkc) = rb[i];
      }
    }
    __syncthreads();
  }

#pragma unroll
  for (int mt = 0; mt < 4; ++mt) {
    const int rl0 = wm * 64 + mt * 16 + lq * 4;
    const int row0 = m0 + rl0;
#pragma unroll
    for (int nt = 0; nt < 4; ++nt) {
      const int cb = n0 + wn * 64 + nt * 16;
      const int col = cb + lr;
      if (EPI == EPI_INPROJ) {
        if (cb < 512) {
          const int gg = cb >> 4;
#pragma unroll
          for (int r = 0; r < 4; ++r) {
            int row = row0 + r, b = row >> 12, s = row & 4095, c = s >> 6, j = s & 63;
            p.Ag[((size_t)(gg * 1024 + b * 64 + c)) * 1152 + j * 16 + lr] = f2bf(acc[mt][nt][r]);
          }
        } else if (cb < 896) {
#pragma unroll
          for (int r = 0; r < 4; ++r) p.qlat[(size_t)(row0 + r) * 384 + (col - 512)] = f2bf(acc[mt][nt][r]);
        } else if (cb < 1152) {
#pragma unroll
          for (int r = 0; r < 4; ++r) p.kvlat[(size_t)(row0 + r) * 256 + (col - 896)] = f2bf(acc[mt][nt][r]);
        } else if (cb == 1152) {
          if (nt < 3) {
#pragma unroll
            for (int r = 0; r < 4; ++r) {
              int row = row0 + r, b = row >> 12, s = row & 4095;
              float2 cs = p.cs[(size_t)row * 16 + lr];
              float x1 = acc[mt][nt][r], x2 = acc[mt][nt < 3 ? nt + 1 : nt][r];
              bf16 o1 = f2bf(x1 * cs.x - x2 * cs.y), o2 = f2bf(x1 * cs.y + x2 * cs.x);
#pragma unroll
              for (int h = 0; h < 8; ++h) {
                bf16* kp = p.Kc + ((size_t)((b * 8 + h) * 4096 + s)) * 96;
                kp[64 + lr] = o1;
                kp[80 + lr] = o2;
              }
            }
          }
        }
      } else if (EPI == EPI_Q) {
        const int hq = cb / 96, d0 = cb - hq * 96;
        if (d0 < 64) {
#pragma unroll
          for (int r = 0; r < 4; ++r) {
            int row = row0 + r, b = row >> 12, s = row & 4095;
            float v = acc[mt][nt][r] * rs[rl0 + r] * QSCALE;
            p.Q[((size_t)((b * 8 + hq) * 4096 + s)) * 96 + d0 + lr] = f2bf(v);
          }
        } else if (d0 == 64) {
          if (nt < 3) {
#pragma unroll
            for (int r = 0; r < 4; ++r) {
              int row = row0 + r, b = row >> 12, s = row & 4095;
              float sc = rs[rl0 + r] * QSCALE;
              float x1 = acc[mt][nt][r] * sc, x2 = acc[mt][nt < 3 ? nt + 1 : nt][r] * sc;
              float2 cs = p.cs[(size_t)row * 16 + lr];
              bf16* qp = p.Q + ((size_t)((b * 8 + hq) * 4096 + s)) * 96;
              qp[64 + lr] = f2bf(x1 * cs.x - x2 * cs.y);
              qp[80 + lr] = f2bf(x1 * cs.y + x2 * cs.x);
            }
          }
        }
      } else if (EPI == EPI_KV) {
        const int hk = cb >> 7, d0 = cb & 127;
        const int b = row0 >> 12, s0 = row0 & 4095;
        if (d0 < 64) {
#pragma unroll
          for (int r = 0; r < 4; ++r)
            p.Kc[((size_t)((b * 8 + hk) * 4096 + s0 + r)) * 96 + d0 + lr] = f2bf(acc[mt][nt][r] * rs[rl0 + r]);
        } else {
          uint2 v;
          v.x = pack2(acc[mt][nt][0] * rs[rl0 + 0], acc[mt][nt][1] * rs[rl0 + 1]);
          v.y = pack2(acc[mt][nt][2] * rs[rl0 + 2], acc[mt][nt][3] * rs[rl0 + 3]);
          *(uint2*)(p.Vt + ((size_t)((b * 8 + hk) * 64 + (d0 - 64) + lr)) * 4096 + s0) = v;
        }
      } else if (EPI == EPI_S) {
#pragma unroll
        for (int r = 0; r < 4; ++r) ((float*)smem)[(rl0 + r) * 129 + col] = acc[mt][nt][r];
      } else if (EPI == EPI_Y) {
        const float dd = p.ssm_d[g * 16 + lr];
        const int j = cb >> 4;
#pragma unroll
        for (int r = 0; r < 4; ++r) {
          int row = row0 + r, b = row >> 6, c = row & 63;
          float u = bf2f(p.Ag[((size_t)(g * 1024 + row)) * 1152 + col]);
          float y = gelu_tanh(acc[mt][nt][r] + dd * u);
          p.ygelu[((size_t)(b * 4096 + c * 64 + j)) * 512 + g * 16 + lr] = f2bf(y);
        }
      } else if (EPI == EPI_GLU) {
        if ((nt & 1) == 0) {
          const int oc = (cb >> 5) * 16 + lr;
#pragma unroll
          for (int r = 0; r < 4; ++r) {
            float v = acc[mt][nt][r] * sigmoidf(acc[mt][(nt & 1) == 0 ? nt + 1 : nt][r]);
            p.ycat[(size_t)(row0 + r) * 1024 + oc] = f2bf(v);
          }
        }
      } else if (EPI == EPI_OUT) {
#pragma unroll
        for (int r = 0; r < 4; ++r) {
          int row = row0 + r, b = row >> 12;
          size_t o = (size_t)row * 1024 + col;
          p.out[o] = p.x[o] + p.mod[b * 8192 + 2048 + col] * acc[mt][nt][r] * rs[128 + rl0 + r];
        }
      } else if (EPI == EPI_FF1) {
#pragma unroll
        for (int r = 0; r < 4; ++r) {
          float v = fmaxf(acc[mt][nt][r], 0.f);
          p.hid[(size_t)(row0 + r) * 4096 + col] = f2bf(v * v);
        }
      } else if (EPI == EPI_FF2) {
#pragma unroll
        for (int r = 0; r < 4; ++r) {
          int row = row0 + r, b = row >> 12;
          size_t o = (size_t)row * 1024 + col;
          p.out[o] = p.out[o] + p.mod[b * 8192 + 5120 + col] * acc[mt][nt][r];
        }
      }
    }
  }
  if (PRE != 0) __syncthreads();
}

__device__ __forceinline__ int lds_byte(int r, int c) {
  int st = (r >> 4) * 2 + (c >> 5), rr = r & 15, cc = c & 31, ob = rr * 64 + cc * 2;
  return st * 1024 + (ob ^ (((ob >> 9) & 1) << 5));
}
__device__ __forceinline__ void stage_rc(int b, int& R, int& C) {
  int st = b / 1024, sb = b % 1024, swz = sb ^ (((sb >> 9) & 1) << 5);
  R = (st >> 1) * 16 + swz / 64;
  C = (st & 1) * 32 + (swz % 64) / 2;
}

#define RS_OFF 139264
#define STB_PITCH 272
#define STF_PITCH 260
#define KST_PITCH 136
#define VT_OFF 69632
#define VT_PITCH 264

typedef __attribute__((ext_vector_type(2))) unsigned u32x2;
typedef __attribute__((ext_vector_type(4))) unsigned u32x4;
__device__ __forceinline__ void lds_st2(LAS bf16* q, uint2 v) { u32x2 w; w[0] = v.x; w[1] = v.y; *(LAS u32x2*)q = w; }
__device__ __forceinline__ void lds_st4f(LAS float* q, float4 v) { f32x4 w; w[0] = v.x; w[1] = v.y; w[2] = v.z; w[3] = v.w; *(LAS f32x4*)q = w; }
__device__ __forceinline__ uint4 lds_ld4(LAS bf16* q) { u32x4 w = *(LAS u32x4*)q; return make_uint4(w[0], w[1], w[2], w[3]); }
__device__ __forceinline__ float4 lds_ld4f(LAS float* q) { f32x4 w = *(LAS f32x4*)q; return make_float4(w[0], w[1], w[2], w[3]); }

#define EPI_BAR asm volatile("s_waitcnt lgkmcnt(0)\n\ts_barrier" ::: "memory")
template <int EPI>
__device__ __forceinline__ void epi256(const P& p, f32x4 (&acc)[2][2][4][2], int brow, int bcol, LAS unsigned char* lds) {
  const int tid = otid(), wid = __builtin_amdgcn_readfirstlane(tid >> 6), lane = tid & 63, wr = wid >> 2,
            wc = wid & 3, fr = lane & 15, fq = lane >> 4;
  LAS bf16* stb = (LAS bf16*)lds;
  LAS float* stf = (LAS float*)lds;

  if (EPI == EPI_OUT || EPI == EPI_FF2) {
    const float* src = (EPI == EPI_OUT) ? p.x : p.out;
    const int goff = (EPI == EPI_OUT) ? 2048 : 5120;
    const int c4 = (tid & 63) * 4, col = bcol + c4, bb = brow >> 12, rw = tid >> 6;
    const float4 g4 = *(const float4*)(p.mod + bb * 8192 + goff + col);
    float4 n4 = make_float4(0.f, 0.f, 0.f, 0.f);
    if (EPI == EPI_OUT) {
      const float4 ng = *(const float4*)(p.norm2_g + col);
      const float4 sc2 = *(const float4*)(p.mod + bb * 8192 + 4096 + col);
      n4 = make_float4(ng.x * (1.f + sc2.x), ng.y * (1.f + sc2.y), ng.z * (1.f + sc2.z), ng.w * (1.f + sc2.w));
    }
#pragma unroll
    for (int ai = 0; ai < 2; ++ai) {
      float4 xp[16];
#pragma unroll
      for (int i = 0; i < 16; ++i) xp[i] = ld_nt4(src + (size_t)(brow + ai * 128 + i * 8 + rw) * 1024 + col);
#pragma unroll
      for (int m = 0; m < 4; ++m) {
        const int rl = wr * 64 + m * 16 + fr;
        float sc = 1.f;
        if (EPI == EPI_OUT) sc = rsqrtf(((LAS float*)(lds + RS_OFF))[ai * 128 + rl] * (1.f / 512.f) + EPSN);
#pragma unroll
        for (int bj = 0; bj < 2; ++bj)
#pragma unroll
          for (int n = 0; n < 2; ++n) {
            const int cl = bj * 128 + wc * 32 + n * 16 + fq * 4;
            f32x4 v = acc[ai][bj][m][n];
            lds_st4f(stf + rl * STF_PITCH + cl, make_float4(v[0] * sc, v[1] * sc, v[2] * sc, v[3] * sc));
          }
      }
      EPI_BAR;
#pragma unroll
      for (int i = 0; i < 16; ++i) {
        const int row = i * 8 + rw;
        float4 v = lds_ld4f(stf + row * STF_PITCH + c4);
        const int grow = brow + ai * 128 + row;
        const float4 x4 = xp[i];
        const float y0 = x4.x + g4.x * v.x, y1 = x4.y + g4.y * v.y, y2 = x4.z + g4.z * v.z, y3 = x4.w + g4.w * v.w;
        st_nt4(p.out + (size_t)grow * 1024 + col, make_float4(y0, y1, y2, y3));
        if (EPI == EPI_OUT) {
          *(uint2*)(p.hbuf + (size_t)grow * 1024 + col) = make_uint2(pack2(y0 * n4.x, y1 * n4.y), pack2(y2 * n4.z, y3 * n4.w));
          float ss = y0 * y0 + y1 * y1 + y2 * y2 + y3 * y3;
#pragma unroll
          for (int o = 32; o >= 1; o >>= 1) ss += __shfl_xor(ss, o);
          if ((tid & 63) == 0) atomicAdd(p.rss_x + grow, ss);
        }
      }
      EPI_BAR;
    }
    return;
  }

#pragma unroll
  for (int ai = 0; ai < 2; ++ai)
#pragma unroll
    for (int m = 0; m < 4; ++m) {
      const int rl = ai * 128 + wr * 64 + m * 16 + fr;
      const int row = brow + rl;
      float rsv = 1.f;
      LAS float* rsl = (LAS float*)(lds + RS_OFF);
      if (EPI == EPI_FF1) rsv = rsqrtf(rsl[rl] * (1.f / 1024.f) + EPSN);
      if (EPI == EPI_Q) rsv = rsqrtf(rsl[rl] * (1.f / 384.f) + EPSN) * QSCALE;
      if (EPI == EPI_KV) rsv = rsqrtf(rsl[rl] * (1.f / 256.f) + EPSN);
#pragma unroll
      for (int bj = 0; bj < 2; ++bj)
#pragma unroll
        for (int n = 0; n < 2; ++n) {
          const int cl = bj * 128 + wc * 32 + n * 16 + fq * 4;
          const int cb = bcol + bj * 128 + wc * 32 + n * 16;
          const f32x4 v = acc[ai][bj][m][n];
          const f32x4 vn = acc[ai][bj][m][1];
          if (EPI == EPI_FF1) {
            const float4 bi = lds_ld4f((LAS float*)(lds + RS_OFF + 1024) + cl);
            float a0 = fmaxf(v[0] * rsv + bi.x, 0.f), a1 = fmaxf(v[1] * rsv + bi.y, 0.f);
            float a2 = fmaxf(v[2] * rsv + bi.z, 0.f), a3 = fmaxf(v[3] * rsv + bi.w, 0.f);
            lds_st2(stb + rl * STB_PITCH + cl, make_uint2(pack2(a0 * a0, a1 * a1), pack2(a2 * a2, a3 * a3)));
          } else if (EPI == EPI_GLU) {
            if (n == 0) {
              const int oc = bj * 64 + wc * 16 + fq * 4;
              lds_st2(stb + rl * STB_PITCH + oc, make_uint2(pack2(v[0] * sigmoidf(vn[0]), v[1] * sigmoidf(vn[1])),
                             pack2(v[2] * sigmoidf(vn[2]), v[3] * sigmoidf(vn[3]))));
            }
          } else if (EPI == EPI_KV) {
            if (wc < 2) {
              lds_st2(stb + rl * KST_PITCH + bj * 64 + wc * 32 + n * 16 + fq * 4, make_uint2(pack2(v[0] * rsv, v[1] * rsv), pack2(v[2] * rsv, v[3] * rsv)));
            } else {
              LAS bf16* vt = (LAS bf16*)(lds + VT_OFF) + (bj * 64 + (wc - 2) * 32 + n * 16 + fq * 4) * VT_PITCH + rl;
              vt[0] = f2bf(v[0] * rsv); vt[VT_PITCH] = f2bf(v[1] * rsv);
              vt[2 * VT_PITCH] = f2bf(v[2] * rsv); vt[3 * VT_PITCH] = f2bf(v[3] * rsv);
            }
          } else if (EPI == EPI_Q) {
            const int hq = cb / 96, d0 = cb - hq * 96;
            if (d0 < 64) {
              lds_st2(stb + rl * STB_PITCH + cl, make_uint2(pack2(v[0] * rsv, v[1] * rsv), pack2(v[2] * rsv, v[3] * rsv)));
            } else if (d0 == 64) {
              if (n == 0) {
                const float4 c01 = *(const float4*)(p.cs + (size_t)row * 16 + fq * 4);
                const float4 c23 = *(const float4*)(p.cs + (size_t)row * 16 + fq * 4 + 2);
                float x10 = v[0] * rsv, x11 = v[1] * rsv, x12 = v[2] * rsv, x13 = v[3] * rsv;
                float x20 = vn[0] * rsv, x21 = vn[1] * rsv, x22 = vn[2] * rsv, x23 = vn[3] * rsv;
                lds_st2(stb + rl * STB_PITCH + cl, make_uint2(pack2(x10 * c01.x - x20 * c01.y, x11 * c01.z - x21 * c01.w),
                               pack2(x12 * c23.x - x22 * c23.y, x13 * c23.z - x23 * c23.w)));
                lds_st2(stb + rl * STB_PITCH + cl + 16, make_uint2(pack2(x10 * c01.y + x20 * c01.x, x11 * c01.w + x21 * c01.z),
                               pack2(x12 * c23.y + x22 * c23.x, x13 * c23.w + x23 * c23.z)));
              }
            }
          } else if (EPI == EPI_INPROJ) {
            if (cb < 1152) {
              lds_st2(stb + rl * STB_PITCH + cl, make_uint2(pack2(v[0], v[1]), pack2(v[2], v[3])));
            } else if (cb == 1152) {
              if (n == 0) {
                const float4 c01 = *(const float4*)(p.cs + (size_t)row * 16 + fq * 4);
                const float4 c23 = *(const float4*)(p.cs + (size_t)row * 16 + fq * 4 + 2);
                lds_st2(stb + rl * STB_PITCH + cl,
                        make_uint2(pack2(v[0] * c01.x - vn[0] * c01.y, v[1] * c01.z - vn[1] * c01.w),
                                   pack2(v[2] * c23.x - vn[2] * c23.y, v[3] * c23.z - vn[3] * c23.w)));
                lds_st2(stb + rl * STB_PITCH + cl + 16,
                        make_uint2(pack2(v[0] * c01.y + vn[0] * c01.x, v[1] * c01.w + vn[1] * c01.z),
                                   pack2(v[2] * c23.y + vn[2] * c23.x, v[3] * c23.w + vn[3] * c23.z)));
              }
            }
          }
        }
    }
  EPI_BAR;

  if (EPI == EPI_FF1) {
#pragma unroll
    for (int i = 0; i < 16; ++i) {
      const int chunk = i * 512 + tid, row = chunk >> 5, c8 = (chunk & 31) * 8;
      uint4 v = lds_ld4(stb + row * STB_PITCH + c8);
      u32x4 vv; vv[0] = v.x; vv[1] = v.y; vv[2] = v.z; vv[3] = v.w;
      __builtin_nontemporal_store(vv, (u32x4*)(p.hid + (size_t)(brow + row) * 4096 + bcol + c8));
    }
  } else if (EPI == EPI_GLU) {
#pragma unroll
    for (int i = 0; i < 8; ++i) {
      const int chunk = i * 512 + tid, row = chunk >> 4, c8 = (chunk & 15) * 8;
      uint4 v = lds_ld4(stb + row * STB_PITCH + c8);
      *(uint4*)(p.ycat + (size_t)(brow + row) * 1024 + (bcol >> 1) + c8) = v;
      float ss = sq2(v.x) + sq2(v.y) + sq2(v.z) + sq2(v.w);
#pragma unroll
      for (int o = 8; o >= 1; o >>= 1) ss += __shfl_xor(ss, o);
      if ((tid & 15) == 0) atomicAdd(p.rss_s + brow + row, ss);
    }
  } else if (EPI == EPI_KV) {
    const int b = brow >> 12, s0 = brow & 4095, h0 = bcol >> 7;
#pragma unroll
    for (int i = 0; i < 8; ++i) {
      const int chunk = i * 512 + tid, row = chunk >> 4, c8 = (chunk & 15) * 8;
      uint4 v = lds_ld4(stb + row * KST_PITCH + c8);
      *(uint4*)(p.Kc + ((size_t)((b * 8 + h0 + (c8 >> 6)) * 4096 + s0 + row)) * 96 + (c8 & 63)) = v;
    }
#pragma unroll
    for (int i = 0; i < 8; ++i) {
      const int chunk = i * 512 + tid, vrow = chunk >> 5, s8 = (chunk & 31) * 8;
      uint4 v = lds_ld4((LAS bf16*)(lds + VT_OFF) + vrow * VT_PITCH + s8);
      *(uint4*)(p.Vt + ((size_t)((b * 8 + h0 + (vrow >> 6)) * 64 + (vrow & 63))) * 4096 + s0 + s8) = v;
    }
  } else if (EPI == EPI_Q) {
    const int b = brow >> 12, s0 = brow & 4095;
#pragma unroll
    for (int i = 0; i < 16; ++i) {
      const int chunk = i * 512 + tid, row = chunk >> 5, c8 = (chunk & 31) * 8;
      uint4 v = lds_ld4(stb + row * STB_PITCH + c8);
      const int cg = bcol + c8, hq = cg / 96, d = cg - hq * 96;
      *(uint4*)(p.Q + ((size_t)((b * 8 + hq) * 4096 + s0 + row)) * 96 + d) = v;
    }
  } else if (EPI == EPI_INPROJ) {
    if (bcol < 512) {
      const int b = brow >> 12, c0 = (brow & 4095) >> 6, g0 = bcol >> 4;
#pragma unroll
      for (int i = 0; i < 16; ++i) {
        const int q = i * 512 + tid, hh = q & 1, j = (q >> 1) & 63, cl = (q >> 7) & 3, gl = q >> 9;
        uint4 v = lds_ld4(stb + (cl * 64 + j) * STB_PITCH + gl * 16 + hh * 8);
        *(uint4*)(p.Ag + ((size_t)((g0 + gl) * 1024 + b * 64 + c0 + cl)) * 1152 + j * 16 + hh * 8) = v;
      }
    } else {
#pragma unroll
      for (int i = 0; i < 16; ++i) {
        const int chunk = i * 512 + tid, row = chunk >> 5, c8 = (chunk & 31) * 8;
        const int cg = bcol + c8;
        float ss = 0.f;
        if (cg >= 1152 && cg < 1184) {
          uint4 v = lds_ld4(stb + row * STB_PITCH + c8);
          const int grow = brow + row, bq = grow >> 12, sq = grow & 4095;
#pragma unroll
          for (int h = 0; h < 8; ++h)
            *(uint4*)(p.Kc + ((size_t)((bq * 8 + h) * 4096 + sq)) * 96 + 64 + (cg - 1152)) = v;
        }
        if (cg < 1152) {
          uint4 v = lds_ld4(stb + row * STB_PITCH + c8);
          if (cg < 896) *(uint4*)(p.qlat + (size_t)(brow + row) * 384 + (cg - 512)) = v;
          else *(uint4*)(p.kvlat + (size_t)(brow + row) * 256 + (cg - 896)) = v;
          ss = sq2(v.x) + sq2(v.y) + sq2(v.z) + sq2(v.w);
        }
#pragma unroll
        for (int o = 8; o >= 1; o >>= 1) ss += __shfl_xor(ss, o);
        if ((tid & 15) == 0 && cg < 1152) atomicAdd((cg < 896 ? p.rss_q : p.rss_kv) + brow + row, ss);
      }
    }
  }
  EPI_BAR;
}

template <int EPI, int PRE>
__device__ __forceinline__ void gemm256(const P& p, const bf16* __restrict__ A, int lda, const bf16* __restrict__ Bt,
                                        int ldb, int K, int brow, int bcol, LAS unsigned char* lds) {
  const int tid = otid(), wid = __builtin_amdgcn_readfirstlane(tid >> 6), lane = tid & 63, wr = wid >> 2,
            wc = wid & 3, fr = lane & 15, fq = lane >> 4;
  const int nt = K / 64;
  if (EPI == EPI_Q || EPI == EPI_KV || EPI == EPI_FF1 || EPI == EPI_OUT) {
    const float* r0 = (EPI == EPI_Q) ? p.rss_q : (EPI == EPI_KV) ? p.rss_kv : (EPI == EPI_FF1) ? p.rss_x : p.rss_a;
    if (wid < 4) {
      __builtin_amdgcn_global_load_lds((const unsigned*)(r0 + brow + wid * 64 + lane), (LAS unsigned*)(lds + RS_OFF + wid * 256), 4, 0, 0);
    } else if (EPI == EPI_OUT) {
      __builtin_amdgcn_global_load_lds((const unsigned*)(p.rss_s + brow + (wid - 4) * 64 + lane), (LAS unsigned*)(lds + RS_OFF + 1024 + (wid - 4) * 256), 4, 0, 0);
    } else if (EPI == EPI_FF1) {
      __builtin_amdgcn_global_load_lds((const unsigned*)(p.biasff + (brow >> 12) * 4096 + bcol + (wid - 4) * 64 + lane), (LAS unsigned*)(lds + RS_OFF + 1024 + (wid - 4) * 256), 4, 0, 0);
    }
  }
  int R0, C0, R1, C1;
  stage_rc(tid * 16, R0, C0);
  stage_rc(tid * 16 + 8192, R1, C1);
  const unsigned voA0 = (unsigned)(R0 * lda + C0) * 2u, voA1 = (unsigned)(R1 * lda + C1) * 2u;
  const unsigned voB0 = (unsigned)(R0 * ldb + C0) * 2u, voB1 = (unsigned)(R1 * ldb + C1) * 2u;
  const char* Abase = (const char*)(A + (size_t)brow * lda);
  const char* Bbase = (const char*)(Bt + (size_t)bcol * ldb);
  const size_t ahalf = (size_t)128 * lda * 2, bhalf = (size_t)128 * ldb * 2;
  const unsigned ldsw = (unsigned)wid * 1024u;
  const int aoff = lds_byte(wr * 64 + fr, fq * 8), boff = lds_byte(wc * 32 + fr, fq * 8);
#define G_SA(b, h) (((b) * 2 + (h)) * 16384)
#define G_SB(b, h) ((4 + (b) * 2 + (h)) * 16384)
#define G_STA(b, h, kt) do { const char* gb_ = Abase + (h) * ahalf + (size_t)(kt) * 128; \
    __builtin_amdgcn_global_load_lds((const unsigned*)(gb_ + voA0), (LAS unsigned*)(lds + G_SA(b, h) + ldsw), 16, 0, 0); \
    __builtin_amdgcn_global_load_lds((const unsigned*)(gb_ + voA1), (LAS unsigned*)(lds + G_SA(b, h) + ldsw + 8192), 16, 0, 0); } while (0)
#define G_STB(b, h, kt) do { const char* gb_ = Bbase + (h) * bhalf + (size_t)(kt) * 128; \
    __builtin_amdgcn_global_load_lds((const unsigned*)(gb_ + voB0), (LAS unsigned*)(lds + G_SB(b, h) + ldsw), 16, 0, 0); \
    __builtin_amdgcn_global_load_lds((const unsigned*)(gb_ + voB1), (LAS unsigned*)(lds + G_SB(b, h) + ldsw + 8192), 16, 0, 0); } while (0)
#define G_LDA(dst, b, h) do { _Pragma("unroll") for (int m = 0; m < 4; ++m) _Pragma("unroll") for (int k = 0; k < 2; ++k) \
    dst[m][k] = *(const LAS bf16x8*)(lds + G_SA(b, h) + aoff + m * 2048 + k * 1024); } while (0)
#define G_LDB(dst, b, h) do { _Pragma("unroll") for (int n = 0; n < 2; ++n) _Pragma("unroll") for (int k = 0; k < 2; ++k) \
    dst[n][k] = *(const LAS bf16x8*)(lds + G_SB(b, h) + boff + n * 2048 + k * 1024); } while (0)
#define G_MMA(ai, bj, At_, Bt_) do { __builtin_amdgcn_s_setprio(1); \
    _Pragma("unroll") for (int m = 0; m < 4; ++m) _Pragma("unroll") for (int n = 0; n < 2; ++n) _Pragma("unroll") for (int k = 0; k < 2; ++k) \
      acc[ai][bj][m][n] = __builtin_amdgcn_mfma_f32_16x16x32_bf16(Bt_[n][k], At_[m][k], acc[ai][bj][m][n], 0, 0, 0); \
    __builtin_amdgcn_s_setprio(0); } while (0)
#define G_WV(n) asm volatile("s_waitcnt vmcnt(" #n ")" ::: "memory")
#define G_WL(n) asm volatile("s_waitcnt lgkmcnt(" #n ")" ::: "memory")
#define G_BAR __builtin_amdgcn_s_barrier()
#define G_SCHED __builtin_amdgcn_sched_barrier(0)

  f32x4 acc[2][2][4][2];
#pragma unroll
  for (int a = 0; a < 2; ++a)
#pragma unroll
    for (int b = 0; b < 2; ++b)
#pragma unroll
      for (int m = 0; m < 4; ++m)
#pragma unroll
        for (int n = 0; n < 2; ++n) acc[a][b][m][n] = (f32x4){0.f, 0.f, 0.f, 0.f};
  bf16x8 At[4][2], B0[2][2], B1[2][2];

  G_STB(0, 0, 0); G_STA(0, 0, 0); G_STB(0, 1, 0); G_STA(0, 1, 0);
  if (wr == 1) G_BAR;
  G_WV(4); G_BAR;
  G_STB(1, 0, 1); G_STA(1, 0, 1); G_STB(1, 1, 1);
  G_WV(6); G_BAR;
  const int tmid = (PRE == 2) ? 8 : (nt - 2);
  for (int t = 0; t < tmid; t += 2) {
    G_LDB(B0, 0, 0); G_SCHED; G_LDA(At, 0, 0); G_STA(1, 1, t + 1);
    G_WL(8); G_BAR; G_WL(0); G_MMA(0, 0, At, B0); G_BAR; G_SCHED;
    G_LDB(B1, 0, 1); G_STB(0, 0, t + 2);
    G_BAR; G_WL(0); G_MMA(0, 1, At, B1); G_BAR;
    G_LDA(At, 0, 1); G_STA(0, 0, t + 2);
    G_BAR; G_WL(0); G_MMA(1, 0, At, B0); G_BAR; G_SCHED;
    G_STB(0, 1, t + 2);
    G_WV(6); G_BAR; G_MMA(1, 1, At, B1); G_BAR;
    G_LDB(B0, 1, 0); G_SCHED; G_LDA(At, 1, 0); G_STA(0, 1, t + 2);
    G_WL(8); G_BAR; G_WL(0); G_MMA(0, 0, At, B0); G_BAR; G_SCHED;
    G_LDB(B1, 1, 1); G_STB(1, 0, t + 3);
    G_BAR; G_WL(0); G_MMA(0, 1, At, B1); G_BAR;
    G_LDA(At, 1, 1); G_STA(1, 0, t + 3);
    G_BAR; G_WL(0); G_MMA(1, 0, At, B0); G_BAR; G_SCHED;
    G_STB(1, 1, t + 3);
    G_WV(6); G_BAR; G_MMA(1, 1, At, B1); G_BAR;
    }
  if (PRE == 2) {
    const int tid2 = otid(), wr2 = __builtin_amdgcn_readfirstlane(tid2 >> 8), fr2 = tid2 & 15;
#pragma unroll
    for (int a = 0; a < 2; ++a)
#pragma unroll
      for (int m = 0; m < 4; ++m) {
        const int rl = a * 128 + wr2 * 64 + m * 16 + fr2;
        LAS float* rsl = (LAS float*)(lds + RS_OFF);
        const float f = rsqrtf(rsl[256 + rl] * (1.f / 512.f) + EPSN) / rsqrtf(rsl[rl] * (1.f / 512.f) + EPSN);
#pragma unroll
        for (int b = 0; b < 2; ++b)
#pragma unroll
          for (int n = 0; n < 2; ++n) acc[a][b][m][n] *= f;
      }
  }
  if (PRE == 2) {
  for (int t = 8; t < nt - 2; t += 2) {
    G_LDB(B0, 0, 0); G_SCHED; G_LDA(At, 0, 0); G_STA(1, 1, t + 1);
    G_WL(8); G_BAR; G_WL(0); G_MMA(0, 0, At, B0); G_BAR; G_SCHED;
    G_LDB(B1, 0, 1); G_STB(0, 0, t + 2);
    G_BAR; G_WL(0); G_MMA(0, 1, At, B1); G_BAR;
    G_LDA(At, 0, 1); G_STA(0, 0, t + 2);
    G_BAR; G_WL(0); G_MMA(1, 0, At, B0); G_BAR; G_SCHED;
    G_STB(0, 1, t + 2);
    G_WV(6); G_BAR; G_MMA(1, 1, At, B1); G_BAR;
    G_LDB(B0, 1, 0); G_SCHED; G_LDA(At, 1, 0); G_STA(0, 1, t + 2);
    G_WL(8); G_BAR; G_WL(0); G_MMA(0, 0, At, B0); G_BAR; G_SCHED;
    G_LDB(B1, 1, 1); G_STB(1, 0, t + 3);
    G_BAR; G_WL(0); G_MMA(0, 1, At, B1); G_BAR;
    G_LDA(At, 1, 1); G_STA(1, 0, t + 3);
    G_BAR; G_WL(0); G_MMA(1, 0, At, B0); G_BAR; G_SCHED;
    G_STB(1, 1, t + 3);
    G_WV(6); G_BAR; G_MMA(1, 1, At, B1); G_BAR;
    }
  }
  {
    G_LDB(B0, 0, 0); G_LDA(At, 0, 0); G_STA(1, 1, nt - 1);
    G_BAR; G_WL(0); G_MMA(0, 0, At, B0); G_BAR;
    G_LDB(B1, 0, 1); G_BAR; G_WL(0); G_MMA(0, 1, At, B1); G_BAR;
    G_LDA(At, 0, 1); G_WV(4); G_BAR; G_WL(0); G_MMA(1, 0, At, B0); G_MMA(1, 1, At, B1); G_BAR;
  }
  {
    G_LDB(B0, 1, 0); G_LDA(At, 1, 0); G_WV(2); G_BAR; G_WL(0); G_MMA(0, 0, At, B0); G_BAR;
    G_LDB(B1, 1, 1); G_WV(0); G_BAR; G_WL(0); G_MMA(0, 1, At, B1); G_BAR;
    G_LDA(At, 1, 1); G_BAR; G_WL(0); G_MMA(1, 0, At, B0); G_MMA(1, 1, At, B1); G_BAR;
  }
  if (wr == 0) G_BAR;

  epi256<EPI>(p, acc, brow, bcol, lds);
}

template <int EPI, int PRE>
__device__ __forceinline__ void gemm256_phase(const P& p, const bf16* A, int lda, const bf16* Bt, int ldb, int K,
                                              int NN, int bid, int nb, LAS unsigned char* lds) {
  if (nb == 256) {
    const int x = bid & 7, j = bid >> 3;
    for (int k = 0; k < NN; ++k) {
      int L = j + 32 * k;
      int mt = x * 32 + L / NN, nt = L % NN;
      if (NN == 16) { mt = x * 32 + (k >> 2) * 8 + (j & 7); nt = (k & 3) * 4 + (j >> 3); }
      gemm256<EPI, PRE>(p, A, lda, Bt, ldb, K, mt * 256, nt * 256, lds);
    }
  } else {
    for (int it = bid; it < 256 * NN; it += nb) gemm256<EPI, PRE>(p, A, lda, Bt, ldb, K, (it / NN) * 256, (it % NN) * 256, lds);
  }
}

#define KSTR 104
#define VSTR 68
#define ATT_BUF (64 * KSTR + 64 * VSTR)

__device__ __forceinline__ void att_qk(const bf16* Kb, const bf16x8 (&qf)[6], int qi, int half, f32x16& s0, f32x16& s1) {
#pragma unroll
  for (int r = 0; r < 16; ++r) { s0[r] = 0.f; s1[r] = 0.f; }
#pragma unroll
  for (int ks = 0; ks < 6; ++ks) {
    bf16x8 a0 = *(const bf16x8*)(Kb + qi * KSTR + ks * 16 + half * 8);
    bf16x8 a1 = *(const bf16x8*)(Kb + (32 + qi) * KSTR + ks * 16 + half * 8);
    s0 = __builtin_amdgcn_mfma_f32_32x32x16_bf16(a0, qf[ks], s0, 0, 0, 0);
    s1 = __builtin_amdgcn_mfma_f32_32x32x16_bf16(a1, qf[ks], s1, 0, 0, 0);
  }
}

__device__ __forceinline__ void att_softmax_pv(const bf16* Vb, f32x16& s0, f32x16& s1, f32x16& o0, f32x16& o1,
                                               float& mrun, float& lsum, int qi, int half, bool domask, int kbase,
                                               int qpos) {
  if (domask) {
#pragma unroll
    for (int r = 0; r < 16; ++r) {
      int key = kbase + (r >> 2) * 8 + half * 4 + (r & 3);
      if (key > qpos) s0[r] = -INFINITY;
      if (key + 32 > qpos) s1[r] = -INFINITY;
    }
  }
  float mt_ = s0[0];
#pragma unroll
  for (int r = 1; r < 16; ++r) mt_ = fmaxf(mt_, s0[r]);
#pragma unroll
  for (int r = 0; r < 16; ++r) mt_ = fmaxf(mt_, s1[r]);
  mt_ = fmaxf(mt_, __shfl_xor(mt_, 32));
  const float mnew = fmaxf(mrun, mt_);
  const float alpha = __builtin_amdgcn_exp2f(mrun - mnew);
  mrun = mnew;
  float ps = 0.f;
#pragma unroll
  for (int r = 0; r < 16; ++r) { s0[r] = __builtin_amdgcn_exp2f(s0[r] - mnew); ps += s0[r]; }
#pragma unroll
  for (int r = 0; r < 16; ++r) { s1[r] = __builtin_amdgcn_exp2f(s1[r] - mnew); ps += s1[r]; }
  lsum = lsum * alpha + ps;
#pragma unroll
  for (int r = 0; r < 16; ++r) { o0[r] *= alpha; o1[r] *= alpha; }
#pragma unroll
  for (int kk = 0; kk < 4; ++kk) {
    unsigned pk[4];
#pragma unroll
    for (int j = 0; j < 4; ++j) {
      float a = (kk < 2) ? s0[(kk & 1) * 8 + 2 * j] : s1[(kk & 1) * 8 + 2 * j];
      float b = (kk < 2) ? s0[(kk & 1) * 8 + 2 * j + 1] : s1[(kk & 1) * 8 + 2 * j + 1];
      pk[j] = pack2(a, b);
    }
    bf16x8 pb = __builtin_bit_cast(bf16x8, make_uint4(pk[0], pk[1], pk[2], pk[3]));
    const bf16* v0p = Vb + qi * VSTR + kk * 16 + half * 4;
    const bf16* v1p = Vb + (32 + qi) * VSTR + kk * 16 + half * 4;
    uint2 a0l = *(const uint2*)(v0p), a0h = *(const uint2*)(v0p + 8);
    uint2 a1l = *(const uint2*)(v1p), a1h = *(const uint2*)(v1p + 8);
    bf16x8 av0 = __builtin_bit_cast(bf16x8, make_uint4(a0l.x, a0l.y, a0h.x, a0h.y));
    bf16x8 av1 = __builtin_bit_cast(bf16x8, make_uint4(a1l.x, a1l.y, a1h.x, a1h.y));
    o0 = __builtin_amdgcn_mfma_f32_32x32x16_bf16(av0, pb, o0, 0, 0, 0);
    o1 = __builtin_amdgcn_mfma_f32_32x32x16_bf16(av1, pb, o1, 0, 0, 0);
  }
}

__device__ __forceinline__ void attn_item(const P& p, int bh, int qt, char* smem) {
  bf16* Ks = (bf16*)smem;
  const int t = otid() & 255, w = __builtin_amdgcn_readfirstlane(t >> 6), l = t & 63, qi = l & 31, half = l >> 5;
  const int q0 = qt * 128, wq0 = q0 + w * 32;
  const bf16* Qp = p.Q + ((size_t)bh * 4096 + wq0 + qi) * 96;
  bf16x8 qf[6];
#pragma unroll
  for (int ks = 0; ks < 6; ++ks) qf[ks] = *(const bf16x8*)(Qp + ks * 16 + half * 8);
  asm volatile("s_waitcnt vmcnt(0)" ::: "memory");
#pragma unroll
  for (int ks = 0; ks < 6; ++ks) asm volatile("" : "+v"(qf[ks]));
  const bf16* Kg = p.Kc + (size_t)bh * 4096 * 96;
  const bf16* Vg = p.Vt + (size_t)bh * 64 * 4096;
  const int nkt = 2 * qt + 2, nfull = 2 * qt;

  const int kr0r = t / 12, kr0c = t - kr0r * 12;
  const int kr1r = (t + 256) / 12, kr1c = (t + 256) - kr1r * 12;
  const int kr2r = (t + 512) / 12, kr2c = (t + 512) - kr2r * 12;
  const int vrow = t >> 3, vkc = t & 7;
  const bf16* kg0 = Kg + (size_t)kr0r * 96 + kr0c * 8;
  const bf16* kg1 = Kg + (size_t)kr1r * 96 + kr1c * 8;
  const bf16* kg2 = Kg + (size_t)kr2r * 96 + kr2c * 8;
  const bf16* vg0 = Vg + (size_t)vrow * 4096 + vkc * 8;
  const bf16* vg1 = Vg + (size_t)(vrow + 32) * 4096 + vkc * 8;
  const int ks0 = kr0r * KSTR + kr0c * 8, ks1 = kr1r * KSTR + kr1c * 8, ks2 = kr2r * KSTR + kr2c * 8;
  const int vs0 = 64 * KSTR + vrow * VSTR + vkc * 8, vs1 = 64 * KSTR + (vrow + 32) * VSTR + vkc * 8;
  uint4 kra, krb, krc, vra, vrb;
#define ATT_GLOAD(kt_) do { kra = *(const uint4*)(kg0 + (size_t)(kt_) * 64 * 96); krb = *(const uint4*)(kg1 + (size_t)(kt_) * 64 * 96); \
    krc = *(const uint4*)(kg2 + (size_t)(kt_) * 64 * 96); vra = *(const uint4*)(vg0 + (kt_) * 64); vrb = *(const uint4*)(vg1 + (kt_) * 64); } while (0)
#define ATT_LSTORE(buf_) do { bf16* kb_ = Ks + (buf_) * ATT_BUF; \
    *(uint4*)(kb_ + ks0) = kra; *(uint4*)(kb_ + ks1) = krb; *(uint4*)(kb_ + ks2) = krc; \
    ((uint2*)(kb_ + vs0))[0] = make_uint2(vra.x, vra.y); ((uint2*)(kb_ + vs0))[1] = make_uint2(vra.z, vra.w); \
    ((uint2*)(kb_ + vs1))[0] = make_uint2(vrb.x, vrb.y); ((uint2*)(kb_ + vs1))[1] = make_uint2(vrb.z, vrb.w); } while (0)
  ATT_GLOAD(0);
  ATT_LSTORE(0);
  ATT_GLOAD(1);
  ATT_LSTORE(1);
  __syncthreads();

  f32x16 o0, o1, sc0, sc1, sn0, sn1;
#pragma unroll
  for (int r = 0; r < 16; ++r) { o0[r] = 0.f; o1[r] = 0.f; sn0[r] = 0.f; sn1[r] = 0.f; }
  float mrun = -INFINITY, lsum = 0.f;
  const int qpos = wq0 + qi;
  att_qk(Ks, qf, qi, half, sc0, sc1);
  int bc = 0, bn = 1, bnn = 2;
  int kt = 0;
  for (; kt < nfull - 1; ++kt) {
    ATT_GLOAD(kt + 2);
    att_qk(Ks + bn * ATT_BUF, qf, qi, half, sn0, sn1);
    att_softmax_pv(Ks + bc * ATT_BUF + 64 * KSTR, sc0, sc1, o0, o1, mrun, lsum, qi, half, false, 0, qpos);
    ATT_LSTORE(bnn);
    __syncthreads();
    sc0 = sn0; sc1 = sn1;
    { int tb = bc; bc = bn; bn = bnn; bnn = tb; }
  }
  for (; kt < nkt; ++kt) {
    const bool more2 = (kt + 2 < nkt);
    if (more2) ATT_GLOAD(kt + 2);
    const bool need_next = (kt + 1 < nkt) && ((kt + 1) * 64 <= wq0 + 31);
    if (need_next) att_qk(Ks + bn * ATT_BUF, qf, qi, half, sn0, sn1);
    if (kt * 64 <= wq0 + 31)
      att_softmax_pv(Ks + bc * ATT_BUF + 64 * KSTR, sc0, sc1, o0, o1, mrun, lsum, qi, half, (kt * 64 + 63 > wq0), kt * 64, qpos);
    if (more2) ATT_LSTORE(bnn);
    __syncthreads();
    sc0 = sn0; sc1 = sn1;
    { int tb = bc; bc = bn; bn = bnn; bnn = tb; }
  }
  const float ltot = lsum + __shfl_xor(lsum, 32);
  const float inv = 1.f / ltot;
  const int b = bh >> 3, h = bh & 7;
  bf16* op = p.ycat + ((size_t)(b * 4096 + wq0 + qi)) * 1024 + 512 + h * 64 + half * 4;
  {
    float ss = 0.f;
#pragma unroll
    for (int r = 0; r < 16; ++r) { float a0 = o0[r] * inv, a1 = o1[r] * inv; ss += a0 * a0 + a1 * a1; }
    ss += __shfl_xor(ss, 32);
    if (half == 0) atomicAdd(p.rss_a + b * 4096 + wq0 + qi, ss);
  }
#pragma unroll
  for (int rg = 0; rg < 4; ++rg) {
    uint2 v0, v1;
    v0.x = pack2(o0[rg * 4 + 0] * inv, o0[rg * 4 + 1] * inv);
    v0.y = pack2(o0[rg * 4 + 2] * inv, o0[rg * 4 + 3] * inv);
    v1.x = pack2(o1[rg * 4 + 0] * inv, o1[rg * 4 + 1] * inv);
    v1.y = pack2(o1[rg * 4 + 2] * inv, o1[rg * 4 + 3] * inv);
    *(uint2*)(op + rg * 8) = v0;
    *(uint2*)(op + 32 + rg * 8) = v1;
  }
}

#define A2_STAGE 20480
#define A2_VOFF 12288
#define A2_NST 6

__device__ __forceinline__ void a2_qk(LAS unsigned char* st, const bf16x8 (&qf)[6], int qi, int half, f32x16& s0, f32x16& s1,
                                      float init = 0.f) {
#pragma unroll
  for (int r = 0; r < 16; ++r) { s0[r] = init; s1[r] = init; }
  bf16x8 a0[6], a1[6];
#pragma unroll
  for (int ks = 0; ks < 6; ++ks) {
    a0[ks] = *(const LAS bf16x8*)(st + ks * 2048 + qi * 32 + half * 16);
    a1[ks] = *(const LAS bf16x8*)(st + ks * 2048 + (32 + qi) * 32 + half * 16);
  }
  __builtin_amdgcn_sched_barrier(0);
  __builtin_amdgcn_s_setprio(1);
#pragma unroll
  for (int ks = 0; ks < 6; ++ks) {
    s0 = __builtin_amdgcn_mfma_f32_32x32x16_bf16(a0[ks], qf[ks], s0, 0, 0, 0);
    s1 = __builtin_amdgcn_mfma_f32_32x32x16_bf16(a1[ks], qf[ks], s1, 0, 0, 0);
  }
  __builtin_amdgcn_s_setprio(0);
}

__device__ __forceinline__ float xhalf_max(float x) {
  typedef __attribute__((ext_vector_type(2))) unsigned u2_t;
  const unsigned xi = __float_as_uint(x);
  u2_t r = __builtin_amdgcn_permlane32_swap(xi, xi, false, false);
  return fmaxf(__uint_as_float(r[0]), __uint_as_float(r[1]));
}
__device__ __forceinline__ void a2_mask(f32x16& s0, f32x16& s1, int half, int kbase, int qpos) {
#pragma unroll
  for (int r = 0; r < 16; ++r) {
    int key = kbase + (r >> 2) * 8 + half * 4 + (r & 3);
    if (key > qpos) s0[r] = -INFINITY;
    if (key + 32 > qpos) s1[r] = -INFINITY;
  }
}
__device__ __forceinline__ float a2_lanemax(const f32x16& s0, const f32x16& s1) {
  float m = s0[0];
#pragma unroll
  for (int r = 1; r < 16; ++r) m = fmaxf(m, s0[r]);
#pragma unroll
  for (int r = 0; r < 16; ++r) m = fmaxf(m, s1[r]);
  return m;
}
__device__ __forceinline__ void a2_update(float mt_, float& mrun, float& lsum, f32x16& o0, f32x16& o1) {
  mt_ = xhalf_max(mt_);
  if (__builtin_amdgcn_ballot_w64(mt_ > mrun + 8.f) != 0) {
    const float mnew = fmaxf(mrun, mt_);
    const float alpha = __builtin_amdgcn_exp2f(mrun - mnew);
    mrun = mnew;
    lsum *= alpha;
#pragma unroll
    for (int r = 0; r < 16; ++r) { o0[r] *= alpha; o1[r] *= alpha; }
  }
}
__device__ __forceinline__ bool a2_update_off(float mt_, bool first, float& moff, float& lsum, f32x16& o0, f32x16& o1,
                                              float& delta) {
  mt_ = xhalf_max(mt_);
  delta = 0.f;
  if (first || __builtin_amdgcn_ballot_w64(mt_ > 8.f) != 0) {
    delta = first ? mt_ : fmaxf(mt_, 0.f);
    if (!first) {
      const float alpha = __builtin_amdgcn_exp2f(-delta);
      lsum *= alpha;
#pragma unroll
      for (int r = 0; r < 16; ++r) { o0[r] *= alpha; o1[r] *= alpha; }
    }
    moff += delta;
    return true;
  }
  return false;
}
__device__ __forceinline__ float a2_exp0(f32x16& s0, f32x16& s1) {
  typedef __attribute__((ext_vector_type(2))) float f32x2_t;
  f32x2_t ps2 = {0.f, 0.f};
#pragma unroll
  for (int r = 0; r < 16; ++r) s0[r] = __builtin_amdgcn_exp2f(s0[r]);
#pragma unroll
  for (int r = 0; r < 16; ++r) s1[r] = __builtin_amdgcn_exp2f(s1[r]);
#pragma unroll
  for (int r = 0; r < 8; ++r) {
    ps2 += (f32x2_t){s0[2 * r], s0[2 * r + 1]};
    ps2 += (f32x2_t){s1[2 * r], s1[2 * r + 1]};
  }
  return ps2[0] + ps2[1];
}
__device__ __forceinline__ float a2_exp(f32x16& s0, f32x16& s1, float mrun) {
  float ps = 0.f;
#pragma unroll
  for (int r = 0; r < 16; ++r) { s0[r] = __builtin_amdgcn_exp2f(s0[r] - mrun); ps += s0[r]; }
#pragma unroll
  for (int r = 0; r < 16; ++r) { s1[r] = __builtin_amdgcn_exp2f(s1[r] - mrun); ps += s1[r]; }
  return ps;
}
struct A2V { u32x2 vl0[4], vh0[4], vl1[4], vh1[4]; };
__device__ __forceinline__ void a2_vload(LAS unsigned char* vst, int qi, int half, A2V& f) {
  const int sw = (qi >> 1) & 7;
  LAS unsigned char* v0row = vst + qi * 128 + half * 8;
  LAS unsigned char* v1row = vst + (32 + qi) * 128 + half * 8;
#pragma unroll
  for (int kk = 0; kk < 4; ++kk) {
    const int olo = ((kk * 2) ^ sw) * 16, ohi = ((kk * 2 + 1) ^ sw) * 16;
    f.vl0[kk] = *(const LAS u32x2*)(v0row + olo); f.vh0[kk] = *(const LAS u32x2*)(v0row + ohi);
    f.vl1[kk] = *(const LAS u32x2*)(v1row + olo); f.vh1[kk] = *(const LAS u32x2*)(v1row + ohi);
  }
}
__device__ __forceinline__ void a2_pv(const A2V& f, const f32x16& s0, const f32x16& s1, f32x16& o0, f32x16& o1) {
  __builtin_amdgcn_s_setprio(1);
#pragma unroll
  for (int kk = 0; kk < 4; ++kk) {
    unsigned pk[4];
#pragma unroll
    for (int j = 0; j < 4; ++j) {
      float a = (kk < 2) ? s0[(kk & 1) * 8 + 2 * j] : s1[(kk & 1) * 8 + 2 * j];
      float b = (kk < 2) ? s0[(kk & 1) * 8 + 2 * j + 1] : s1[(kk & 1) * 8 + 2 * j + 1];
      pk[j] = pack2(a, b);
    }
    bf16x8 pb = __builtin_bit_cast(bf16x8, make_uint4(pk[0], pk[1], pk[2], pk[3]));
    bf16x8 av0 = __builtin_bit_cast(bf16x8, make_uint4(f.vl0[kk][0], f.vl0[kk][1], f.vh0[kk][0], f.vh0[kk][1]));
    bf16x8 av1 = __builtin_bit_cast(bf16x8, make_uint4(f.vl1[kk][0], f.vl1[kk][1], f.vh1[kk][0], f.vh1[kk][1]));
    o0 = __builtin_amdgcn_mfma_f32_32x32x16_bf16(av0, pb, o0, 0, 0, 0);
    o1 = __builtin_amdgcn_mfma_f32_32x32x16_bf16(av1, pb, o1, 0, 0, 0);
  }
  __builtin_amdgcn_s_setprio(0);
}
__device__ __forceinline__ void a2_softmax_pv(LAS unsigned char* vst, f32x16& s0, f32x16& s1, f32x16& o0, f32x16& o1,
                                              float& moff, float& lsum, int qi, int half, bool domask, int kbase,
                                              int qpos, bool first) {
  A2V f;
  a2_vload(vst, qi, half, f);
  __builtin_amdgcn_sched_barrier(0);
  if (domask) a2_mask(s0, s1, half, kbase, qpos);
  float delta;
  if (a2_update_off(a2_lanemax(s0, s1), first, moff, lsum, o0, o1, delta)) {
#pragma unroll
    for (int r = 0; r < 16; ++r) { s0[r] -= delta; s1[r] -= delta; }
  }
  lsum += a2_exp0(s0, s1);
  a2_pv(f, s0, s1, o0, o1);
}
__device__ __forceinline__ void a2_softmax_pv2(LAS unsigned char* vstA, LAS unsigned char* vstB, f32x16& a0, f32x16& a1,
                                               f32x16& b0, f32x16& b1, f32x16& o0, f32x16& o1, float& moff,
                                               float& lsum, int qi, int half, bool first) {
  A2V f;
  a2_vload(vstA, qi, half, f);
  __builtin_amdgcn_sched_barrier(0);
  float delta;
  if (a2_update_off(fmaxf(a2_lanemax(a0, a1), a2_lanemax(b0, b1)), first, moff, lsum, o0, o1, delta)) {
#pragma unroll
    for (int r = 0; r < 16; ++r) { a0[r] -= delta; a1[r] -= delta; b0[r] -= delta; b1[r] -= delta; }
  }
  lsum += a2_exp0(a0, a1);
  a2_pv(f, a0, a1, o0, o1);
  a2_vload(vstB, qi, half, f);
  lsum += a2_exp0(b0, b1);
  a2_pv(f, b0, b1, o0, o1);
}

__device__ __forceinline__ void attn256_item(const P& p, int bh, int qt, LAS unsigned char* lds, bool do_atomic = true) {
  const int t = otid(), w = __builtin_amdgcn_readfirstlane(t >> 6), l = t & 63, qi = l & 31, half = l >> 5;
  const int q0 = qt * 256, wq0 = q0 + w * 32;
  const bf16* Qp = p.Q + ((size_t)bh * 4096 + wq0 + qi) * 96;
  bf16x8 qf[6];
  const char* Kg = (const char*)(p.Kc + (size_t)bh * 4096 * 96);
  const char* Vg = (const char*)(p.Vt + (size_t)bh * 64 * 4096);
  const int nkt = 4 * qt + 4, nfull = 4 * qt;

  const int p2 = 512 + (t & 255);
  const unsigned ko1 = (unsigned)((((t >> 1) & 63) * 96 + ((t >> 7) * 2 + (t & 1)) * 8) * 2);
  const unsigned ko2 = (unsigned)((((p2 >> 1) & 63) * 96 + ((p2 >> 7) * 2 + (p2 & 1)) * 8) * 2);
  const int vdv = t >> 3;
  const unsigned vo = (unsigned)((vdv * 4096 + (((t & 7) ^ ((vdv >> 1) & 7)) * 8)) * 2);
  const unsigned ldsw = (unsigned)w * 1024u;
#define A2_ISSUE(kt_, st_) do { \
    const char* kb_ = Kg + (size_t)(kt_) * (64 * 96 * 2); const char* vb_ = Vg + (size_t)(kt_) * 128; \
    LAS unsigned char* sb_ = lds + (st_) * A2_STAGE; \
    __builtin_amdgcn_global_load_lds((const unsigned*)(kb_ + ko1), (LAS unsigned*)(sb_ + ldsw), 16, 0, 0); \
    if (w < 4) __builtin_amdgcn_global_load_lds((const unsigned*)(kb_ + ko2), (LAS unsigned*)(sb_ + 8192 + ldsw), 16, 0, 0); \
    __builtin_amdgcn_global_load_lds((const unsigned*)(vb_ + vo), (LAS unsigned*)(sb_ + A2_VOFF + ldsw), 16, 0, 0); } while (0)
#define A2_WAIT3 do { if (w < 4) asm volatile("s_waitcnt vmcnt(9)" ::: "memory"); else asm volatile("s_waitcnt vmcnt(6)" ::: "memory"); } while (0)
#define A2_WAIT0 asm volatile("s_waitcnt vmcnt(0)" ::: "memory")
#define A2_BAR asm volatile("s_waitcnt lgkmcnt(0)\n\ts_barrier" ::: "memory")

  A2_ISSUE(0, 0); A2_ISSUE(1, 1); A2_ISSUE(2, 2); A2_ISSUE(3, 3);
#pragma unroll
  for (int ks = 0; ks < 6; ++ks) qf[ks] = *(const bf16x8*)(Qp + ks * 16 + half * 8);
  A2_WAIT0;
#pragma unroll
  for (int ks = 0; ks < 6; ++ks) asm volatile("" : "+v"(qf[ks]));
  A2_BAR;

  f32x16 o0, o1, sa0, sa1, sb0, sb1;
#pragma unroll
  for (int r = 0; r < 16; ++r) { o0[r] = 0.f; o1[r] = 0.f; }
  float mrun = 0.f, lsum = 0.f;
  const int qpos = wq0 + qi;
  int sA = 0;
  int kt = 0;
#define A2_WAIT2 do { if (w < 4) asm volatile("s_waitcnt vmcnt(6)" ::: "memory"); else asm volatile("s_waitcnt vmcnt(4)" ::: "memory"); } while (0)
  for (; kt + 1 < nfull; kt += 2) {
    const int sI = (sA + 4 >= A2_NST) ? sA + 4 - A2_NST : sA + 4;
    A2_ISSUE(kt + 4, sI);
    A2_ISSUE(kt + 5, sI + 1);
    a2_qk(lds + sA * A2_STAGE, qf, qi, half, sa0, sa1, -mrun);
    a2_qk(lds + (sA + 1) * A2_STAGE, qf, qi, half, sb0, sb1, -mrun);
    a2_softmax_pv2(lds + sA * A2_STAGE + A2_VOFF, lds + (sA + 1) * A2_STAGE + A2_VOFF, sa0, sa1, sb0, sb1, o0, o1,
                   mrun, lsum, qi, half, kt == 0);
    A2_WAIT2;
    A2_BAR;
    sA = (sA + 2 >= A2_NST) ? 0 : sA + 2;
  }
  for (; kt < nkt; kt += 2) {
#pragma unroll
    for (int u = 0; u < 2; ++u) {
      const int k1 = kt + u;
      if (k1 * 64 <= wq0 + 31) {
        a2_qk(lds + (sA + u) * A2_STAGE, qf, qi, half, sa0, sa1, -mrun);
        a2_softmax_pv(lds + (sA + u) * A2_STAGE + A2_VOFF, sa0, sa1, o0, o1, mrun, lsum, qi, half, (k1 * 64 + 63 > wq0),
                      k1 * 64, qpos, k1 == 0);
      }
    }
    A2_WAIT0;
    A2_BAR;
    sA = (sA + 2 >= A2_NST) ? 0 : sA + 2;
  }
  const float ltot = lsum + __shfl_xor(lsum, 32);
  const float inv = 1.f / ltot;
  const int b = bh >> 3, h = bh & 7;
  bf16* op = p.ycat + ((size_t)(b * 4096 + wq0 + qi)) * 1024 + 512 + h * 64 + half * 4;
  {
    float ss = 0.f;
#pragma unroll
    for (int r = 0; r < 16; ++r) { float a0 = o0[r] * inv, a1 = o1[r] * inv; ss += a0 * a0 + a1 * a1; }
    ss += __shfl_xor(ss, 32);
    if (half == 0 && do_atomic) atomicAdd(p.rss_a + b * 4096 + wq0 + qi, ss);
  }
#pragma unroll
  for (int rg = 0; rg < 4; ++rg) {
    uint2 v0, v1;
    v0.x = pack2(o0[rg * 4 + 0] * inv, o0[rg * 4 + 1] * inv);
    v0.y = pack2(o0[rg * 4 + 2] * inv, o0[rg * 4 + 3] * inv);
    v1.x = pack2(o1[rg * 4 + 0] * inv, o1[rg * 4 + 1] * inv);
    v1.y = pack2(o1[rg * 4 + 2] * inv, o1[rg * 4 + 3] * inv);
    *(uint2*)(op + rg * 8) = v0;
    *(uint2*)(op + 32 + rg * 8) = v1;
  }
}

template <bool TOBF>
__device__ __forceinline__ void norm_rows(const P& p, const float* __restrict__ src, const float* __restrict__ g,
                                          int shift_off, int scale_off, bf16* dstb, float* dstf, int item) {
  const int t = otid() & 255, w = t >> 6, l = t & 63;
  const int row0 = item * 16 + w;
  float4 v[4][4];
  float ss[4] = {0.f, 0.f, 0.f, 0.f};
#pragma unroll
  for (int q = 0; q < 4; ++q) {
    const float4* sp = (const float4*)(src + (size_t)(row0 + 4 * q) * 1024);
#pragma unroll
    for (int i = 0; i < 4; ++i) v[q][i] = ld_nt4((const float*)(sp + i * 64 + l));
  }
#pragma unroll
  for (int q = 0; q < 4; ++q)
#pragma unroll
    for (int i = 0; i < 4; ++i)
      ss[q] += v[q][i].x * v[q][i].x + v[q][i].y * v[q][i].y + v[q][i].z * v[q][i].z + v[q][i].w * v[q][i].w;
#pragma unroll
  for (int o = 32; o >= 1; o >>= 1) {
#pragma unroll
    for (int q = 0; q < 4; ++q) ss[q] += __shfl_xor(ss[q], o);
  }
  const float* md = p.mod + (row0 >> 12) * 8192;
#pragma unroll
  for (int i = 0; i < 4; ++i) {
    const int col = i * 256 + l * 4;
    float4 gg = *(const float4*)(g + col);
    float4 sc = *(const float4*)(md + scale_off + col);
    float4 sh = *(const float4*)(md + shift_off + col);
    const float m0 = gg.x * (1.f + sc.x), m1 = gg.y * (1.f + sc.y), m2 = gg.z * (1.f + sc.z), m3 = gg.w * (1.f + sc.w);
#pragma unroll
    for (int q = 0; q < 4; ++q) {
      const float rstd = rsqrtf(ss[q] * (1.f / 1024.f) + EPSN);
      const int row = row0 + 4 * q;
      float y0 = v[q][i].x * rstd * m0 + sh.x;
      float y1 = v[q][i].y * rstd * m1 + sh.y;
      float y2 = v[q][i].z * rstd * m2 + sh.z;
      float y3 = v[q][i].w * rstd * m3 + sh.w;
      if (TOBF) {
        uint2 o; o.x = pack2(y0, y1); o.y = pack2(y2, y3);
        *(uint2*)(dstb + (size_t)row * 1024 + col) = o;
      } else {
        st_nt4(dstf + (size_t)row * 1024 + col, make_float4(y0, y1, y2, y3));
      }
    }
  }
}

__device__ __forceinline__ void mod_item(const P& p, int item, char* smem, const int mode = 0) {
  float* cnd = (float*)smem;
  float* red = (float*)(smem + 8192);
  const int t = otid() & 255;
  const int cbk = (mode == 0) ? (item & 31) : (item & 15), ksp = (mode == 0) ? (item >> 5) : (item >> 4);
  const int n0 = cbk * 256, k0 = ksp * 128;
  const float* W; int ldw; int nn0; const float* bias;
  if (mode == 1) { W = p.w_ff1; ldw = 4096; nn0 = n0; bias = nullptr; }
  else if (n0 < 6144) { W = p.ada_w; ldw = 6144; nn0 = n0; bias = p.ada_b; }
  else { W = p.fada_w; ldw = 2048; nn0 = n0 - 6144; bias = p.fada_b; }
#pragma unroll
  for (int i = 0; i < 8; ++i) {
    int idx = i * 256 + t, b = idx >> 7, kk = idx & 127;
    if (mode == 1) {
      cnd[idx] = p.mod[b * 8192 + 3072 + k0 + kk];
    } else {
      float c = p.c[b * 1024 + k0 + kk];
      cnd[idx] = c * sigmoidf(c);
    }
  }
  __syncthreads();
  const int c4 = (t & 63) * 4, kq = t >> 6;
  float4 acc[16];
#pragma unroll
  for (int b = 0; b < 16; ++b) acc[b] = make_float4(0.f, 0.f, 0.f, 0.f);
  const float* wp = W + (size_t)(k0 + kq * 32) * ldw + nn0 + c4;
  for (int kb = 0; kb < 32; kb += 8) {
    float4 w[8];
#pragma unroll
    for (int u = 0; u < 8; ++u) w[u] = *(const float4*)(wp + (size_t)(kb + u) * ldw);
    __builtin_amdgcn_sched_barrier(0);
#pragma unroll
    for (int u = 0; u < 8; ++u) {
#pragma unroll
      for (int b = 0; b < 16; ++b) {
        float cv = cnd[b * 128 + kq * 32 + kb + u];
        acc[b].x += cv * w[u].x; acc[b].y += cv * w[u].y; acc[b].z += cv * w[u].z; acc[b].w += cv * w[u].w;
      }
      __builtin_amdgcn_sched_barrier(0);
    }
  }
#pragma unroll
  for (int b = 0; b < 16; ++b) *(float4*)(red + (kq * 16 + b) * 256 + c4) = acc[b];
  __syncthreads();
#pragma unroll
  for (int i = 0; i < 16; ++i) {
    int o = i * 256 + t, b = o >> 8, c = o & 255;
    float s = red[(0 * 16 + b) * 256 + c] + red[(1 * 16 + b) * 256 + c] + red[(2 * 16 + b) * 256 + c] + red[(3 * 16 + b) * 256 + c];
    if (mode == 1) {
      atomicAdd(p.biasff + b * 4096 + n0 + c, s);
    } else {
      if (ksp == 0) s += bias[nn0 + c];
      atomicAdd(p.mod + b * 8192 + n0 + c, s);
    }
  }
  __syncthreads();
}

__device__ __forceinline__ void tr_tile(const float* __restrict__ W, int K, int N, bf16* __restrict__ Wt,
                                        const float* __restrict__ rsA, const float* __restrict__ rsB, int splitK,
                                        int glu, int kt, int ntile, char* smem) {
  float* tile = (float*)smem;
  const int t = otid() & 255;
  const int k0 = kt * 64, n0 = ntile * 64;
#pragma unroll
  for (int i = 0; i < 4; ++i) {
    int r = (t >> 4) + 16 * i, c4 = (t & 15) * 4;
    float4 v = make_float4(0.f, 0.f, 0.f, 0.f);
    if (n0 + c4 < N) v = *(const float4*)(W + (size_t)(k0 + r) * N + n0 + c4);
    float sc = 1.f;
    if (rsA) { int k = k0 + r; sc = (k < splitK) ? rsA[k] : rsB[k - splitK]; }
    tile[(c4 + 0) * 65 + r] = v.x * sc;
    tile[(c4 + 1) * 65 + r] = v.y * sc;
    tile[(c4 + 2) * 65 + r] = v.z * sc;
    tile[(c4 + 3) * 65 + r] = v.w * sc;
  }
  __syncthreads();
  {
    int n = t >> 2, ks = (t & 3) * 16;
    int no = n0 + n;
    if (glu) { int vv = (no < 512) ? no : no - 512; no = (vv >> 4) * 32 + (vv & 15) + ((no < 512) ? 0 : 16); }
    unsigned o[8];
#pragma unroll
    for (int j = 0; j < 8; ++j) o[j] = pack2(tile[n * 65 + ks + 2 * j], tile[n * 65 + ks + 2 * j + 1]);
    uint4* dp = (uint4*)(Wt + (size_t)no * K + k0 + ks);
    dp[0] = make_uint4(o[0], o[1], o[2], o[3]);
    dp[1] = make_uint4(o[4], o[5], o[6], o[7]);
  }
  __syncthreads();
}

__device__ __forceinline__ float2 cmul(float2 a, float2 b) {
  return make_float2(a.x * b.x - a.y * b.y, a.x * b.y + a.y * b.x);
}
__device__ __forceinline__ float2 lam_pow(float lre, float lim, float dt, int m) {
  float mag = __expf((float)m * lre * dt);
  float s, c;
  sincosf((float)m * lim * dt, &s, &c);
  return make_float2(mag * c, mag * s);
}
__device__ __forceinline__ float2 zoh_fac(float lre, float lim, float dt) {
  float2 lb = lam_pow(lre, lim, dt, 1);
  float nr = lb.x - 1.f, ni = lb.y;
  float den = lre * lre + lim * lim;
  return make_float2((nr * lre + ni * lim) / den, (ni * lre - nr * lim) / den);
}

__device__ __forceinline__ void ktab_item(const P& p, int item, char* smem) {
  float2* lamm = (float2*)smem;
  float2* fac = lamm + 64;
  float2* CL = fac + 64;
  float2* BB = CL + 1024;
  const int t = otid() & 255;
  const int g = item >> 6, m = item & 63;
  if (t < 64) {
    float lre = p.lam_re[g * 64 + t], lim = p.lam_im[g * 64 + t], dt = __expf(p.log_dt[g]);
    lamm[t] = lam_pow(lre, lim, dt, m);
    fac[t] = zoh_fac(lre, lim, dt);
  }
  float cr[4], ci[4], br[4], bi[4];
#pragma unroll
  for (int i = 0; i < 4; ++i) {
    const int idx = g * 1024 + i * 256 + t;
    cr[i] = p.c_re[idx]; ci[i] = p.c_im[idx]; br[i] = p.b_re[idx]; bi[i] = p.b_im[idx];
  }
  __syncthreads();
#pragma unroll
  for (int i = 0; i < 4; ++i) {
    const int idx = i * 256 + t;
    CL[idx] = cmul(make_float2(cr[i], ci[i]), lamm[idx & 63]);
    BB[idx] = cmul(fac[idx >> 4], make_float2(br[i], bi[i]));
  }
  __syncthreads();
  const int h = t >> 4, hp = t & 15;
  float s = 0.f;
#pragma unroll 8
  for (int pp = 0; pp < 64; ++pp) {
    float2 c = CL[h * 64 + pp], bq = BB[pp * 16 + hp];
    s += c.x * bq.x - c.y * bq.y;
  }
  p.ktab[((size_t)(g * 64 + m) * 16 + h) * 16 + hp] = s;
  __syncthreads();
}

#define TR_IN 320
#define TR_GLU 128
#define TR_UQ 72
#define TR_UKV 64
#define TR_OUT 256
#define TR_FF1 1024
#define TR_FF2 1024

template <int PH>
__device__ __forceinline__ void run_phase(const P& p, int bid_, int nb_, char* smem_) {
  const int hb = __builtin_amdgcn_readfirstlane((otid() >> 8));
  const int bid = bid_ * 2 + hb, nb = nb_ * 2;
  char* smem = smem_ + hb * HSMEM;
  LAS unsigned char* lds = (LAS unsigned char*)smem_;
  const int t = otid() & 255;
  if (PH == 0) {
    const int n_mod = 256;
    const int n_tr = TR_IN + TR_GLU + TR_UQ + TR_UKV + TR_OUT + TR_FF1 + TR_FF2;
    const int n_kt = 2048;
    const int n_pw = (32 * 65 * 64) / 256;
    const int n_bb = (32 * 64 * 16) / 256;
    const int n_cs = (65536 * 16) / 256;
    const int total = n_mod + n_tr + n_kt + n_pw + n_bb + n_cs;
    for (int it = bid; it < total; it += nb) {
      int i = it;
      if (i < n_mod) { mod_item(p, i, smem); continue; }
      i -= n_mod;
      if (i < n_tr) {
        if (i < TR_IN) { tr_tile(p.w_in, 1024, 1184, p.Wt_in, nullptr, nullptr, 0, 0, i % 16, i / 16, smem); continue; }
        i -= TR_IN;
        if (i < TR_GLU) { tr_tile(p.w_glu, 512, 1024, p.Wt_glu, nullptr, nullptr, 0, 1, i % 8, i / 8, smem); continue; }
        i -= TR_GLU;
        if (i < TR_UQ) { tr_tile(p.w_uq, 384, 768, p.Wt_uq, p.q_norm_g, p.q_norm_g, 384, 0, i % 6, i / 6, smem); continue; }
        i -= TR_UQ;
        if (i < TR_UKV) { tr_tile(p.w_ukv, 256, 1024, p.Wt_ukv, p.kv_norm_g, p.kv_norm_g, 256, 0, i % 4, i / 4, smem); continue; }
        i -= TR_UKV;
        if (i < TR_OUT) { tr_tile(p.w_out, 1024, 1024, p.Wt_out, p.ssm_out_g, p.attn_out_g, 512, 0, i % 16, i / 16, smem); continue; }
        i -= TR_OUT;
        if (i < TR_FF1) { tr_tile(p.w_ff1, 1024, 4096, p.Wt_ff1, nullptr, nullptr, 0, 0, i % 16, i / 16, smem); continue; }
        i -= TR_FF1;
        tr_tile(p.w_ff2, 4096, 1024, p.Wt_ff2, nullptr, nullptr, 0, 0, i % 64, i / 64, smem);
        continue;
      }
      i -= n_tr;
      if (i < n_kt) { ktab_item(p, i, smem); continue; }
      i -= n_kt;
      if (i < n_pw) {
        int idx = i * 256 + t;
        int pp = idx & 63, m = (idx >> 6) % 65, g = idx / (64 * 65);
        float dt = __expf(p.log_dt[g]);
        p.pw[idx] = lam_pow(p.lam_re[g * 64 + pp], p.lam_im[g * 64 + pp], dt, m);
        continue;
      }
      i -= n_pw;
      if (i < n_bb) {
        int idx = i * 256 + t;
        int gp = idx >> 4;
        int g = gp >> 6;
        float dt = __expf(p.log_dt[g]);
        float2 f = zoh_fac(p.lam_re[gp], p.lam_im[gp], dt);
        p.bbar[idx] = cmul(f, make_float2(p.b_re[idx], p.b_im[idx]));
        continue;
      }
      i -= n_bb;
      {
        int idx = i * 256 + t;
        int tok = idx >> 4, ii = idx & 15;
        float invf = exp2f(-(float)ii * (13.287712379549449f / 16.f));
        float ang = (float)p.pos[tok] * invf;
        float s, c;
        sincosf(ang, &s, &c);
        p.cs[idx] = make_float2(c, s);
      }
    }
  } else if (PH == 1) {
    const int n_norm = 4096;
    const int n_te = (32 * 1024 * 144) / 256;
    const int n_f = (32 * 128 * 128) / 256;
    const int total = n_norm + n_te + n_f;
    for (int it = bid; it < total; it += nb) {
      int i = it;
      if (i < n_norm) { norm_rows<true>(p, p.x, p.norm1_g, 0, 1024, p.hbuf, nullptr, i); continue; }
      i -= n_norm;
      if (i < n_te) {
        int idx = i * 256 + t;
        int k8 = idx % 144, n = (idx / 144) & 1023, g = idx / (144 * 1024);
        int k = k8 * 8, j = n >> 4, h = n & 15;
        if (k < 1024 && k >= ((n >> 7) + 1) * 128) continue;
        float v[8];
        if (k < 1024) {
          int ii = k >> 4, hp0 = k & 15;
          if (ii <= j) {
            const float* kp = p.ktab + ((size_t)(g * 64 + (j - ii)) * 16 + h) * 16 + hp0;
            float4 a = *(const float4*)kp, b = *(const float4*)(kp + 4);
            v[0] = a.x; v[1] = a.y; v[2] = a.z; v[3] = a.w; v[4] = b.x; v[5] = b.y; v[6] = b.z; v[7] = b.w;
          } else {
#pragma unroll
            for (int q = 0; q < 8; ++q) v[q] = 0.f;
          }
        } else {
          int q = k - 1024, p0 = q & 63, isim = q >> 6;
#pragma unroll
          for (int jj = 0; jj < 8; ++jj) {
            int pp = p0 + jj;
            float2 C = make_float2(p.c_re[(g * 16 + h) * 64 + pp], p.c_im[(g * 16 + h) * 64 + pp]);
            float2 L = p.pw[(size_t)(g * 65 + j + 1) * 64 + pp];
            float2 pr = cmul(C, L);
            v[jj] = isim ? -pr.y : pr.x;
          }
        }
        uint4 o = make_uint4(pack2(v[0], v[1]), pack2(v[2], v[3]), pack2(v[4], v[5]), pack2(v[6], v[7]));
        *(uint4*)(p.Bty + ((size_t)(g * 1024 + n)) * 1152 + k) = o;
        continue;
      }
      i -= n_te;
      {
        int idx = i * 256 + t;
        int k8 = idx & 127, n = (idx >> 7) & 127, g = idx >> 14;
        int k = k8 * 8, ii = k >> 4, hp0 = k & 15;
        int pp = n & 63, isim = n >> 6;
        float2 L = p.pw[(size_t)(g * 65 + 63 - ii) * 64 + pp];
        float v[8];
#pragma unroll
        for (int jj = 0; jj < 8; ++jj) {
          float2 pr = cmul(L, p.bbar[(size_t)(g * 64 + pp) * 16 + hp0 + jj]);
          v[jj] = isim ? pr.y : pr.x;
        }
        uint4 o = make_uint4(pack2(v[0], v[1]), pack2(v[2], v[3]), pack2(v[4], v[5]), pack2(v[6], v[7]));
        *(uint4*)(p.Fm + ((size_t)(g * 128 + n)) * 1024 + k) = o;
      }
    }
  } else if (PH == 2) {
    gemm256_phase<EPI_INPROJ, 0>(p, p.hbuf, 1024, p.Wt_in, 1024, 1024, 5, bid_, nb_, lds);
  } else if (PH == 3) {
    gemm256_phase<EPI_KV, 0>(p, p.kvlat, 256, p.Wt_ukv, 256, 256, 4, bid_, nb_, lds);
    gemm256_phase<EPI_Q, 0>(p, p.qlat, 384, p.Wt_uq, 384, 384, 3, bid_, nb_, lds);
    for (int i = bid - 256; i >= 0 && i < 128; i += nb) mod_item(p, i, smem, 1);
    for (int i = bid; i < 256; i += nb) {
      int g = i >> 3, mt = i & 7;
      gemm_tile<EPI_S, 0>(p, p.Ag + (size_t)g * 1024 * 1152, 1152, p.Fm + (size_t)g * 128 * 1024, 1024, 16, 16, 0,
                          mt * 128, 0, g, smem);
      __syncthreads();
      if (t < 128) {
        const int bsel = t >> 6, pp = t & 63;
        const float* Sst = (const float*)smem + (bsel * 64) * 129;
        const float2 LL = p.pw[(size_t)(g * 65 + 64) * 64 + pp];
        float2 X = make_float2(0.f, 0.f);
        bf16* xp_ = p.Ag + ((size_t)(g * 1024 + mt * 128 + bsel * 64)) * 1152 + 1024 + pp;
        for (int c = 0; c < 64; ++c) {
          xp_[(size_t)c * 1152] = f2bf(X.x);
          xp_[(size_t)c * 1152 + 64] = f2bf(X.y);
          const float sr = Sst[c * 129 + pp], si = Sst[c * 129 + 64 + pp];
          const float2 nx = cmul(LL, X);
          X = make_float2(nx.x + sr, nx.y + si);
        }
      }
      __syncthreads();
    }
  } else if (PH == 4) {
    const int total = 32768 / 256;
    for (int it = bid; it < total; it += nb) {
      int idx = it * 256 + t;
      int pp = idx & 63, b = (idx >> 6) & 15, g = idx >> 10;
      float2 LL = p.pw[(size_t)(g * 65 + 64) * 64 + pp];
      float2 X = make_float2(0.f, 0.f);
      const size_t rbase = (size_t)(g * 1024 + b * 64);
      for (int c0 = 0; c0 < 64; c0 += 16) {
        float sr[16], si[16];
#pragma unroll
        for (int q = 0; q < 16; ++q) {
          sr[q] = p.S[(rbase + c0 + q) * 128 + pp];
          si[q] = p.S[(rbase + c0 + q) * 128 + 64 + pp];
        }
#pragma unroll
        for (int q = 0; q < 16; ++q) {
          size_t row = rbase + c0 + q;
          p.Ag[row * 1152 + 1024 + pp] = f2bf(X.x);
          p.Ag[row * 1152 + 1088 + pp] = f2bf(X.y);
          float2 nx = cmul(LL, X);
          X = make_float2(nx.x + sr[q], nx.y + si[q]);
        }
      }
    }
  } else if (PH == 5) {
    const int na = 4096, ny = 2048;
    const int total = na + ny;
    if (nb_ == 256) {
      const int x = bid_ & 7, j = bid_ >> 3;
      for (int r = 0; r < 8; ++r) attn256_item(p, 16 * x + 2 * r + (j >> 4), (r & 1) ? (15 - (j & 15)) : (j & 15), lds);
#ifdef ATTN_TWICE
      for (int r = 0; r < 8; ++r) attn256_item(p, 16 * x + 2 * r + (j >> 4), (r & 1) ? (15 - (j & 15)) : (j & 15), lds, false);
#endif
    } else {
      for (int it = bid_; it < 2048; it += nb_) attn256_item(p, it & 127, 15 - (it >> 7), lds);
    }
    __syncthreads();
    if (nb_ == 256) {
      const int x = bid_ & 7, q = bid_ >> 3;
      for (int r = 0; r < 4; ++r) {
        const int g = x + 8 * r, nt = ((q & 7) + 2 * r) & 7, mt = (q >> 3) * 2 + hb;
        const int nk1 = 2 * nt + 2;
        gemm_tile<EPI_Y, 0>(p, p.Ag + (size_t)g * 1024 * 1152, 1152, p.Bty + (size_t)g * 1024 * 1152, 1152, nk1 + 2,
                            nk1, 16, mt * 128, nt * 128, g, smem);
      }
    } else
    for (int it = na + bid; it < total; it += nb) {
      int i = it;
      i -= na;
      {
        int mt = ((i >> 4) & 3) * 2 + (i & 1), nt = (i >> 1) & 7, g = i >> 6;
        int nk1 = 2 * nt + 2;
        gemm_tile<EPI_Y, 0>(p, p.Ag + (size_t)g * 1024 * 1152, 1152, p.Bty + (size_t)g * 1024 * 1152, 1152, nk1 + 2,
                            nk1, 16, mt * 128, nt * 128, g, smem);
      }
    }
  } else if (PH == 6) {
    gemm256_phase<EPI_GLU, 0>(p, p.ygelu, 512, p.Wt_glu, 512, 512, 4, bid_, nb_, lds);
  } else if (PH == 7) {
    gemm256_phase<EPI_OUT, 2>(p, p.ycat, 1024, p.Wt_out, 1024, 1024, 4, bid_, nb_, lds);
  } else if (PH == 8) {
    for (int it = bid; it < 4096; it += nb) norm_rows<true>(p, p.out, p.norm2_g, 3072, 4096, p.hbuf, nullptr, it);
  } else if (PH == 9) {
    gemm256_phase<EPI_FF1, 0>(p, p.hbuf, 1024, p.Wt_ff1, 1024, 1024, 16, bid_, nb_, lds);
  } else if (PH == 10) {
    gemm256_phase<EPI_FF2, 0>(p, p.hid, 4096, p.Wt_ff2, 4096, 4096, 4, bid_, nb_, lds);
  } else if (PH == 11) {
    for (int it = bid; it < 4096; it += nb) norm_rows<false>(p, p.out, p.fnorm_g, 6144, 7168, nullptr, p.out, it);
  }
}

template <int PH>
__global__ void __launch_bounds__(NT, 2) k_phase(P p) {
  __shared__ __attribute__((aligned(16))) char smem[SMEM_BYTES];
  run_phase<PH>(p, blockIdx.x, gridDim.x, smem);
}

__global__ void __launch_bounds__(NT, 2) k_mega(P p) {
  __shared__ __attribute__((aligned(16))) char smem[SMEM_BYTES];
  cg::grid_group grid = cg::this_grid();
  const int bid = blockIdx.x, nb = gridDim.x;
#ifndef DUPMASK
#define DUPMASK 0
#endif
#define RUNP(ph) run_phase<ph>(p, bid, nb, smem); grid.sync(); if (DUPMASK & (1 << ph)) { run_phase<ph>(p, bid, nb, smem); grid.sync(); }
  RUNP(0) RUNP(1) RUNP(2) RUNP(3) RUNP(5) RUNP(6) RUNP(7) RUNP(9)
  run_phase<10>(p, bid, nb, smem); grid.sync();
  run_phase<11>(p, bid, nb, smem);
}

extern "C" void kernel_launch(void* const* d_in, const int* in_sizes, int n_in, void* d_out, int out_size, void* d_ws,
                              size_t ws_size, hipStream_t stream) {
  P p{};
  p.x = (const float*)d_in[0]; p.c = (const float*)d_in[1]; p.pos = (const int*)d_in[2];
  p.ada_w = (const float*)d_in[3]; p.ada_b = (const float*)d_in[4]; p.norm1_g = (const float*)d_in[5];
  p.w_in = (const float*)d_in[6]; p.lam_re = (const float*)d_in[7]; p.lam_im = (const float*)d_in[8];
  p.b_re = (const float*)d_in[9]; p.b_im = (const float*)d_in[10]; p.c_re = (const float*)d_in[11];
  p.c_im = (const float*)d_in[12]; p.ssm_d = (const float*)d_in[13]; p.log_dt = (const float*)d_in[14];
  p.w_glu = (const float*)d_in[15]; p.q_norm_g = (const float*)d_in[16]; p.w_uq = (const float*)d_in[17];
  p.kv_norm_g = (const float*)d_in[18]; p.w_ukv = (const float*)d_in[19]; p.ssm_out_g = (const float*)d_in[20];
  p.attn_out_g = (const float*)d_in[21]; p.w_out = (const float*)d_in[22]; p.norm2_g = (const float*)d_in[23];
  p.w_ff1 = (const float*)d_in[24]; p.w_ff2 = (const float*)d_in[25]; p.fada_w = (const float*)d_in[26];
  p.fada_b = (const float*)d_in[27]; p.fnorm_g = (const float*)d_in[28];
  p.out = (float*)d_out;
  char* ws = (char*)d_ws;
  size_t off = 0;
  auto take = [&](size_t bytes) { char* r = ws + off; off += (bytes + 255) & ~(size_t)255; return r; };
  p.Wt_in = (bf16*)take(1280ull * 1024 * 2);
  p.Wt_glu = (bf16*)take(1024ull * 512 * 2);
  p.Wt_uq = (bf16*)take(768ull * 384 * 2);
  p.Wt_ukv = (bf16*)take(1024ull * 256 * 2);
  p.Wt_out = (bf16*)take(1024ull * 1024 * 2);
  p.Wt_ff1 = (bf16*)take(4096ull * 1024 * 2);
  p.Wt_ff2 = (bf16*)take(1024ull * 4096 * 2);
  p.mod = (float*)take(16ull * 8192 * 4);
  p.rss_q = (float*)take(65536ull * 4);
  p.rss_kv = (float*)take(65536ull * 4);
  p.rss_s = (float*)take(65536ull * 4);
  p.rss_a = (float*)take(65536ull * 4);
  p.rss_x = (float*)take(65536ull * 4);
  p.biasff = (float*)take(16ull * 4096 * 4);
  p.pw = (float2*)take(32ull * 65 * 64 * 8);
  p.bbar = (float2*)take(32ull * 64 * 16 * 8);
  p.ktab = (float*)take(32ull * 64 * 256 * 4);
  p.cs = (float2*)take(65536ull * 16 * 8);
  p.hbuf = (bf16*)take(65536ull * 1024 * 2);
  size_t region = off;
  p.Ag = (bf16*)take(32ull * 1024 * 1152 * 2);
  p.Bty = (bf16*)take(32ull * 1024 * 1152 * 2);
  p.Fm = (bf16*)take(32ull * 128 * 1024 * 2);
  p.S = (float*)take(32ull * 1024 * 128 * 4);
  p.qlat = (bf16*)take(65536ull * 384 * 2);
  p.kvlat = (bf16*)take(65536ull * 256 * 2);
  p.Q = (bf16*)take(128ull * 4096 * 96 * 2);
  p.Kc = (bf16*)take(128ull * 4096 * 96 * 2);
  p.Vt = (bf16*)take(128ull * 64 * 4096 * 2);
  p.ygelu = (bf16*)take(65536ull * 512 * 2);
  p.ycat = (bf16*)take(65536ull * 1024 * 2);
  p.hid = (bf16*)(ws + region);

  hipMemsetAsync(p.mod, 0, 16ull * 8192 * 4 + 5ull * 65536 * 4 + 16ull * 4096 * 4, stream);
#if ONE_LAUNCH
  static int grid_blocks = 0;
  if (!grid_blocks) {
    int dev = 0, cus = 0, per_cu = 0;
    hipGetDevice(&dev);
    hipDeviceGetAttribute(&cus, hipDeviceAttributeMultiprocessorCount, dev);
    hipOccupancyMaxActiveBlocksPerMultiprocessor(&per_cu, k_mega, NT, 0);
    if (per_cu > 1) per_cu = 1;
    if (per_cu < 1) per_cu = 1;
    grid_blocks = cus * per_cu;
  }
  void* args[] = {&p};
  hipError_t e = hipLaunchCooperativeKernel((void*)k_mega, dim3(grid_blocks), dim3(NT), args, 0, stream);
  if (e != hipSuccess) fprintf(stderr, "cooperative launch failed: %s (grid %d)\n", hipGetErrorString(e), grid_blocks);
#else
  const int G = 256;
  k_phase<0><<<G, NT, 0, stream>>>(p);
  k_phase<1><<<G, NT, 0, stream>>>(p);
  k_phase<2><<<G, NT, 0, stream>>>(p);
  k_phase<3><<<G, NT, 0, stream>>>(p);
  k_phase<5><<<G, NT, 0, stream>>>(p);
  k_phase<6><<<G, NT, 0, stream>>>(p);
  k_phase<7><<<G, NT, 0, stream>>>(p);
  k_phase<9><<<G, NT, 0, stream>>>(p);
  k_phase<10><<<G, NT, 0, stream>>>(p);
  k_phase<11><<<G, NT, 0, stream>>>(p);
#endif
}
```
